# Optimizing an MI355X kernel written in HIP

```python
import math
import jax, jax.numpy as jnp
from jax import lax
import numpy as np

D_MODEL = 1024
BATCH = 8
SEQ = 4096
DEPTH = 4

GRID_W = 64
CTX_LEN = 256
Q_BLOCK = 128
ROPE_BASE = 10000.0
EPS = 1e-6
ADA_SCALE = 0.02

DA_HEADS = 4
DA_HD = 64
DA_Q = DA_HEADS * 2 * DA_HD
DA_K = DA_HEADS * 2 * DA_HD
DA_V = DA_HEADS * 2 * DA_HD
MLA_HEADS = 4
MLA_NOPE = 128
MLA_ROPE = 64
MLA_V = 128
MLA_Q_RANK = 384
MLA_KV_RANK = 256
MLA_OUT = MLA_HEADS * MLA_V
W_IN_COLS = DA_Q + DA_K + DA_V + MLA_Q_RANK + MLA_KV_RANK + MLA_ROPE + 2 * D_MODEL
N_EXPERTS = 32
TOP_K = 4
D_FF = 512
SWIGLU_LIMIT = 7.0
SWIGLU_ALPHA = 1.702
EXPERT_BLOCK = 512

kernel_name = "hybrid_diffattn_mla_moe_prefix_dit"


def rms(x, g):
    xf = x.astype(jnp.float32)
    y = xf * lax.rsqrt(jnp.mean(xf * xf, axis=-1, keepdims=True) + EPS)
    return (y * g.astype(jnp.float32)).astype(x.dtype)


def modulate(x, g, shift, scale):
    return rms(x, g) * (1 + scale) + shift


def rotate_half(x):
    x1, x2 = jnp.split(x, 2, axis=-1)
    return jnp.concatenate([-x2, x1], axis=-1)


def rotate_axial(x):
    xr, xc = jnp.split(x, 2, axis=-1)
    return jnp.concatenate([rotate_half(xr), rotate_half(xc)], axis=-1)


def axial_tables(rows, cols, d_rot, dtype):
    half = d_rot // 2
    freqs = ROPE_BASE ** (-jnp.arange(0, half, 2, dtype=jnp.float32) / half)
    ar = rows[:, None] * freqs
    ac = cols[:, None] * freqs
    ang = jnp.concatenate([ar, ar, ac, ac], axis=-1)
    return jnp.cos(ang)[:, None, :].astype(dtype), jnp.sin(ang)[:, None, :].astype(dtype)


def apply_rope(x, tables):
    cos, sin = tables
    return x * cos + rotate_axial(x) * sin


def softmax32(s):
    return jax.nn.softmax(s.astype(jnp.float32), axis=-1)


def diff_core(q1, q2, k1, k2, v, lam):
    scale = 1.0 / math.sqrt(DA_HD)
    p1 = softmax32(jnp.einsum('bqhd,bkhd->bhqk', q1, k1) * scale)
    p2 = softmax32(jnp.einsum('bqhd,bkhd->bhqk', q2, k2) * scale)
    p = (p1 - lam * p2).astype(v.dtype)
    return jnp.einsum('bhqk,bkhe->bqhe', p, v)


def mla_core(qn, qr, kn, kr, v):
    scale = 1.0 / math.sqrt(MLA_NOPE + MLA_ROPE)
    s = jnp.einsum('bqhd,bkhd->bhqk', qn, kn) + jnp.einsum('bqhd,bkd->bhqk', qr, kr)
    p = softmax32(s * scale).astype(v.dtype)
    return jnp.einsum('bhqk,bkhe->bqhe', p, v)


def blocked(fn, *qs):
    B, S = qs[0].shape[:2]
    nb = S // Q_BLOCK
    split = lambda a: jnp.moveaxis(a.reshape(B, nb, Q_BLOCK, *a.shape[2:]), 1, 0)
    out = lax.map(lambda qb: fn(*qb), tuple(split(a) for a in qs))
    return jnp.moveaxis(out, 0, 1).reshape(B, S, *out.shape[3:])


def mixer_inputs(h, w_in, qa_g, kva_g, wqb, wkvb, rope_da, rope_mla):
    B, S, _ = h.shape
    z = h @ w_in
    o = np.cumsum([DA_Q, DA_K, DA_V, MLA_Q_RANK, MLA_KV_RANK, MLA_ROPE])
    da_q, da_k, da_v, cq, ckv, kr, gates = jnp.split(z, list(o), axis=-1)
    da_q = da_q.reshape(B, S, DA_HEADS, 2, DA_HD)
    da_k = da_k.reshape(B, S, DA_HEADS, 2, DA_HD)
    q1, q2 = da_q[..., 0, :], da_q[..., 1, :]
    k1, k2 = da_k[..., 0, :], da_k[..., 1, :]
    v = da_v.reshape(B, S, DA_HEADS, 2 * DA_HD)
    q_mla = (rms(cq, qa_g) @ wqb).reshape(B, S, MLA_HEADS, MLA_NOPE + MLA_ROPE)
    kv_mla = (rms(ckv, kva_g) @ wkvb).reshape(B, S, MLA_HEADS, MLA_NOPE + MLA_V)
    qn, qr = q_mla[..., :MLA_NOPE], q_mla[..., MLA_NOPE:]
    kn, vm = kv_mla[..., :MLA_NOPE], kv_mla[..., MLA_NOPE:]
    if rope_da is not None:
        q1, q2 = apply_rope(q1, rope_da), apply_rope(q2, rope_da)
        k1, k2 = apply_rope(k1, rope_da), apply_rope(k2, rope_da)
        qr = apply_rope(qr, rope_mla)
        kr = apply_rope(kr[:, :, None, :], rope_mla)[:, :, 0, :]
    return q1, q2, k1, k2, v, qn, qr, kn, kr, vm, gates


def merge(o_da, o_mla, gates, subln_g, lam_init, w_br_a, w_br_b, w_out):
    B, S = o_da.shape[:2]
    o_da = (rms(o_da, subln_g) * (1.0 - lam_init)).reshape(B, S, DA_V)
    o_mla = o_mla.reshape(B, S, MLA_OUT)
    ga, gb = jnp.split(jax.nn.sigmoid(gates), 2, axis=-1)
    return (ga * (o_da @ w_br_a) + gb * (o_mla @ w_br_b)) @ w_out


def moe(t, rw, rb, wgu, bgu, wdn, bdn):
    T, D = t.shape
    TK = T * TOP_K
    NB = (TK + EXPERT_BLOCK - 1) // EXPERT_BLOCK + N_EXPERTS
    logits = (t @ rw + rb).astype(jnp.float32)
    topv, topi = lax.top_k(logits, TOP_K)
    wts = jax.nn.softmax(topv, axis=-1).reshape(-1)
    flat_e = topi.reshape(-1)
    order = jnp.argsort(flat_e)
    e_sorted = flat_e[order]
    tok = order // TOP_K
    sizes = jnp.bincount(flat_e, length=N_EXPERTS).astype(jnp.int32)
    padded = ((sizes + EXPERT_BLOCK - 1) // EXPERT_BLOCK) * EXPERT_BLOCK
    start = jnp.cumsum(sizes) - sizes
    pend = jnp.cumsum(padded)
    pstart = pend - padded
    dest = pstart[e_sorted] + (jnp.arange(TK, dtype=jnp.int32) - start[e_sorted])
    buf = jnp.zeros((NB * EXPERT_BLOCK, D), t.dtype).at[dest].set(t[tok])
    block_e = jnp.minimum(jnp.searchsorted(pend, jnp.arange(NB, dtype=jnp.int32) * EXPERT_BLOCK,
                                           side='right'), N_EXPERTS - 1)
    xb = buf.reshape(NB, EXPERT_BLOCK, D)
    h = jnp.einsum('nbd,ndf->nbf', xb, wgu[block_e]) + bgu[block_e][:, None, :]
    gate, lin = jnp.split(h, 2, axis=-1)
    gate = jnp.minimum(gate, SWIGLU_LIMIT)
    lin = jnp.clip(lin, -SWIGLU_LIMIT, SWIGLU_LIMIT)
    act = (lin + 1) * gate * jax.nn.sigmoid(SWIGLU_ALPHA * gate)
    out = jnp.einsum('nbf,nfd->nbd', act, wdn[block_e]) + bdn[block_e][:, None, :]
    y = out.reshape(NB * EXPERT_BLOCK, D)[dest] * wts[order][:, None].astype(out.dtype)
    return jnp.zeros_like(t).at[tok].add(y)


def setup_inputs(seed: int = 0) -> dict:
    key = jax.random.key(seed)
    ks = jax.random.split(key, 32)
    f32 = jnp.float32
    n = lambda k, shape, s: jax.random.normal(k, shape, f32) * s
    L, D = DEPTH, D_MODEL
    return {
        "x": n(ks[0], (BATCH, SEQ, D), 1.0),
        "c": n(ks[1], (BATCH, D), 1.0),
        "ctx": n(ks[2], (BATCH, CTX_LEN, D), 1.0),
        "c_ctx": n(ks[3], (D,), 1.0),
        "ada_w": n(ks[4], (L, D, 6 * D), ADA_SCALE),
        "ada_b": n(ks[5], (L, 6 * D), ADA_SCALE),
        "norm1_g": 1.0 + n(ks[6], (L, D), 0.02),
        "norm2_g": 1.0 + n(ks[7], (L, D), 0.02),
        "w_in": n(ks[8], (L, D, W_IN_COLS), D ** -0.5),
        "da_lq1": n(ks[9], (L, DA_HD), 0.1),
        "da_lk1": n(ks[10], (L, DA_HD), 0.1),
        "da_lq2": n(ks[11], (L, DA_HD), 0.1),
        "da_lk2": n(ks[12], (L, DA_HD), 0.1),
        "da_subln_g": 1.0 + n(ks[13], (L, 2 * DA_HD), 0.02),
        "mla_qa_g": 1.0 + n(ks[14], (L, MLA_Q_RANK), 0.02),
        "mla_kva_g": 1.0 + n(ks[15], (L, MLA_KV_RANK), 0.02),
        "mla_wqb": n(ks[16], (L, MLA_Q_RANK, MLA_HEADS * (MLA_NOPE + MLA_ROPE)), MLA_Q_RANK ** -0.5),
        "mla_wkvb": n(ks[17], (L, MLA_KV_RANK, MLA_HEADS * (MLA_NOPE + MLA_V)), MLA_KV_RANK ** -0.5),
        "w_br_a": n(ks[18], (L, DA_V, D), DA_V ** -0.5),
        "w_br_b": n(ks[19], (L, MLA_OUT, D), MLA_OUT ** -0.5),
        "w_out": n(ks[20], (L, D, D), D ** -0.5),
        "router_w": n(ks[21], (L, D, N_EXPERTS), D ** -0.5),
        "router_b": n(ks[22], (L, N_EXPERTS), 0.01),
        "moe_wgu": n(ks[23], (L, N_EXPERTS, D, 2 * D_FF), D ** -0.5),
        "moe_bgu": n(ks[24], (L, N_EXPERTS, 2 * D_FF), 0.01),
        "moe_wdn": n(ks[25], (L, N_EXPERTS, D_FF, D), D_FF ** -0.5),
        "moe_bdn": n(ks[26], (L, N_EXPERTS, D), 0.01),
        "final_g": 1.0 + n(ks[27], (D,), 0.02),
    }


def reference(x, c, ctx, c_ctx, ada_w, ada_b, norm1_g, norm2_g, w_in, da_lq1, da_lk1, da_lq2, da_lk2,
              da_subln_g, mla_qa_g, mla_kva_g, mla_wqb, mla_wkvb, w_br_a, w_br_b, w_out,
              router_w, router_b, moe_wgu, moe_bgu, moe_wdn, moe_bdn, final_g):
    B, S, D = x.shape
    ROWS = S // GRID_W
    rows = jnp.repeat(jnp.arange(ROWS, dtype=jnp.float32), GRID_W)
    cols = jnp.tile(jnp.arange(GRID_W, dtype=jnp.float32), ROWS)
    rope_da = axial_tables(rows, cols, DA_HD, x.dtype)
    rope_mla = axial_tables(rows, cols, MLA_ROPE, x.dtype)
    y = ctx
    for l in range(DEPTH):
        last = l == DEPTH - 1
        mod_x = (jax.nn.silu(c) @ ada_w[l] + ada_b[l])[:, None, :]
        mod_y = (jax.nn.silu(c_ctx) @ ada_w[l] + ada_b[l])[None, None, :]
        sh1x, sc1x, g1x, sh2x, sc2x, g2x = jnp.split(mod_x, 6, axis=-1)
        sh1y, sc1y, g1y, sh2y, sc2y, g2y = jnp.split(mod_y, 6, axis=-1)

        hx = modulate(x, norm1_g[l], sh1x, sc1x)
        hy = modulate(y, norm1_g[l], sh1y, sc1y)
        proj = (w_in[l], mla_qa_g[l], mla_kva_g[l], mla_wqb[l], mla_wkvb[l])
        q1x, q2x, k1x, k2x, vx, qnx, qrx, knx, krx, vmx, gx = mixer_inputs(hx, *proj, rope_da, rope_mla)
        q1y, q2y, k1y, k2y, vy, qny, qry, kny, kry, vmy, gy = mixer_inputs(hy, *proj, None, None)

        lam_init = 0.8 - 0.6 * math.exp(-0.3 * l)
        lam = (jnp.exp(jnp.sum(da_lq1[l].astype(jnp.float32) * da_lk1[l].astype(jnp.float32)))
               - jnp.exp(jnp.sum(da_lq2[l].astype(jnp.float32) * da_lk2[l].astype(jnp.float32)))
               + lam_init)

        k1a = jnp.concatenate([k1x, k1y], axis=1)
        k2a = jnp.concatenate([k2x, k2y], axis=1)
        va = jnp.concatenate([vx, vy], axis=1)
        kna = jnp.concatenate([knx, kny], axis=1)
        kra = jnp.concatenate([krx, kry], axis=1)
        vma = jnp.concatenate([vmx, vmy], axis=1)
        o_da_x = blocked(lambda a, b: diff_core(a, b, k1a, k2a, va, lam), q1x, q2x)
        o_mla_x = blocked(lambda a, b: mla_core(a, b, kna, kra, vma), qnx, qrx)
        mix_x = merge(o_da_x, o_mla_x, gx, da_subln_g[l], lam_init, w_br_a[l], w_br_b[l], w_out[l])
        x = x + g1x * mix_x

        moe_p = (router_w[l], router_b[l], moe_wgu[l], moe_bgu[l], moe_wdn[l], moe_bdn[l])
        h2x = modulate(x, norm2_g[l], sh2x, sc2x)
        if not last:
            o_da_y = diff_core(q1y, q2y, k1y, k2y, vy, lam)
            o_mla_y = mla_core(qny, qry, kny, kry, vmy)
            mix_y = merge(o_da_y, o_mla_y, gy, da_subln_g[l], lam_init, w_br_a[l], w_br_b[l], w_out[l])
            y = y + g1y * mix_y
            h2y = modulate(y, norm2_g[l], sh2y, sc2y)
            Ty = y.shape[1]
            f = moe(jnp.concatenate([h2x.reshape(-1, D), h2y.reshape(-1, D)], axis=0), *moe_p)
            x = x + g2x * f[:B * S].reshape(B, S, D)
            y = y + g2y * f[B * S:].reshape(B, Ty, D)
        else:
            x = x + g2x * moe(h2x.reshape(-1, D), *moe_p).reshape(B, S, D)
    return rms(x, final_g)
```

```cpp
#include <hip/hip_runtime.h>
#include <cstdio>
#include <cstdint>

#ifndef MK_ONE_LAUNCH
#define MK_ONE_LAUNCH 0
#endif

#define GAS __attribute__((address_space(1)))
#define LAS __attribute__((address_space(3)))
typedef unsigned short bf16_t;
typedef short bf16x8 __attribute__((ext_vector_type(8)));
typedef short s16x4 __attribute__((ext_vector_type(4)));
typedef float f32x4 __attribute__((ext_vector_type(4)));
typedef float f32x16 __attribute__((ext_vector_type(16)));
typedef unsigned u32x4 __attribute__((ext_vector_type(4)));
typedef unsigned u32x2 __attribute__((ext_vector_type(2)));

constexpr int DM = 1024, NB = 8, SEQ = 4096, DEPTH = 4, CTXL = 256;
constexpr int MX = NB * SEQ, MY = NB * CTXL, MT = MX + MY;
constexpr int NIN = 4352;
constexpr int NEXP = 32, DFF = 512;
constexpr int PMAX = 147456;
constexpr float EPS = 1e-6f;

constexpr size_t al256(size_t x) { return (x + 255) & ~(size_t)255; }
constexpr size_t WS_CTL = 0, CTL_ZERO_BYTES = 1u << 20;
constexpr size_t WS_MOD = CTL_ZERO_BYTES;
constexpr size_t WS_ROPE = WS_MOD + al256((size_t)DEPTH * 9 * 6144 * 4);
constexpr size_t WS_RWT = WS_ROPE + 8192;
constexpr size_t WS_WIN = WS_RWT + (size_t)DEPTH * 32 * 1024 * 4;
constexpr size_t WS_WQB = WS_WIN + (size_t)DEPTH * NIN * 1024 * 2;
constexpr size_t WS_WKVB = WS_WQB + (size_t)DEPTH * 768 * 384 * 2;
constexpr size_t WS_WBRA = WS_WKVB + (size_t)DEPTH * 1024 * 256 * 2;
constexpr size_t WS_WBRB = WS_WBRA + (size_t)DEPTH * 1024 * 512 * 2;
constexpr size_t WS_WOUT = WS_WBRB + (size_t)DEPTH * 1024 * 512 * 2;
constexpr size_t WS_WGU = WS_WOUT + (size_t)DEPTH * 1024 * 1024 * 2;
constexpr size_t WS_WDN = WS_WGU + (size_t)DEPTH * 32 * 1024 * 1024 * 2;
constexpr size_t WS_XS = WS_WDN + (size_t)DEPTH * 32 * 1024 * 512 * 2;
constexpr size_t WS_H = WS_XS + (size_t)MT * 1024 * 4;
constexpr size_t WS_QDA = WS_H + (size_t)MT * 1024 * 2;
constexpr size_t WS_KDA = WS_QDA + (size_t)MT * 512 * 2;
constexpr size_t WS_VDA = WS_KDA + (size_t)MT * 512 * 2;
constexpr size_t WS_GATES = WS_VDA + (size_t)MT * 512 * 2;
constexpr size_t WS_CQ = WS_GATES + (size_t)MT * 2048 * 2;
constexpr size_t WS_CKV = WS_CQ + (size_t)MT * 384 * 2;
constexpr size_t WS_KR = WS_CKV + (size_t)MT * 256 * 2;
constexpr size_t WS_ROWSQ = WS_KR + (size_t)MT * 64 * 2;
constexpr size_t WS_QMLA = WS_ROWSQ + (size_t)MT * 12 * 4;
constexpr size_t WS_KVMLA = WS_QMLA + (size_t)MT * 768 * 2;
constexpr size_t WS_ODA = WS_KVMLA + (size_t)MT * 1024 * 2;
constexpr size_t WS_OMLA = WS_ODA + (size_t)MT * 1024 * 2;
constexpr size_t WS_ODAN = WS_OMLA + (size_t)MT * 512 * 2;
constexpr size_t WS_U = WS_ODAN + (size_t)MT * 512 * 2;
constexpr size_t WS_TOPE = WS_U + (size_t)MT * 1024 * 2;
constexpr size_t WS_WTS = WS_TOPE + (size_t)MT * 16;
constexpr size_t WS_YDEST = WS_WTS + (size_t)MT * 16;
constexpr size_t WS_CNTWG = WS_YDEST + (size_t)MT * 16;
constexpr size_t WS_PSTART = WS_CNTWG + 1024 * 32 * 4;
constexpr size_t WS_ACT = WS_PSTART + 256;
constexpr size_t WS_Y = WS_ACT + (size_t)PMAX * 512 * 2;
constexpr size_t WS_END = WS_Y + (size_t)PMAX * 1024 * 2;

constexpr int CW_BAR = 4096;

constexpr int RING_BYTES = 131072;
constexpr int MISC_OFF = RING_BYTES;
constexpr int ROPE_OFF = 135168;
constexpr int LDS_BYTES = 147456;

__device__ __forceinline__ unsigned cvt_pk_bf16(float lo, float hi) { unsigned r; asm volatile("v_cvt_pk_bf16_f32 %0, %1, %2" : "=v"(r) : "v"(lo), "v"(hi)); return r; }
__device__ __forceinline__ float bf_lo(unsigned w) { return __uint_as_float(w << 16); }
__device__ __forceinline__ float bf_hi(unsigned w) { return __uint_as_float(w & 0xffff0000u); }
__device__ __forceinline__ float shx(float v, int o, int lane) { return __int_as_float(__builtin_amdgcn_ds_bpermute((lane ^ o) << 2, __float_as_int(v))); }
__device__ __forceinline__ int shxi(int v, int o, int lane) { return __builtin_amdgcn_ds_bpermute((lane ^ o) << 2, v); }
__device__ __forceinline__ float wave_sum(float v, int lane) {
#pragma unroll
    for (int o = 1; o < 64; o <<= 1) v += shx(v, o, lane);
    return v;
}
__device__ __forceinline__ float xchg32(float x, bool lo_half) {
    auto rr = __builtin_amdgcn_permlane32_swap(__float_as_uint(x), __float_as_uint(x), false, false);
    return __uint_as_float(lo_half ? rr[1] : rr[0]);
}
__device__ __forceinline__ float sigmoidf_(float x) { return 1.0f / (1.0f + __expf(-x)); }
__device__ __forceinline__ int opaque_tid() { int t = threadIdx.x; asm volatile("" : "+v"(t)); return t; }
#define LDS_WAIT() asm volatile("s_waitcnt lgkmcnt(0)" ::: "memory")
#define VM_WAIT() asm volatile("s_waitcnt vmcnt(0)" ::: "memory")

#define XB_TMO      128
#define XB_XCNT(j)  (256  + 64 * (j))
#define XB_XSUB(j)  (1280 + 64 * (j))
#define XB_XGEN(j)  (2304 + 64 * (j))
#define XB_TOP      3328
#define XB_TOPGEN   3392
#define XCD_BAR_WORDS 3456
#define XB_SPIN_CAP (1u << 18)
__device__ __forceinline__ unsigned xb_ld(unsigned* p)              { return __hip_atomic_load(p, __ATOMIC_RELAXED, __HIP_MEMORY_SCOPE_AGENT); }
__device__ __forceinline__ unsigned xb_add(unsigned* p, unsigned v) { return __hip_atomic_fetch_add(p, v, __ATOMIC_RELAXED, __HIP_MEMORY_SCOPE_AGENT); }
__device__ __forceinline__ unsigned xb_xcc_id() { return (unsigned)__builtin_amdgcn_s_getreg((3 << 11) | 20) & 0xFu; }
#define XB_SPIN(cond, bar) do { unsigned _sp = 0; while (cond) { __builtin_amdgcn_s_sleep(1); \
    if ((++_sp & 255u) == 0u) { if (xb_ld(&(bar)[XB_TMO])) break; if (_sp > XB_SPIN_CAP) { atomicAdd(&(bar)[XB_TMO], 1u); break; } } } } while (0)
struct XcdBarrier { unsigned* bar; unsigned x; volatile LAS unsigned* st; };
__device__ __forceinline__ XcdBarrier xcd_barrier_post(unsigned* bar, volatile LAS unsigned* st) {
    XcdBarrier b; b.bar = bar; b.x = xb_xcc_id(); b.st = st;
    if (threadIdx.x == 0) (void)xb_add(&bar[XB_XCNT(b.x)], 1u);
    return b;
}
__device__ __forceinline__ void xcd_barrier_complete(unsigned* bar, unsigned x, unsigned& nloc, unsigned& nx) {
    const unsigned G = gridDim.x * gridDim.y * gridDim.z;
    unsigned sum, cnt, mine, sp = 0u;
    for (;;) {
        sum = 0u; cnt = 0u; mine = 0u;
#pragma unroll
        for (unsigned j = 0; j < 16; ++j) { const unsigned c = xb_ld(&bar[XB_XCNT(j)]); sum += c; cnt += (c > 0u) ? 1u : 0u; mine = (j == x) ? c : mine; }
        if (sum == G) break;
        __builtin_amdgcn_s_sleep(1);
        if ((++sp & 255u) == 0u) { if (xb_ld(&bar[XB_TMO])) break; if (sp > XB_SPIN_CAP) { atomicAdd(&bar[XB_TMO], 1u); break; } }
    }
    nloc = mine > 0u ? mine : 1u; nx = cnt > 0u ? cnt : 1u;
}
__device__ __forceinline__ void xcd_barrier(const XcdBarrier& b) {
    asm volatile("s_waitcnt vmcnt(0)" ::: "memory");
    __syncthreads();
    if (threadIdx.x == 0) {
        unsigned* bar = b.bar; asm volatile("" : "+s"(bar));
        __builtin_amdgcn_s_waitcnt(0);
        unsigned nloc = b.st[0], nx = b.st[1];
        if (nloc == 0u) { xcd_barrier_complete(bar, b.x, nloc, nx); b.st[0] = nloc; b.st[1] = nx; }
        const unsigned old = xb_add(&bar[XB_XSUB(b.x)], 1u);
        const unsigned gen = old / nloc;
        if (old + 1u == (gen + 1u) * nloc) {
            __builtin_amdgcn_fence(__ATOMIC_RELEASE, "agent");
            asm volatile("s_waitcnt vmcnt(0)" ::: "memory");
            const unsigned og = xb_add(&bar[XB_TOP], 1u);
            const unsigned tg = og / nx;
            if (og + 1u == (tg + 1u) * nx) xb_add(&bar[XB_TOPGEN], 1u);
            else XB_SPIN(xb_ld(&bar[XB_TOPGEN]) == tg, bar);
            __builtin_amdgcn_fence(__ATOMIC_ACQUIRE, "agent");
            xb_add(&bar[XB_XGEN(b.x)], 1u);
            asm volatile("s_waitcnt vmcnt(0)" ::: "memory");
        } else {
            XB_SPIN(xb_ld(&bar[XB_XGEN(b.x)]) == gen, bar);
            __builtin_amdgcn_fence(__ATOMIC_ACQUIRE, "agent");
            asm volatile("s_waitcnt vmcnt(0)" ::: "memory");
        }
    }
    __syncthreads();
}

namespace pg8 {
constexpr int BM = 256, BK = 64, HALF = 128, HTB = HALF * BK * 2, STAGE_BYTES = 8 * HTB, NXCD = 8, WGM = 8;
__host__ __device__ __forceinline__ int lds_byte(int r, int c) { const int st = (r >> 4) * 2 + (c >> 5), rr = r & 15, cc = c & 31, ob = rr * 64 + cc * 2; return st * 1024 + (ob ^ (((ob >> 9) & 1) << 5)); }
__host__ __device__ __forceinline__ void stage_rc(int b, int& R, int& C) { const int st = b / 1024, sb = b % 1024, swz = sb ^ (((sb >> 9) & 1) << 5); R = (st >> 1) * 16 + swz / 64; C = (st & 1) * 32 + (swz % 64) / 2; }
__host__ __device__ __forceinline__ int perm32(int rho) { const int n = rho >> 4, i = rho & 15; return 8 * (i >> 2) + 4 * n + (i & 3); }
struct Unit { int pm, pn, z; };

template <class Epi, class Sched>
__device__ __forceinline__ void gemm_phase(LAS unsigned char* lds, const int K, const Sched& S, const Epi& E) {
    const int tid = opaque_tid(), wid = __builtin_amdgcn_readfirstlane(tid >> 6), lane = tid & 63, wr = wid >> 2, wc = wid & 3, fr = lane & 15, fq = lane >> 4;
    const int nt = K / BK;
    unsigned voffA[2], voffB[2];
#pragma unroll
    for (int i = 0; i < 2; ++i) { int R, C; stage_rc(tid * 16 + i * 8192, R, C); const int Rb = (R & ~31) + perm32(R & 31);
        voffA[i] = (unsigned)(R * K + C) * 2u; voffB[i] = (unsigned)(Rb * K + C) * 2u; }
    const size_t kstep = (size_t)(BK * 2);
    const size_t hstep = (size_t)HALF * K * 2;
    const unsigned ldsw = (unsigned)wid * 1024u;
    const int aoff = lds_byte(wr * 64 + fr, fq * 8), boff = lds_byte(wc * 32 + fr, fq * 8);
#define PG8_SA(b, h) (((b) * 2 + (h)) * HTB)
#define PG8_SB(b, h) ((4 + (b) * 2 + (h)) * HTB)
#define PG8_STAGE(bufoff, gbase, voff) do { _Pragma("unroll") for (int _i = 0; _i < 2; ++_i) \
        __builtin_amdgcn_global_load_lds((const unsigned*)((const char*)(gbase) + (voff)[_i]), (LAS unsigned*)(lds + (bufoff) + ldsw + _i * 8192), 16, 0, 0); } while (0)
#define PG8_LDA(dst, b, h) do { _Pragma("unroll") for (int m = 0; m < 4; ++m) _Pragma("unroll") for (int k = 0; k < 2; ++k) dst[m][k] = *(const LAS bf16x8*)(lds + PG8_SA(b, h) + aoff + m * 2048 + k * 1024); } while (0)
#define PG8_LDB(dst, b, h) do { _Pragma("unroll") for (int n = 0; n < 2; ++n) _Pragma("unroll") for (int k = 0; k < 2; ++k) dst[n][k] = *(const LAS bf16x8*)(lds + PG8_SB(b, h) + boff + n * 2048 + k * 1024); } while (0)
#define PG8_MMA(ai, bj, At, Bt) do { __builtin_amdgcn_s_setprio(1); _Pragma("unroll") for (int m = 0; m < 4; ++m) _Pragma("unroll") for (int n = 0; n < 2; ++n) _Pragma("unroll") for (int k = 0; k < 2; ++k) \
        acc[ai][bj][m][n] = __builtin_amdgcn_mfma_f32_16x16x32_bf16(Bt[n][k], At[m][k], acc[ai][bj][m][n], 0, 0, 0); __builtin_amdgcn_s_setprio(0); } while (0)
#define PG8_WAIT_V(n) asm volatile("s_waitcnt vmcnt(" #n ")" ::: "memory")
#define PG8_WAIT_L(n) asm volatile("s_waitcnt lgkmcnt(" #n ")" ::: "memory")
#define PG8_BAR __builtin_amdgcn_s_barrier()
#define PG8_SCHED __builtin_amdgcn_sched_barrier(0)
    Unit cur, nxt; int ui = 0;
    if (!S.next(0, cur)) return;
    f32x4 acc[2][2][4][2];
#pragma unroll
    for (int a = 0; a < 2; ++a)
#pragma unroll
        for (int b = 0; b < 2; ++b)
#pragma unroll
            for (int m = 0; m < 4; ++m)
#pragma unroll
                for (int n = 0; n < 2; ++n) acc[a][b][m][n] = (f32x4){0.f, 0.f, 0.f, 0.f};
    bf16x8 At[4][2], B0[2][2], B1[2][2];
    const char* cA = S.a_tile(cur); const char* cB = S.b_tile(cur);
    PG8_STAGE(PG8_SB(0, 0), cB, voffB); PG8_STAGE(PG8_SB(0, 1), cB + hstep, voffB); PG8_STAGE(PG8_SA(0, 0), cA, voffA); PG8_STAGE(PG8_SA(0, 1), cA + hstep, voffA);
    if (wr == 1) PG8_BAR;
    PG8_WAIT_V(2); PG8_BAR;
    PG8_STAGE(PG8_SB(1, 0), cB + kstep, voffB); PG8_STAGE(PG8_SA(1, 0), cA + kstep, voffA); PG8_STAGE(PG8_SB(1, 1), cB + hstep + kstep, voffB);
    PG8_WAIT_V(6); PG8_BAR;
    for (;;) {
        const bool has_next = S.next(ui + 1, nxt);
        const char* nA = has_next ? S.a_tile(nxt) : cA; const char* nB = has_next ? S.b_tile(nxt) : cB;
        for (int t = 0; t < nt; t += 2) {
            const bool last = (t == nt - 2);
            const char* a1 = cA + (size_t)(t + 1) * kstep;
            const char* a2 = last ? nA : cA + (size_t)(t + 2) * kstep; const char* b2 = last ? nB : cB + (size_t)(t + 2) * kstep;
            const char* a3 = a2 + kstep; const char* b3 = b2 + kstep;
            PG8_LDB(B0, 0, 0); PG8_LDB(B1, 0, 1); PG8_SCHED; PG8_LDA(At, 0, 0); PG8_STAGE(PG8_SA(1, 1), a1 + hstep, voffA);
            PG8_WAIT_V(8); PG8_WAIT_L(0); PG8_BAR; PG8_MMA(0, 0, At, B0); PG8_MMA(0, 1, At, B1); PG8_BAR; PG8_SCHED;
            PG8_LDA(At, 0, 1); PG8_STAGE(PG8_SB(0, 0), b2, voffB); PG8_STAGE(PG8_SB(0, 1), b2 + hstep, voffB); PG8_STAGE(PG8_SA(0, 0), a2, voffA);
            PG8_WAIT_V(8); PG8_WAIT_L(0); PG8_BAR; PG8_MMA(1, 0, At, B0); PG8_MMA(1, 1, At, B1); PG8_BAR; PG8_SCHED;
            PG8_LDB(B0, 1, 0); PG8_LDB(B1, 1, 1); PG8_SCHED; PG8_LDA(At, 1, 0); PG8_STAGE(PG8_SA(0, 1), a2 + hstep, voffA);
            PG8_WAIT_V(8); PG8_WAIT_L(0); PG8_BAR; PG8_MMA(0, 0, At, B0); PG8_MMA(0, 1, At, B1); PG8_BAR; PG8_SCHED;
            PG8_LDA(At, 1, 1); PG8_STAGE(PG8_SB(1, 0), b3, voffB); PG8_STAGE(PG8_SB(1, 1), b3 + hstep, voffB); PG8_STAGE(PG8_SA(1, 0), a3, voffA);
            PG8_WAIT_V(8); PG8_WAIT_L(0); PG8_BAR; PG8_MMA(1, 0, At, B0); PG8_MMA(1, 1, At, B1); PG8_BAR; PG8_SCHED;
        }
        if (wr == 0) PG8_BAR;
        E(acc, cur, wr, wc, fr, fq);
        if (!has_next) break;
#pragma unroll
        for (int a = 0; a < 2; ++a)
#pragma unroll
            for (int b = 0; b < 2; ++b)
#pragma unroll
                for (int m = 0; m < 4; ++m)
#pragma unroll
                    for (int n = 0; n < 2; ++n) acc[a][b][m][n] = (f32x4){0.f, 0.f, 0.f, 0.f};
        cur = nxt; cA = nA; cB = nB; ++ui;
        if (wr == 1) PG8_BAR;
    }
    PG8_WAIT_V(0);
    PG8_BAR;
#undef PG8_SA
#undef PG8_SB
#undef PG8_STAGE
#undef PG8_LDA
#undef PG8_LDB
#undef PG8_MMA
#undef PG8_WAIT_V
#undef PG8_WAIT_L
#undef PG8_BAR
#undef PG8_SCHED
}

__device__ __forceinline__ bool static_next(int i, int G, int c, int nM, int nN, Unit& u) {
    const int nwg = nM * nN; const long L = (long)i * G + c; if (L >= nwg) return false;
    int wgid = (int)L; { const int q = nwg / NXCD, r = nwg % NXCD, xcd = wgid % NXCD, off = wgid / NXCD; wgid = (xcd < r ? xcd * (q + 1) : r * (q + 1) + (xcd - r) * q) + off; }
    const int nig = WGM * nN, gid = wgid / nig, fm = gid * WGM, gsz = (nM - fm) < WGM ? (nM - fm) : WGM;
    u.pm = fm + ((wgid % nig) % gsz); u.pn = (wgid % nig) / gsz; u.z = 0; return true;
}
struct PlainSched {
    const char* A; const char* Bt; int K, nM, nN, G, c;
    __device__ __forceinline__ bool next(int i, Unit& u) const { return static_next(i, G, c, nM, nN, u); }
    __device__ __forceinline__ const char* a_tile(const Unit& u) const { return A + (size_t)u.pm * 256 * K * 2; }
    __device__ __forceinline__ const char* b_tile(const Unit& u) const { return Bt + (size_t)u.pn * 256 * K * 2; }
};
struct PairSched {
    const char* A0; long dA; const char* B0; long dB; int K, nM, nN, G, c;
    __device__ __forceinline__ bool next(int i, Unit& u) const { const bool ok = static_next(i >> 1, G, c, nM, nN, u); u.z = i & 1; return ok; }
    __device__ __forceinline__ const char* a_tile(const Unit& u) const { return A0 + (long)u.z * dA + (size_t)u.pm * 256 * K * 2; }
    __device__ __forceinline__ const char* b_tile(const Unit& u) const { return B0 + (long)u.z * dB + (size_t)u.pn * 256 * K * 2; }
};
struct MoeSched {
    const char* A; const char* Bt; int K; size_t bstride; int ntiles, G, c; const LAS int* tile_e;
    __device__ __forceinline__ bool next(int i, Unit& u) const { const long L = (long)i * G + c; const int t = (int)(L >> 2); if (t >= ntiles) return false;
        u.pm = t; u.pn = (int)(L & 3); u.z = __builtin_amdgcn_readfirstlane(tile_e[t]); return true; }
    __device__ __forceinline__ const char* a_tile(const Unit& u) const { return A + (size_t)u.pm * 256 * K * 2; }
    __device__ __forceinline__ const char* b_tile(const Unit& u) const { return Bt + (size_t)u.z * bstride + (size_t)u.pn * 256 * K * 2; }
};
}
using pg8::Unit;

#define EPI_ROWS(u, wr, fr) const int row0_ = (u).pm * 256 + (wr) * 64 + (fr);
#define EPI_V8(v, acc, ai, bj, m) float v[8] = {acc[ai][bj][m][0][0], acc[ai][bj][m][0][1], acc[ai][bj][m][0][2], acc[ai][bj][m][0][3], acc[ai][bj][m][1][0], acc[ai][bj][m][1][1], acc[ai][bj][m][1][2], acc[ai][bj][m][1][3]}
__device__ __forceinline__ void store8_bf16(bf16_t* p, const float (&v)[8]) {
    u32x4 w; w.x = cvt_pk_bf16(v[0], v[1]); w.y = cvt_pk_bf16(v[2], v[3]); w.z = cvt_pk_bf16(v[4], v[5]); w.w = cvt_pk_bf16(v[6], v[7]);
    *(u32x4*)p = w;
}
__device__ __forceinline__ void rope8(float (&v)[8], int pos, int g, int fq, const LAS float* T) {
    const int p = g ? (pos & 63) : (pos >> 6);
    const LAS f32x4* t = (const LAS f32x4*)(T + p * 32 + (fq & 1) * 16);
    const f32x4 t0 = t[0], t1 = t[1], t2 = t[2], t3 = t[3];
    const float cs[8] = {t0[0], t0[2], t1[0], t1[2], t2[0], t2[2], t3[0], t3[2]};
    const float sn[8] = {t0[1], t0[3], t1[1], t1[3], t2[1], t2[3], t3[1], t3[3]};
    const bool lo = fq < 2;
#pragma unroll
    for (int i = 0; i < 8; ++i) { const float pv = xchg32(v[i], lo); v[i] = lo ? (v[i] * cs[i] - pv * sn[i]) : (v[i] * cs[i] + pv * sn[i]); }
}

struct EpiG1 {
    unsigned char* ws; const LAS float* rope;
    __device__ __forceinline__ void operator()(const f32x4 (&acc)[2][2][4][2], const Unit& u, int wr, int wc, int fr, int fq) const {
        EPI_ROWS(u, wr, fr)
        bf16_t* const qda = (bf16_t*)(ws + WS_QDA); bf16_t* const kda = (bf16_t*)(ws + WS_KDA); bf16_t* const vda = (bf16_t*)(ws + WS_VDA); bf16_t* const gates = (bf16_t*)(ws + WS_GATES);
        bf16_t* const cq = (bf16_t*)(ws + WS_CQ); bf16_t* const ckv = (bf16_t*)(ws + WS_CKV); bf16_t* const kr = (bf16_t*)(ws + WS_KR); float* const rowsq = (float*)(ws + WS_ROWSQ);
        const int pn = u.pn; const bool xrows = u.pm < (MX / 256);
        if (pn < 4) {
            bf16_t* dst = pn < 2 ? qda : kda; const int cb = (pn & 1) * 256 + wc * 32 + 8 * fq;
#pragma unroll
            for (int ai = 0; ai < 2; ++ai)
#pragma unroll
                for (int m = 0; m < 4; ++m) { const int row = row0_ + ai * 128 + m * 16;
#pragma unroll
                    for (int bj = 0; bj < 2; ++bj) { EPI_V8(v, acc, ai, bj, m); if (xrows) rope8(v, row & 4095, wc & 1, fq, rope); store8_bf16(dst + (size_t)row * 512 + cb + bj * 128, v); } }
        } else if (pn < 6) {
            const int cb = (pn - 4) * 256 + wc * 32 + 8 * fq;
#pragma unroll
            for (int ai = 0; ai < 2; ++ai)
#pragma unroll
                for (int m = 0; m < 4; ++m) { const int row = row0_ + ai * 128 + m * 16;
#pragma unroll
                    for (int bj = 0; bj < 2; ++bj) { EPI_V8(v, acc, ai, bj, m); store8_bf16(vda + (size_t)row * 512 + cb + bj * 128, v); } }
        } else if (pn < 14) {
            const int cb = (pn - 6) * 256 + wc * 32 + 8 * fq;
#pragma unroll
            for (int ai = 0; ai < 2; ++ai)
#pragma unroll
                for (int m = 0; m < 4; ++m) { const int row = row0_ + ai * 128 + m * 16;
#pragma unroll
                    for (int bj = 0; bj < 2; ++bj) { EPI_V8(v, acc, ai, bj, m);
#pragma unroll
                        for (int i = 0; i < 8; ++i) v[i] = sigmoidf_(v[i]);
                        store8_bf16(gates + (size_t)row * 2048 + cb + bj * 128, v); } }
        } else if (pn == 14) {
            const int cb = wc * 32 + 8 * fq;
#pragma unroll
            for (int ai = 0; ai < 2; ++ai)
#pragma unroll
                for (int m = 0; m < 4; ++m) { const int row = row0_ + ai * 128 + m * 16; float ss = 0.f;
#pragma unroll
                    for (int bj = 0; bj < 2; ++bj) { EPI_V8(v, acc, ai, bj, m);
#pragma unroll
                        for (int i = 0; i < 8; ++i) ss += v[i] * v[i];
                        store8_bf16(cq + (size_t)row * 384 + cb + bj * 128, v); }
                    ss += shx(ss, 16, fq * 16 + fr); ss += shx(ss, 32, fq * 16 + fr);
                    if (fq == 0) rowsq[(size_t)row * 12 + wc] = ss; }
        } else if (pn == 15) {
            const int cb = wc * 32 + 8 * fq;
#pragma unroll
            for (int ai = 0; ai < 2; ++ai)
#pragma unroll
                for (int m = 0; m < 4; ++m) { const int row = row0_ + ai * 128 + m * 16; float ss = 0.f;
                    { EPI_V8(v, acc, ai, 0, m);
#pragma unroll
                        for (int i = 0; i < 8; ++i) ss += v[i] * v[i];
                        store8_bf16(cq + (size_t)row * 384 + 256 + cb, v); }
                    ss += shx(ss, 16, fq * 16 + fr); ss += shx(ss, 32, fq * 16 + fr);
                    if (fq == 0) rowsq[(size_t)row * 12 + 4 + wc] = ss;
                    if (wc < 2) { EPI_V8(v, acc, ai, 1, m); if (xrows) rope8(v, row & 4095, wc, fq, rope); store8_bf16(kr + (size_t)row * 64 + cb, v); } }
        } else {
            const int cb = wc * 32 + 8 * fq;
#pragma unroll
            for (int ai = 0; ai < 2; ++ai)
#pragma unroll
                for (int m = 0; m < 4; ++m) { const int row = row0_ + ai * 128 + m * 16; float ss = 0.f;
#pragma unroll
                    for (int bj = 0; bj < 2; ++bj) { EPI_V8(v, acc, ai, bj, m);
#pragma unroll
                        for (int i = 0; i < 8; ++i) ss += v[i] * v[i];
                        store8_bf16(ckv + (size_t)row * 256 + cb + bj * 128, v); }
                    ss += shx(ss, 16, fq * 16 + fr); ss += shx(ss, 32, fq * 16 + fr);
                    if (fq == 0) rowsq[(size_t)row * 12 + 8 + wc] = ss; }
        }
    }
};
struct EpiQMla {
    unsigned char* ws; const LAS float* rope;
    __device__ __forceinline__ void operator()(const f32x4 (&acc)[2][2][4][2], const Unit& u, int wr, int wc, int fr, int fq) const {
        EPI_ROWS(u, wr, fr)
        bf16_t* const qmla = (bf16_t*)(ws + WS_QMLA); const float* const rowsq = (const float*)(ws + WS_ROWSQ);
        const bool xrows = u.pm < (MX / 256);
#pragma unroll
        for (int ai = 0; ai < 2; ++ai)
#pragma unroll
            for (int m = 0; m < 4; ++m) { const int row = row0_ + ai * 128 + m * 16;
                const f32x4 q0_ = *(const f32x4*)(rowsq + (size_t)row * 12), q1_ = *(const f32x4*)(rowsq + (size_t)row * 12 + 4);
                const float sc = rsqrtf((((q0_[0] + q0_[1]) + (q0_[2] + q0_[3])) + ((q1_[0] + q1_[1]) + (q1_[2] + q1_[3]))) * (1.0f / 384.0f) + EPS);
#pragma unroll
                for (int bj = 0; bj < 2; ++bj) { const int g32 = u.pn * 8 + bj * 4 + wc, j = g32 % 6;
                    EPI_V8(v, acc, ai, bj, m);
#pragma unroll
                    for (int i = 0; i < 8; ++i) v[i] *= sc;
                    if (xrows && j >= 4) rope8(v, row & 4095, j - 4, fq, rope);
                    store8_bf16(qmla + (size_t)row * 768 + g32 * 32 + 8 * fq, v); } }
    }
};
struct EpiKvMla {
    unsigned char* ws;
    __device__ __forceinline__ void operator()(const f32x4 (&acc)[2][2][4][2], const Unit& u, int wr, int wc, int fr, int fq) const {
        EPI_ROWS(u, wr, fr)
        bf16_t* const kvmla = (bf16_t*)(ws + WS_KVMLA); const float* const rowsq = (const float*)(ws + WS_ROWSQ);
        const int cb = u.pn * 256 + wc * 32 + 8 * fq;
#pragma unroll
        for (int ai = 0; ai < 2; ++ai)
#pragma unroll
            for (int m = 0; m < 4; ++m) { const int row = row0_ + ai * 128 + m * 16;
                const f32x4 q2_ = *(const f32x4*)(rowsq + (size_t)row * 12 + 8);
                const float sc = rsqrtf(((q2_[0] + q2_[1]) + (q2_[2] + q2_[3])) * (1.0f / 256.0f) + EPS);
#pragma unroll
                for (int bj = 0; bj < 2; ++bj) { EPI_V8(v, acc, ai, bj, m);
#pragma unroll
                    for (int i = 0; i < 8; ++i) v[i] *= sc;
                    store8_bf16(kvmla + (size_t)row * 1024 + cb + bj * 128, v); } }
    }
};
struct EpiBranch {
    unsigned char* ws;
    __device__ __forceinline__ void operator()(const f32x4 (&acc)[2][2][4][2], const Unit& u, int wr, int wc, int fr, int fq) const {
        EPI_ROWS(u, wr, fr)
        bf16_t* const U = (bf16_t*)(ws + WS_U); const bf16_t* const gates = (const bf16_t*)(ws + WS_GATES);
        const int cb = u.pn * 256 + wc * 32 + 8 * fq;
#pragma unroll
        for (int ai = 0; ai < 2; ++ai)
#pragma unroll
            for (int m = 0; m < 4; ++m) { const int row = row0_ + ai * 128 + m * 16;
#pragma unroll
                for (int bj = 0; bj < 2; ++bj) { const int col = cb + bj * 128; EPI_V8(v, acc, ai, bj, m);
                    const u32x4 g = *(const u32x4*)(gates + (size_t)row * 2048 + (u.z ? 1024 : 0) + col);
                    const float gv[8] = {bf_lo(g.x), bf_hi(g.x), bf_lo(g.y), bf_hi(g.y), bf_lo(g.z), bf_hi(g.z), bf_lo(g.w), bf_hi(g.w)};
                    bf16_t* up = U + (size_t)row * 1024 + col;
                    if (u.z) { const u32x4 o = *(const u32x4*)up; const float ov[8] = {bf_lo(o.x), bf_hi(o.x), bf_lo(o.y), bf_hi(o.y), bf_lo(o.z), bf_hi(o.z), bf_lo(o.w), bf_hi(o.w)};
#pragma unroll
                        for (int i = 0; i < 8; ++i) v[i] = ov[i] + gv[i] * v[i]; }
                    else {
#pragma unroll
                        for (int i = 0; i < 8; ++i) v[i] = gv[i] * v[i]; }
                    store8_bf16(up, v); } }
    }
};
struct EpiOut {
    float* XS; const float* xin; const float* ctx; const float* mod_l; int first;
    __device__ __forceinline__ void operator()(const f32x4 (&acc)[2][2][4][2], const Unit& u, int wr, int wc, int fr, int fq) const {
        EPI_ROWS(u, wr, fr)
        const int cb = u.pn * 256 + wc * 32 + 8 * fq;
        const bool xrows = u.pm < (MX / 256);
        const int bidx = xrows ? (u.pm >> 4) : 8;
        const float* g1 = mod_l + (size_t)bidx * 6144 + 2048;
        const float* base = first ? (xrows ? xin : ctx - (size_t)MX * 1024) : XS;
#pragma unroll
        for (int bj = 0; bj < 2; ++bj) { const int col = cb + bj * 128;
            const f32x4 ga = *(const f32x4*)(g1 + col), gb = *(const f32x4*)(g1 + col + 4);
#pragma unroll
            for (int ai = 0; ai < 2; ++ai)
#pragma unroll
                for (int m = 0; m < 4; ++m) { const size_t off = (size_t)(row0_ + ai * 128 + m * 16) * 1024 + col;
                    const f32x4 b0 = *(const f32x4*)(base + off), b1 = *(const f32x4*)(base + off + 4);
                    *(f32x4*)(XS + off) = b0 + ga * acc[ai][bj][m][0]; *(f32x4*)(XS + off + 4) = b1 + gb * acc[ai][bj][m][1]; } }
    }
};
struct EpiUp {
    bf16_t* act; const float* bgu;
    __device__ __forceinline__ void operator()(const f32x4 (&acc)[2][2][4][2], const Unit& u, int wr, int wc, int fr, int fq) const {
        EPI_ROWS(u, wr, fr)
        const int j0 = u.pn * 128 + wc * 32 + 8 * fq;
        const float* bg = bgu + (size_t)u.z * 1024 + j0;
        const f32x4 g0 = *(const f32x4*)bg, g1 = *(const f32x4*)(bg + 4), l0 = *(const f32x4*)(bg + 512), l1 = *(const f32x4*)(bg + 516);
        const float bgv[8] = {g0[0], g0[1], g0[2], g0[3], g1[0], g1[1], g1[2], g1[3]}, blv[8] = {l0[0], l0[1], l0[2], l0[3], l1[0], l1[1], l1[2], l1[3]};
#pragma unroll
        for (int ai = 0; ai < 2; ++ai)
#pragma unroll
            for (int m = 0; m < 4; ++m) { const int row = row0_ + ai * 128 + m * 16;
                EPI_V8(gt, acc, ai, 0, m); EPI_V8(ln, acc, ai, 1, m); float o[8];
#pragma unroll
                for (int i = 0; i < 8; ++i) { const float g = fminf(gt[i] + bgv[i], 7.0f); const float li = fminf(fmaxf(ln[i] + blv[i], -7.0f), 7.0f);
                    o[i] = (li + 1.0f) * g * sigmoidf_(1.702f * g); }
                store8_bf16(act + (size_t)row * 512 + j0, o); }
    }
};
struct EpiDown {
    bf16_t* Y; const float* bdn;
    __device__ __forceinline__ void operator()(const f32x4 (&acc)[2][2][4][2], const Unit& u, int wr, int wc, int fr, int fq) const {
        EPI_ROWS(u, wr, fr)
        const int cb = u.pn * 256 + wc * 32 + 8 * fq;
#pragma unroll
        for (int bj = 0; bj < 2; ++bj) { const int col = cb + bj * 128; const float* bp = bdn + (size_t)u.z * 1024 + col;
            const f32x4 b0 = *(const f32x4*)bp, b1 = *(const f32x4*)(bp + 4);
#pragma unroll
            for (int ai = 0; ai < 2; ++ai)
#pragma unroll
                for (int m = 0; m < 4; ++m) { const int row = row0_ + ai * 128 + m * 16;
                    const f32x4 a0 = acc[ai][bj][m][0] + b0, a1 = acc[ai][bj][m][1] + b1;
                    const float v[8] = {a0[0], a0[1], a0[2], a0[3], a1[0], a1[1], a1[2], a1[3]};
                    store8_bf16(Y + (size_t)row * 1024 + col, v); } }
    }
};

namespace att {
constexpr int NW = 8, QBLK = 32, KVBLK = 64;
constexpr int SHM_V = 16384, SHM_KR = 8192, SHM_KN = 16384;
constexpr int OFF_V = 0, OFF_KR = 2 * SHM_V, OFF_KN = OFF_KR + 2 * SHM_KR, OFF_WS = OFF_KN + 2 * SHM_KN;
constexpr float THR = 8.f;
#define KSWZN(row, colB) ((row) * 256 + ((colB) ^ (((row) & 15) << 4)))
#define KSWZR(row, colB) ((row) * 128 + ((colB) ^ ((((row) >> 1) & 7) << 4)))
#define SBAR() __builtin_amdgcn_sched_barrier(0)
__device__ __forceinline__ int crow(int r, int hi) { return (r & 3) + 8 * (r >> 2) + 4 * hi; }
template <int DN> struct SC { static constexpr float SCALE = DN ? 0.07216878364870322f : 0.125f; };
template <int DN>
__device__ __forceinline__ void partialSM(f32x16& p0, f32x16& p1, float& m_reg, float& mn, float& alpha) {
    constexpr float SCALE = SC<DN>::SCALE, C = SCALE * 1.4426950408889634f;
    float pmax = p0[0];
#pragma unroll
    for (int r = 1; r < 16; ++r) pmax = fmaxf(pmax, p0[r]);
#pragma unroll
    for (int r = 0; r < 16; ++r) pmax = fmaxf(pmax, p1[r]);
    { auto rr = __builtin_amdgcn_permlane32_swap(__float_as_uint(pmax), __float_as_uint(pmax), false, false);
      pmax = fmaxf(__uint_as_float(rr[0]), __uint_as_float(rr[1])); }
    if (__builtin_expect(__all(pmax - m_reg <= THR / SCALE), 1)) { mn = m_reg; alpha = 1.f; }
    else { mn = fmaxf(m_reg, pmax); alpha = __builtin_amdgcn_exp2f((m_reg - mn) * C); m_reg = mn; }
    const float mnC = -mn * C;
#pragma unroll
    for (int r = 0; r < 16; ++r) p0[r] = fmaf(p0[r], C, mnC);
#pragma unroll
    for (int r = 0; r < 16; ++r) p1[r] = fmaf(p1[r], C, mnC);
#pragma unroll
    for (int r = 0; r < 16; ++r) p0[r] = __builtin_amdgcn_exp2f(p0[r]);
}
__device__ __forceinline__ void finishSM(f32x16& p0, f32x16& p1, float alpha, float& l_reg, bf16x8& pa0, bf16x8& pa1, bf16x8& pa2, bf16x8& pa3) {
#pragma unroll
    for (int r = 0; r < 16; ++r) p1[r] = __builtin_amdgcn_exp2f(p1[r]);
    float ps = 0;
#pragma unroll
    for (int r = 0; r < 16; ++r) ps += p0[r];
#pragma unroll
    for (int r = 0; r < 16; ++r) ps += p1[r];
    { auto rr = __builtin_amdgcn_permlane32_swap(__float_as_uint(ps), __float_as_uint(ps), false, false);
      ps = __uint_as_float(rr[0]) + __uint_as_float(rr[1]); }
    l_reg = l_reg * alpha + ps;
#define PK4(P, BASE, OUT) do { unsigned a0 = cvt_pk_bf16(P[BASE + 0], P[BASE + 1]), a1 = cvt_pk_bf16(P[BASE + 2], P[BASE + 3]);   \
    unsigned b0 = cvt_pk_bf16(P[BASE + 4], P[BASE + 5]), b1 = cvt_pk_bf16(P[BASE + 6], P[BASE + 7]);                              \
    auto r0 = __builtin_amdgcn_permlane32_swap(a0, b0, false, false); auto r1 = __builtin_amdgcn_permlane32_swap(a1, b1, false, false); \
    u32x4 w = {r0[0], r1[0], r0[1], r1[1]}; OUT = *reinterpret_cast<bf16x8*>(&w); } while (0)
    PK4(p0, 0, pa0); PK4(p0, 8, pa1); PK4(p1, 0, pa2); PK4(p1, 8, pa3);
#undef PK4
}
template <int DN>
__device__ __forceinline__ void qkt(f32x16& p0, f32x16& p1, const char* Kn, const char* Kr, const bf16x8* qn, const bf16x8* qr, int r32, int hi) {
    p0 = f32x16{}; p1 = f32x16{};
    if constexpr (DN > 0) {
#pragma unroll
        for (int d0 = 0; d0 < DN / 16; ++d0) { const int cb = d0 * 32 + hi * 16;
            const bf16x8 b0 = *reinterpret_cast<const bf16x8*>(Kn + KSWZN(r32, cb));
            const bf16x8 b1 = *reinterpret_cast<const bf16x8*>(Kn + KSWZN(32 + r32, cb));
            p0 = __builtin_amdgcn_mfma_f32_32x32x16_bf16(b0, qn[d0], p0, 0, 0, 0);
            p1 = __builtin_amdgcn_mfma_f32_32x32x16_bf16(b1, qn[d0], p1, 0, 0, 0); }
    }
#pragma unroll
    for (int d0 = 0; d0 < 4; ++d0) { const int cb = d0 * 32 + hi * 16;
        const bf16x8 b0 = *reinterpret_cast<const bf16x8*>(Kr + KSWZR(r32, cb));
        const bf16x8 b1 = *reinterpret_cast<const bf16x8*>(Kr + KSWZR(32 + r32, cb));
        p0 = __builtin_amdgcn_mfma_f32_32x32x16_bf16(b0, qr[d0], p0, 0, 0, 0);
        p1 = __builtin_amdgcn_mfma_f32_32x32x16_bf16(b1, qr[d0], p1, 0, 0, 0); }
}
__device__ __forceinline__ int v_st(int k, int c) { const int kk = (k & ~0xC) | ((k & 4) << 1) | ((k & 8) >> 1); return ((kk >> 3) * 4 + (c >> 5)) * 512 + ((kk & 7) * 32 + (c & 31)) * 2; }
__device__ __forceinline__ int v_rd_base(int lane) { return ((lane & 3) << 3) | (((lane >> 2) & 3) << 6) | (((lane >> 4) & 1) << 5) | (((lane >> 5) & 1) << 8); }
constexpr int v_rd_off(int d0, int ks, int half) { return d0 * 512 + ks * 4096 + half * 2048; }
template <int OFF> __device__ __forceinline__ s16x4 tr_read(int vb) {
    s16x4 r; asm volatile("ds_read_b64_tr_b16 %0, %1 offset:%2" : "=&v"(r) : "v"(vb), "i"(OFF) : "memory"); return r;
}
template <int D0> __device__ __forceinline__ void pv_one(f32x16& od, int vb, bf16x8 pa0, bf16x8 pa1, bf16x8 pa2, bf16x8 pa3) {
    const s16x4 l0 = tr_read<v_rd_off(D0, 0, 0)>(vb), h0 = tr_read<v_rd_off(D0, 0, 1)>(vb), l1 = tr_read<v_rd_off(D0, 1, 0)>(vb), h1 = tr_read<v_rd_off(D0, 1, 1)>(vb);
    const s16x4 l2 = tr_read<v_rd_off(D0, 2, 0)>(vb), h2 = tr_read<v_rd_off(D0, 2, 1)>(vb), l3 = tr_read<v_rd_off(D0, 3, 0)>(vb), h3 = tr_read<v_rd_off(D0, 3, 1)>(vb);
    asm volatile("s_waitcnt lgkmcnt(0)" ::: "memory"); SBAR();
#define PK(L, H) (bf16x8){L[0], L[1], L[2], L[3], H[0], H[1], H[2], H[3]}
    od = __builtin_amdgcn_mfma_f32_32x32x16_bf16(pa0, PK(l0, h0), od, 0, 0, 0);
    od = __builtin_amdgcn_mfma_f32_32x32x16_bf16(pa1, PK(l1, h1), od, 0, 0, 0);
    od = __builtin_amdgcn_mfma_f32_32x32x16_bf16(pa2, PK(l2, h2), od, 0, 0, 0);
    od = __builtin_amdgcn_mfma_f32_32x32x16_bf16(pa3, PK(l3, h3), od, 0, 0, 0);
#undef PK
}
__device__ __forceinline__ void pv_d0(f32x16* o, int vb, bf16x8 pa0, bf16x8 pa1, bf16x8 pa2, bf16x8 pa3) {
    pv_one<0>(o[0], vb, pa0, pa1, pa2, pa3); pv_one<1>(o[1], vb, pa0, pa1, pa2, pa3); pv_one<2>(o[2], vb, pa0, pa1, pa2, pa3); pv_one<3>(o[3], vb, pa0, pa1, pa2, pa3);
}
template <int DN, int LDQ, int LDKN, int LDKR, int LDV, int LDO, int SDEPTH>
__device__ __forceinline__ void attn_unit(const bf16_t* __restrict__ Qn, const bf16_t* __restrict__ Qr, const bf16_t* __restrict__ Kng, const bf16_t* __restrict__ Krg,
                                          const bf16_t* __restrict__ Vg, bf16_t* __restrict__ Ob, const int q0, const int kx0, const int ky0, const int ntx, const int NT, char* lds) {
    const int tid = opaque_tid(), wid = tid >> 6, lane = tid & 63, r32 = lane & 31, hi = lane >> 5;
    char* V_lds = lds + OFF_V; char* KR_lds = lds + OFF_KR; char* KN_lds = lds + OFF_KN;
    float* ws = (float*)(lds + OFF_WS) + wid * 64; float* li_l = ws; float* al_l = ws + 32;
    float m_reg = -1e30f, l_reg = 0; f32x16 o[4] = {}; bf16x8 qn[DN ? DN / 16 : 1], qr[4];
    { const size_t qrow = (size_t)(q0 + wid * QBLK + r32);
      if constexpr (DN > 0) {
#pragma unroll
          for (int d0 = 0; d0 < DN / 16; ++d0) qn[d0] = *reinterpret_cast<const bf16x8*>(Qn + qrow * LDQ + hi * 8 + d0 * 16);
      }
#pragma unroll
      for (int d0 = 0; d0 < 4; ++d0) qr[d0] = *reinterpret_cast<const bf16x8*>(Qr + qrow * LDQ + hi * 8 + d0 * 16); }
    const int sr = tid >> 4, sc = (tid & 15) * 8, vst0 = v_st(sr, sc), vst1 = v_st(32 + sr, sc);
    const int rr_ = tid >> 3, rc_ = (tid & 7) * 8;
    const int vb0 = (int)(uintptr_t)V_lds + v_rd_base(lane);
    struct { bf16x8 vs0, vs1, kn0, kn1, kr0; } st_[SDEPTH];
#define KROW(j) __builtin_amdgcn_readfirstlane((j) < ntx ? kx0 + (j) * KVBLK : ky0 + ((j) - ntx) * KVBLK)
    const unsigned ovV0 = (unsigned)(sr * LDV + sc) * 2u, ovV1 = (unsigned)((32 + sr) * LDV + sc) * 2u, ovN0 = (unsigned)(sr * LDKN + sc) * 2u, ovN1 = (unsigned)((32 + sr) * LDKN + sc) * 2u, ovR = (unsigned)(rr_ * LDKR + rc_) * 2u;
#define SLOAD(i, j) do { const size_t k0_ = (size_t)KROW(j); const char* vb_ = (const char*)(Vg + k0_ * LDV); const char* rb_ = (const char*)(Krg + k0_ * LDKR); \
    st_[i].vs0 = *reinterpret_cast<const bf16x8*>(vb_ + ovV0); st_[i].vs1 = *reinterpret_cast<const bf16x8*>(vb_ + ovV1); \
    if constexpr (DN > 0) { const char* nb_ = (const char*)(Kng + k0_ * LDKN); st_[i].kn0 = *reinterpret_cast<const bf16x8*>(nb_ + ovN0); st_[i].kn1 = *reinterpret_cast<const bf16x8*>(nb_ + ovN1); } \
    st_[i].kr0 = *reinterpret_cast<const bf16x8*>(rb_ + ovR); } while (0)
#define SWRITE(b, i) do { *(bf16x8*)(V_lds + (b) * SHM_V + vst0) = st_[i].vs0; *(bf16x8*)(V_lds + (b) * SHM_V + vst1) = st_[i].vs1; \
    if constexpr (DN > 0) { *(bf16x8*)(KN_lds + (b) * SHM_KN + KSWZN(sr, sc * 2)) = st_[i].kn0; *(bf16x8*)(KN_lds + (b) * SHM_KN + KSWZN(32 + sr, sc * 2)) = st_[i].kn1; } \
    *(bf16x8*)(KR_lds + (b) * SHM_KR + KSWZR(rr_, rc_ * 2)) = st_[i].kr0; } while (0)
#define SWAIT() do { if constexpr (SDEPTH == 2) { if constexpr (DN > 0) asm volatile("s_waitcnt vmcnt(5)" ::: "memory"); else asm volatile("s_waitcnt vmcnt(3)" ::: "memory"); } else asm volatile("s_waitcnt vmcnt(0)" ::: "memory"); } while (0)
#define RESC(a) do { if (__any((a) < 1.f)) { if (hi == 0) al_l[r32] = (a); asm volatile("s_waitcnt lgkmcnt(0)" ::: "memory"); \
    _Pragma("unroll") for (int d = 0; d < 4; ++d) _Pragma("unroll") for (int r = 0; r < 16; ++r) o[d][r] *= al_l[crow(r, hi)]; } } while (0)
    f32x16 pA0, pA1, pB0, pB1; float mnA, mnB, alA, alB; bf16x8 pa0, pa1, pa2, pa3;
    constexpr int SE = 0, SO = SDEPTH - 1;
    SLOAD(SE, 0); asm volatile("s_waitcnt vmcnt(0)" ::: "memory"); SWRITE(0, SE); __syncthreads();
    qkt<DN>(pA0, pA1, KN_lds, KR_lds, qn, qr, r32, hi); partialSM<DN>(pA0, pA1, m_reg, mnA, alA);
    SLOAD(SO, 1); if constexpr (SDEPTH == 2) { if (2 < NT) SLOAD(SE, 2); }
    SWAIT(); SWRITE(1, SO); __syncthreads();
    for (int j = 1; j + 1 < NT; j += 2) {
        SBAR(); qkt<DN>(pB0, pB1, KN_lds + SHM_KN, KR_lds + SHM_KR, qn, qr, r32, hi);
        finishSM(pA0, pA1, alA, l_reg, pa0, pa1, pa2, pa3); SBAR();
        SLOAD(SO, j + SDEPTH); SBAR();
        pv_d0(o, vb0, pa0, pa1, pa2, pa3); partialSM<DN>(pB0, pB1, m_reg, mnB, alB);
        __syncthreads(); SWAIT(); SWRITE(0, SE);
        RESC(alB); __syncthreads();
        SBAR(); qkt<DN>(pA0, pA1, KN_lds, KR_lds, qn, qr, r32, hi);
        finishSM(pB0, pB1, alB, l_reg, pa0, pa1, pa2, pa3); SBAR();
        if (SDEPTH == 1 || j + 3 < NT) SLOAD(SE, j + 1 + SDEPTH); SBAR();
        pv_d0(o, vb0 + SHM_V, pa0, pa1, pa2, pa3); partialSM<DN>(pA0, pA1, m_reg, mnA, alA);
        __syncthreads(); SWAIT(); SWRITE(1, SO);
        RESC(alA); __syncthreads();
    }
    SBAR(); qkt<DN>(pB0, pB1, KN_lds + SHM_KN, KR_lds + SHM_KR, qn, qr, r32, hi);
    finishSM(pA0, pA1, alA, l_reg, pa0, pa1, pa2, pa3); SBAR();
    pv_d0(o, vb0, pa0, pa1, pa2, pa3); partialSM<DN>(pB0, pB1, m_reg, mnB, alB);
    __syncthreads(); RESC(alB);
    finishSM(pB0, pB1, alB, l_reg, pa0, pa1, pa2, pa3); SBAR();
    pv_d0(o, vb0 + SHM_V, pa0, pa1, pa2, pa3);
    if (hi == 0) li_l[r32] = l_reg; asm volatile("s_waitcnt lgkmcnt(0)" ::: "memory");
    const int tz = opaque_tid(), wid2 = tz >> 6, r32b = tz & 31, hib = (tz >> 5) & 1;
    const float* li2 = (const float*)(lds + OFF_WS) + wid2 * 64;
    float rli[16];
#pragma unroll
    for (int r = 0; r < 16; ++r) rli[r] = __builtin_amdgcn_rcpf(li2[crow(r, hib)]);
    bf16_t* Ow = Ob + (size_t)(q0 + wid2 * QBLK) * LDO;
#pragma unroll
    for (int r = 0; r < 16; ++r) { const int orow = crow(r, hib);
#pragma unroll
        for (int d0 = 0; d0 < 4; ++d0) { const unsigned w = cvt_pk_bf16(o[d0][r] * rli[r], 0.f); Ow[(size_t)orow * LDO + d0 * 32 + r32b] = (bf16_t)(w & 0xffffu); } }
    __syncthreads();
#undef KROW
#undef SLOAD
#undef SWRITE
#undef SWAIT
#undef RESC
}
}

struct Params { const float* in[28]; float* out; unsigned char* ws; int ph_lo, ph_hi; };
struct Ctx { LAS unsigned char* lds; char* ldsg; int tid, lane, wave, vcu, G; unsigned char* ws; };
enum { I_X = 0, I_C, I_CTX, I_CCTX, I_ADAW, I_ADAB, I_N1G, I_N2G, I_WIN, I_LQ1, I_LK1, I_LQ2, I_LK2, I_SUBLN, I_QAG, I_KVAG, I_WQB, I_WKVB, I_WBRA, I_WBRB, I_WOUT, I_RW, I_RB, I_WGU, I_BGU, I_WDN, I_BDN, I_FG };
template <typename T> __device__ __forceinline__ T* wsp(const Ctx& C, size_t off) { return (T*)(C.ws + off); }
constexpr int PTRTAB_OFF = MISC_OFF + 3072;
__device__ __forceinline__ const float* inp(const Ctx& C, int i) {
    const unsigned long long v = ((volatile LAS unsigned long long*)(C.lds + PTRTAB_OFF))[i];
    const unsigned lo = __builtin_amdgcn_readfirstlane((unsigned)v), hi = __builtin_amdgcn_readfirstlane((unsigned)(v >> 32));
    return (const float*)(((unsigned long long)hi << 32) | lo);
}

__device__ __forceinline__ void p0_transpose_item(const float* W, int K, int N, bf16_t* WT, int k0, int n0d, int n0s, const float* gain, LAS float* scr, int lane) {
#pragma unroll 8
    for (int i = 0; i < 32; ++i) { const int kk = 2 * i + (lane >> 5); float w = 0.f;
        if (n0s >= 0) { w = W[(size_t)(k0 + kk) * N + n0s + (lane & 31)]; if (gain) w *= gain[k0 + kk]; }
        scr[kk * 33 + (lane & 31)] = w; }
    LDS_WAIT(); asm volatile("" ::: "memory");
    const int c = lane & 7;
#pragma unroll
    for (int j = 0; j < 4; ++j) { const int n = (lane >> 3) + 8 * j; const LAS float* s = scr + (8 * c) * 33 + n;
        u32x4 o; o.x = cvt_pk_bf16(s[0 * 33], s[1 * 33]); o.y = cvt_pk_bf16(s[2 * 33], s[3 * 33]); o.z = cvt_pk_bf16(s[4 * 33], s[5 * 33]); o.w = cvt_pk_bf16(s[6 * 33], s[7 * 33]);
        *(u32x4*)(WT + (size_t)(n0d + n) * K + k0 + 8 * c) = o; }
    LDS_WAIT(); asm volatile("" ::: "memory");
}
__device__ __forceinline__ int win_src_col(int n) {
    if (n < 1536) return n; if (n < 3584) return 2240 + (n - 1536); if (n < 3968) return 1536 + (n - 3584);
    if (n < 4032) return 2176 + (n - 3968); if (n < 4096) return -1; return 1920 + (n - 4096);
}
__device__ __forceinline__ void phase_prologue(const Params& P, const Ctx& C0) {
    Ctx C = C0; { const int t_ = opaque_tid(); C.tid = t_; C.lane = t_ & 63; C.wave = __builtin_amdgcn_readfirstlane(t_ >> 6); asm volatile("" : "+s"(C.ws)); asm volatile("" : "+s"(C.vcu)); asm volatile("" : "+s"(C.G)); }
    LAS float* scr = (LAS float*)(C.lds + C.wave * 8448);
    const int gw = C.vcu * 8 + C.wave, NGW = C.G * 8;
    constexpr int I_IN = 16 * (NIN / 32), I_QB = 6 * 24, I_KVB = 4 * 32, I_BR = 8 * 32, I_OUT = 16 * 32, I_GU = 32 * 16 * 32, I_DN = 32 * 8 * 32;
    constexpr int PER_L = I_IN + I_QB + I_KVB + 2 * I_BR + I_OUT + I_GU + I_DN;
    for (int it = gw; it < DEPTH * PER_L; it += NGW) {
        const int l = it / PER_L; int r = it % PER_L;
        if (r < I_IN) { const int nb = r % (NIN / 32), kb = r / (NIN / 32);
            p0_transpose_item(inp(C, I_WIN) + (size_t)l * 1024 * 4288, 1024, 4288, wsp<bf16_t>(C, WS_WIN) + (size_t)l * NIN * 1024, kb * 64, nb * 32, win_src_col(nb * 32), nullptr, scr, C.lane); continue; } r -= I_IN;
        if (r < I_QB) { const int nb = r % 24, kb = r / 24;
            p0_transpose_item(inp(C, I_WQB) + (size_t)l * 384 * 768, 384, 768, wsp<bf16_t>(C, WS_WQB) + (size_t)l * 768 * 384, kb * 64, nb * 32, nb * 32, inp(C, I_QAG) + l * 384, scr, C.lane); continue; } r -= I_QB;
        if (r < I_KVB) { const int nb = r % 32, kb = r / 32;
            p0_transpose_item(inp(C, I_WKVB) + (size_t)l * 256 * 1024, 256, 1024, wsp<bf16_t>(C, WS_WKVB) + (size_t)l * 1024 * 256, kb * 64, nb * 32, nb * 32, inp(C, I_KVAG) + l * 256, scr, C.lane); continue; } r -= I_KVB;
        if (r < I_BR) { const int nb = r % 32, kb = r / 32;
            p0_transpose_item(inp(C, I_WBRA) + (size_t)l * 512 * 1024, 512, 1024, wsp<bf16_t>(C, WS_WBRA) + (size_t)l * 1024 * 512, kb * 64, nb * 32, nb * 32, nullptr, scr, C.lane); continue; } r -= I_BR;
        if (r < I_BR) { const int nb = r % 32, kb = r / 32;
            p0_transpose_item(inp(C, I_WBRB) + (size_t)l * 512 * 1024, 512, 1024, wsp<bf16_t>(C, WS_WBRB) + (size_t)l * 1024 * 512, kb * 64, nb * 32, nb * 32, nullptr, scr, C.lane); continue; } r -= I_BR;
        if (r < I_OUT) { const int nb = r % 32, kb = r / 32;
            p0_transpose_item(inp(C, I_WOUT) + (size_t)l * 1024 * 1024, 1024, 1024, wsp<bf16_t>(C, WS_WOUT) + (size_t)l * 1024 * 1024, kb * 64, nb * 32, nb * 32, nullptr, scr, C.lane); continue; } r -= I_OUT;
        if (r < I_GU) { const int e = r / 512, q = r % 512, nb = q % 32, kb = q / 32; const int n0 = nb * 32;
            const int src = 512 * ((n0 >> 7) & 1) + 128 * (n0 >> 8) + (n0 & 127);
            p0_transpose_item(inp(C, I_WGU) + ((size_t)l * 32 + e) * 1024 * 1024, 1024, 1024, wsp<bf16_t>(C, WS_WGU) + ((size_t)l * 32 + e) * 1024 * 1024, kb * 64, n0, src, nullptr, scr, C.lane); continue; } r -= I_GU;
        { const int e = r / 256, q = r % 256, nb = q % 32, kb = q / 32;
            p0_transpose_item(inp(C, I_WDN) + ((size_t)l * 32 + e) * 512 * 1024, 512, 1024, wsp<bf16_t>(C, WS_WDN) + ((size_t)l * 32 + e) * 1024 * 512, kb * 64, nb * 32, nb * 32, nullptr, scr, C.lane); }
    }
    { float* rwt = wsp<float>(C, WS_RWT); const float* rw = inp(C, I_RW);
      for (int i = C.vcu * 512 + C.tid; i < DEPTH * 32 * 1024; i += C.G * 512) { const int l = i >> 15, e = (i >> 10) & 31, d = i & 1023; rwt[i] = rw[((size_t)l * 1024 + d) * 32 + e]; }
 }
    __syncthreads();
    { LAS float* s = (LAS float*)(C.lds + 69632); LAS float* red = (LAS float*)(C.lds + 106496);
      const float* const cc = inp(C, I_C); const float* const cx = inp(C, I_CCTX);
      for (int i = C.tid; i < 9 * 1024; i += 512) { const float v = i < 8192 ? cc[i] : cx[i - 8192]; s[i] = v / (1.0f + __expf(-v)); }
      __syncthreads();
      const int cl = C.tid & 31, kg = C.tid >> 5; float* MOD = wsp<float>(C, WS_MOD); const float* const adaw = inp(C, I_ADAW); const float* const adab = inp(C, I_ADAB);
      for (int blk = C.vcu; blk < DEPTH * 192; blk += C.G) { const int l = blk / 192, col = (blk % 192) * 32 + cl;
          const float* w = adaw + (size_t)l * 1024 * 6144 + col; float a[9];
#pragma unroll
          for (int r = 0; r < 9; ++r) a[r] = 0.f;
          for (int kk = 0; kk < 64; ++kk) { const int k = kg * 64 + kk; const float wv = w[(size_t)k * 6144];
#pragma unroll
              for (int r = 0; r < 9; ++r) a[r] += s[r * 1024 + k] * wv; }
#pragma unroll
          for (int r = 0; r < 9; ++r) red[(kg * 32 + cl) * 9 + r] = a[r];
          __syncthreads();
          if (C.tid < 288) { const int c2 = C.tid & 31, r = C.tid >> 5; float t = 0.f;
              for (int g = 0; g < 16; ++g) t += red[(g * 32 + c2) * 9 + r];
              const int col2 = (blk % 192) * 32 + c2; MOD[((size_t)l * 9 + r) * 6144 + col2] = t + adab[(size_t)l * 6144 + col2]; }
          __syncthreads(); } }
}

__device__ __forceinline__ void phase_mod1(const Params& P, const Ctx& C0, const int l) {
    Ctx C = C0; { const int t_ = opaque_tid(); C.tid = t_; C.lane = t_ & 63; C.wave = __builtin_amdgcn_readfirstlane(t_ >> 6); asm volatile("" : "+s"(C.ws)); asm volatile("" : "+s"(C.vcu)); asm volatile("" : "+s"(C.G)); }
    const int gw = C.vcu * 8 + C.wave, NGW = C.G * 8;
    const float* MOD = wsp<float>(C, WS_MOD); float* XS = wsp<float>(C, WS_XS); bf16_t* H = wsp<bf16_t>(C, WS_H);
    const int* YD = wsp<int>(C, WS_YDEST); const float* WT = wsp<float>(C, WS_WTS); const bf16_t* Y = wsp<bf16_t>(C, WS_Y);
    const float* ng = inp(C, I_N1G) + l * 1024; const float* const xin = inp(C, I_X); const float* const cin = inp(C, I_CTX);
    for (int m = gw; m < MT; m += NGW) {
        const int bidx = m < MX ? (m >> 12) : 8;
        const float* src = l == 0 ? (m < MX ? xin + (size_t)m * 1024 : cin + (size_t)(m - MX) * 1024) : XS + (size_t)m * 1024;
        f32x4 v[4];
#pragma unroll
        for (int j = 0; j < 4; ++j) v[j] = ((const f32x4*)src)[C.lane + 64 * j];
        if (l > 0) {
            f32x4 f[4];
#pragma unroll
            for (int j = 0; j < 4; ++j) f[j] = (f32x4){0.f, 0.f, 0.f, 0.f};
#pragma unroll
            for (int k = 0; k < 4; ++k) { const int dst = YD[m * 4 + k]; const float w = WT[m * 4 + k]; const u32x2* yr = (const u32x2*)(Y + (size_t)dst * 1024);
#pragma unroll
                for (int j = 0; j < 4; ++j) { const u32x2 y = yr[C.lane + 64 * j]; f[j] += w * (f32x4){bf_lo(y.x), bf_hi(y.x), bf_lo(y.y), bf_hi(y.y)}; } }
            const float* g2 = MOD + ((size_t)(l - 1) * 9 + bidx) * 6144 + 5 * 1024;
#pragma unroll
            for (int j = 0; j < 4; ++j) { v[j] += ((const f32x4*)g2)[C.lane + 64 * j] * f[j]; ((f32x4*)(XS + (size_t)m * 1024))[C.lane + 64 * j] = v[j]; }
        }
        float ss = 0.f;
#pragma unroll
        for (int j = 0; j < 4; ++j) ss += (v[j].x * v[j].x + v[j].y * v[j].y) + (v[j].z * v[j].z + v[j].w * v[j].w);
        const float rstd = rsqrtf(wave_sum(ss, C.lane) * (1.0f / 1024.0f) + EPS);
        const float* sh = MOD + ((size_t)l * 9 + bidx) * 6144; const float* sc = sh + 1024;
        u32x2* o8 = (u32x2*)(H + (size_t)m * 1024);
#pragma unroll
        for (int j = 0; j < 4; ++j) { const f32x4 g = ((const f32x4*)ng)[C.lane + 64 * j], s1 = ((const f32x4*)sc)[C.lane + 64 * j], s0 = ((const f32x4*)sh)[C.lane + 64 * j];
            const f32x4 h = v[j] * rstd * g * (1.0f + s1) + s0; u32x2 w; w.x = cvt_pk_bf16(h.x, h.y); w.y = cvt_pk_bf16(h.z, h.w); o8[C.lane + 64 * j] = w; }
    }
}
__device__ __forceinline__ void phase_final(const Params& P, const Ctx& C0) {
    Ctx C = C0; { const int t_ = opaque_tid(); C.tid = t_; C.lane = t_ & 63; C.wave = __builtin_amdgcn_readfirstlane(t_ >> 6); asm volatile("" : "+s"(C.ws)); asm volatile("" : "+s"(C.vcu)); asm volatile("" : "+s"(C.G)); }
    const int gw = C.vcu * 8 + C.wave, NGW = C.G * 8;
    const float* MOD = wsp<float>(C, WS_MOD); const float* XS = wsp<float>(C, WS_XS);
    const int* YD = wsp<int>(C, WS_YDEST); const float* WT = wsp<float>(C, WS_WTS); const bf16_t* Y = wsp<bf16_t>(C, WS_Y);
    const float* fg = inp(C, I_FG); float* const outp = (float*)inp(C, 28);
    for (int m = gw; m < MX; m += NGW) {
        const int bidx = m >> 12;
        f32x4 v[4], f[4];
#pragma unroll
        for (int j = 0; j < 4; ++j) { v[j] = ((const f32x4*)(XS + (size_t)m * 1024))[C.lane + 64 * j]; f[j] = (f32x4){0.f, 0.f, 0.f, 0.f}; }
#pragma unroll
        for (int k = 0; k < 4; ++k) { const int dst = YD[m * 4 + k]; const float w = WT[m * 4 + k]; const u32x2* yr = (const u32x2*)(Y + (size_t)dst * 1024);
#pragma unroll
            for (int j = 0; j < 4; ++j) { const u32x2 y = yr[C.lane + 64 * j]; f[j] += w * (f32x4){bf_lo(y.x), bf_hi(y.x), bf_lo(y.y), bf_hi(y.y)}; } }
        const float* g2 = MOD + ((size_t)(DEPTH - 1) * 9 + bidx) * 6144 + 5 * 1024;
        float ss = 0.f;
#pragma unroll
        for (int j = 0; j < 4; ++j) { v[j] += ((const f32x4*)g2)[C.lane + 64 * j] * f[j]; ss += (v[j].x * v[j].x + v[j].y * v[j].y) + (v[j].z * v[j].z + v[j].w * v[j].w); }
        const float rstd = rsqrtf(wave_sum(ss, C.lane) * (1.0f / 1024.0f) + EPS);
#pragma unroll
        for (int j = 0; j < 4; ++j) ((f32x4*)(outp + (size_t)m * 1024))[C.lane + 64 * j] = v[j] * rstd * ((const f32x4*)fg)[C.lane + 64 * j];
    }
}
__device__ __forceinline__ void phase_damerge(const Params& P, const Ctx& C0, const int l, const int Ml) {
    Ctx C = C0; { const int t_ = opaque_tid(); C.tid = t_; C.lane = t_ & 63; C.wave = __builtin_amdgcn_readfirstlane(t_ >> 6); asm volatile("" : "+s"(C.ws)); asm volatile("" : "+s"(C.vcu)); asm volatile("" : "+s"(C.G)); }
    const int gw = C.vcu * 8 + C.wave, NGW = C.G * 8;
    const float lam_init = 0.8f - 0.6f * expf(-0.3f * (float)l);
    const float d1 = wave_sum(inp(C, I_LQ1)[l * 64 + C.lane] * inp(C, I_LK1)[l * 64 + C.lane], C.lane), d2 = wave_sum(inp(C, I_LQ2)[l * 64 + C.lane] * inp(C, I_LK2)[l * 64 + C.lane], C.lane);
    const float lam = expf(d1) - expf(d2) + lam_init;
    const float gA = inp(C, I_SUBLN)[l * 128 + 2 * C.lane] * (1.0f - lam_init), gB = inp(C, I_SUBLN)[l * 128 + 2 * C.lane + 1] * (1.0f - lam_init);
    const unsigned* ODA = wsp<unsigned>(C, WS_ODA); unsigned* ODAN = wsp<unsigned>(C, WS_ODAN);
    for (int m = gw; m < Ml; m += NGW) {
#pragma unroll
        for (int h = 0; h < 4; ++h) { const unsigned a = ODA[(size_t)m * 512 + h * 128 + C.lane], b = ODA[(size_t)m * 512 + h * 128 + 64 + C.lane];
            const float o0 = bf_lo(a) - lam * bf_lo(b), o1 = bf_hi(a) - lam * bf_hi(b);
            const float r = rsqrtf(wave_sum(o0 * o0 + o1 * o1, C.lane) * (1.0f / 128.0f) + EPS);
            ODAN[(size_t)m * 256 + h * 64 + C.lane] = cvt_pk_bf16(o0 * r * gA, o1 * r * gB); }
    }
}
__device__ __forceinline__ void phase_mod2_router(const Params& P, const Ctx& C0, const int l, const int Ml) {
    Ctx C = C0; { const int t_ = opaque_tid(); C.tid = t_; C.lane = t_ & 63; C.wave = __builtin_amdgcn_readfirstlane(t_ >> 6); asm volatile("" : "+s"(C.ws)); asm volatile("" : "+s"(C.vcu)); asm volatile("" : "+s"(C.G)); }
    LAS float* rwt = (LAS float*)C.lds;
    LAS int* hist = (LAS int*)(C.lds + MISC_OFF + 256);
    { const f32x4* src = (const f32x4*)(wsp<float>(C, WS_RWT) + (size_t)l * 32768); LAS f32x4* d = (LAS f32x4*)rwt;
      for (int i = C.tid; i < 8192; i += 512) d[i] = src[i];
      if (C.tid < 32) hist[C.tid] = 0; }
    __syncthreads();
    const float* MOD = wsp<float>(C, WS_MOD); const float* XS = wsp<float>(C, WS_XS); bf16_t* H = wsp<bf16_t>(C, WS_H);
    int* TOPE = wsp<int>(C, WS_TOPE); float* WT = wsp<float>(C, WS_WTS);
    const float* ng = inp(C, I_N2G) + l * 1024; const float rbias = inp(C, I_RB)[l * 32 + (C.lane >> 1)];
    const int wg = blockIdx.x, RPW = (Ml + C.G - 1) / C.G, m_lo = wg * RPW, m_hi = (m_lo + RPW < Ml) ? m_lo + RPW : Ml;
    for (int m = m_lo + C.wave; m < m_hi; m += 8) {
        const int bidx = m < MX ? (m >> 12) : 8;
        f32x4 v[4]; float ss = 0.f;
#pragma unroll
        for (int j = 0; j < 4; ++j) { v[j] = ((const f32x4*)(XS + (size_t)m * 1024))[C.lane + 64 * j]; ss += (v[j].x * v[j].x + v[j].y * v[j].y) + (v[j].z * v[j].z + v[j].w * v[j].w); }
        const float rstd = rsqrtf(wave_sum(ss, C.lane) * (1.0f / 1024.0f) + EPS);
        const float* sh = MOD + ((size_t)l * 9 + bidx) * 6144 + 3 * 1024; const float* sc = sh + 1024;
        u32x2* o8 = (u32x2*)(H + (size_t)m * 1024);
#pragma unroll
        for (int j = 0; j < 4; ++j) { const f32x4 g = ((const f32x4*)ng)[C.lane + 64 * j], s1 = ((const f32x4*)sc)[C.lane + 64 * j], s0 = ((const f32x4*)sh)[C.lane + 64 * j];
            v[j] = v[j] * rstd * g * (1.0f + s1) + s0; u32x2 w; w.x = cvt_pk_bf16(v[j].x, v[j].y); w.y = cvt_pk_bf16(v[j].z, v[j].w); o8[C.lane + 64 * j] = w; }
        float a[32];
#pragma unroll
        for (int e = 0; e < 32; ++e) { float t = 0.f;
#pragma unroll
            for (int j = 0; j < 4; ++j) { const f32x4 w = ((const LAS f32x4*)(rwt + e * 1024))[C.lane + 64 * j]; t += (v[j].x * w.x + v[j].y * w.y) + (v[j].z * w.z + v[j].w * w.w); }
            a[e] = t; }
#define RS_STEP(N, OFF, BIT) _Pragma("unroll") for (int e = 0; e < N; ++e) { const bool up = (C.lane >> BIT) & 1; const float keep = up ? a[e + N] : a[e], send = up ? a[e] : a[e + N]; a[e] = keep + shx(send, OFF, C.lane); }
        RS_STEP(16, 32, 5) RS_STEP(8, 16, 4) RS_STEP(4, 8, 3) RS_STEP(2, 4, 2) RS_STEP(1, 2, 1)
#undef RS_STEP
        float lg = a[0] + shx(a[0], 1, C.lane) + rbias;
        const int myE = C.lane >> 1;
        float tv[4]; int ti[4];
#pragma unroll
        for (int k = 0; k < 4; ++k) { float bv = lg; int bi = myE;
#pragma unroll
            for (int o = 1; o < 64; o <<= 1) { const float ov = shx(bv, o, C.lane); const int oi = shxi(bi, o, C.lane); if (ov > bv || (ov == bv && oi < bi)) { bv = ov; bi = oi; } }
            tv[k] = bv; ti[k] = bi; if (myE == bi) lg = -3.0e38f; }
        const float e1 = __expf(tv[1] - tv[0]), e2 = __expf(tv[2] - tv[0]), e3 = __expf(tv[3] - tv[0]); const float inv = 1.0f / (1.0f + e1 + e2 + e3);
        if (C.lane < 4) { const int e = C.lane == 0 ? ti[0] : C.lane == 1 ? ti[1] : C.lane == 2 ? ti[2] : ti[3];
            const float w = (C.lane == 0 ? 1.0f : C.lane == 1 ? e1 : C.lane == 2 ? e2 : e3) * inv;
            const int rank = atomicAdd((int*)(hist + e), 1);
            TOPE[m * 4 + C.lane] = e | (rank << 8); WT[m * 4 + C.lane] = w; }
    }
    __syncthreads();
    if (C.tid < 32) wsp<int>(C, WS_CNTWG)[wg * 32 + C.tid] = hist[C.tid];
    __syncthreads();
}
__device__ __forceinline__ void phase_lists(const Params& P, const Ctx& C0, const int Ml) {
    Ctx C = C0; { const int t_ = opaque_tid(); C.tid = t_; C.lane = t_ & 63; C.wave = __builtin_amdgcn_readfirstlane(t_ >> 6); asm volatile("" : "+s"(C.ws)); asm volatile("" : "+s"(C.vcu)); asm volatile("" : "+s"(C.G)); }
    LAS int* part = (LAS int*)(C.lds);
    LAS int* tot = (LAS int*)(C.lds + 4096);
    LAS int* base = (LAS int*)(C.lds + 4096 + 128);
    LAS int* pst = (LAS int*)(C.lds + 4096 + 256);
    const int* CNT = wsp<int>(C, WS_CNTWG); const int wg = blockIdx.x;
    { const int e = C.tid & 31, seg = C.tid >> 5; int s = 0, sb = 0;
      for (int w = seg; w < C.G; w += 16) { const int c = CNT[w * 32 + e]; s += c; if (w < wg) sb += c; }
      part[seg * 32 + e] = s; part[512 + seg * 32 + e] = sb; }
    __syncthreads();
    if (C.tid < 32) { int s = 0, sb = 0; for (int g = 0; g < 16; ++g) { s += part[g * 32 + C.tid]; sb += part[512 + g * 32 + C.tid]; } tot[C.tid] = s; base[C.tid] = sb; }
    __syncthreads();
    if (C.tid == 0) { int p = 0; for (int e = 0; e < 32; ++e) { pst[e] = p; p += (tot[e] + 255) & ~255; } pst[32] = p;
        if (wg == 0) { int* PS = wsp<int>(C, WS_PSTART); for (int e = 0; e <= 32; ++e) PS[e] = pst[e]; } }
    __syncthreads();
    const int* TOPE = wsp<int>(C, WS_TOPE); int* YD = wsp<int>(C, WS_YDEST); const bf16_t* H = wsp<bf16_t>(C, WS_H); bf16_t* XG = wsp<bf16_t>(C, WS_Y);
    const int RPW = (Ml + C.G - 1) / C.G, m_lo = wg * RPW, m_hi = (m_lo + RPW < Ml) ? m_lo + RPW : Ml;
    for (int m = m_lo + C.wave; m < m_hi; m += 8) {
        const u32x4 h0 = ((const u32x4*)(H + (size_t)m * 1024))[C.lane], h1 = ((const u32x4*)(H + (size_t)m * 1024))[C.lane + 64];
#pragma unroll
        for (int k = 0; k < 4; ++k) { const int t = TOPE[m * 4 + k], e = t & 255, rank = t >> 8; const int dst = pst[e] + base[e] + rank;
            if (C.lane == 0) YD[m * 4 + k] = dst;
            ((u32x4*)(XG + (size_t)dst * 1024))[C.lane] = h0; ((u32x4*)(XG + (size_t)dst * 1024))[C.lane + 64] = h1; }
    }
    for (int e = C.wave; e < 32; e += 8) { const int lo = pst[e] + tot[e], hi = pst[e + 1];
        for (int r = lo + wg; r < hi; r += C.G) { ((u32x4*)(XG + (size_t)r * 1024))[C.lane] = (u32x4){0u, 0u, 0u, 0u}; ((u32x4*)(XG + (size_t)r * 1024))[C.lane + 64] = (u32x4){0u, 0u, 0u, 0u}; } }
    __syncthreads();
}
__device__ __forceinline__ int moe_tiles(const Ctx& C0, LAS int* tile_e) {
    Ctx C = C0; { const int t_ = opaque_tid(); C.tid = t_; C.lane = t_ & 63; C.wave = __builtin_amdgcn_readfirstlane(t_ >> 6); asm volatile("" : "+s"(C.ws)); asm volatile("" : "+s"(C.vcu)); asm volatile("" : "+s"(C.G)); }
    const int* PS = wsp<int>(C, WS_PSTART);
    const int ntiles = PS[32] >> 8;
    for (int t = C.tid; t < ntiles; t += 512) { int e = 0;
#pragma unroll 1
        for (int j = 1; j < 32; ++j) if ((PS[j] >> 8) <= t) e = j;
        tile_e[t] = e; }
    __syncthreads();
    return __builtin_amdgcn_readfirstlane(ntiles);
}

constexpr int PH_PER_LAYER = 11, N_PHASES = 1 + DEPTH * PH_PER_LAYER + 1;
__global__ void __launch_bounds__(512, 2) dit_fwd(Params P) {
    extern __shared__ __attribute__((aligned(16))) unsigned char lds_raw[];
    Ctx C; C.lds = (LAS unsigned char*)lds_raw; C.ldsg = (char*)lds_raw; C.tid = threadIdx.x; C.lane = C.tid & 63; C.wave = __builtin_amdgcn_readfirstlane(C.tid >> 6);
    C.G = gridDim.x; { const int bx = blockIdx.x; C.vcu = (C.G % 8 == 0) ? (bx % 8) * (C.G / 8) + bx / 8 : bx; }
    C.ws = P.ws;
    volatile LAS unsigned* MISC = (volatile LAS unsigned*)(C.lds + MISC_OFF);
    if (C.tid < 64) MISC[C.tid] = 0u;
    if (C.tid == 64) { LAS unsigned long long* tab = (LAS unsigned long long*)(C.lds + PTRTAB_OFF);
#pragma unroll
        for (int i = 0; i < 28; ++i) tab[i] = (unsigned long long)P.in[i];
        tab[28] = (unsigned long long)P.out; }
    { LAS float* T = (LAS float*)(C.lds + ROPE_OFF);
      for (int i = C.tid; i < 1024; i += 512) { const int p = i >> 4, f = i & 15; const float fr = powf(10000.0f, -(float)(2 * f) / 32.0f); const float a = (float)p * fr; T[2 * i] = cosf(a); T[2 * i + 1] = sinf(a); } }
    __syncthreads();
    unsigned* barw = (unsigned*)(C.ws + WS_CTL) + CW_BAR;
    XcdBarrier bar; bar.bar = barw; bar.x = 0; bar.st = nullptr;
    const int lo = P.ph_lo, hi = P.ph_hi;
    const bool multi = (hi - lo) > 1;
    if (multi) bar = xcd_barrier_post(barw, MISC + 8);
#ifndef PH_MASK
#define PH_MASK 0xffff
#endif
#define IN(k) (lo <= (k) && (k) < hi)
#define EN(p) ((PH_MASK >> (p)) & 1)
#define SEAM(k) do { if (IN((k) + 1)) xcd_barrier(bar); } while (0)
    if (EN(11) && IN(0)) { phase_prologue(P, C); SEAM(0); }
    for (int l = 0; l < DEPTH; ++l) {
        const int pb = 1 + l * PH_PER_LAYER;
        const bool lastl = (l == DEPTH - 1);
        const int Ml = lastl ? MX : MT;
        const int nMl = Ml / 256;
        const float* MODl = wsp<float>(C, WS_MOD) + (size_t)l * 9 * 6144;
        if (EN(0) && IN(pb + 0)) { phase_mod1(P, C, l); SEAM(pb + 0); }
        if (EN(1) && IN(pb + 1)) {
            pg8::PlainSched S{(const char*)wsp<bf16_t>(C, WS_H), (const char*)(wsp<bf16_t>(C, WS_WIN) + (size_t)l * NIN * 1024), 1024, MT / 256, NIN / 256, C.G, (int)blockIdx.x};
            EpiG1 E{C.ws, (const LAS float*)(C.lds + ROPE_OFF)};
            pg8::gemm_phase(C.lds, 1024, S, E);
            SEAM(pb + 1);
        }
        if (EN(2) && IN(pb + 2)) {
            { pg8::PlainSched S{(const char*)wsp<bf16_t>(C, WS_CQ), (const char*)(wsp<bf16_t>(C, WS_WQB) + (size_t)l * 768 * 384), 384, MT / 256, 3, C.G, (int)blockIdx.x};
              EpiQMla E{C.ws, (const LAS float*)(C.lds + ROPE_OFF)};
              pg8::gemm_phase(C.lds, 384, S, E); }
            { pg8::PlainSched S{(const char*)wsp<bf16_t>(C, WS_CKV), (const char*)(wsp<bf16_t>(C, WS_WKVB) + (size_t)l * 1024 * 256), 256, MT / 256, 4, C.G, (int)blockIdx.x};
              EpiKvMla E{C.ws};
              pg8::gemm_phase(C.lds, 256, S, E); }
            SEAM(pb + 2);
        }
        if (EN(3) && IN(pb + 3)) {
            const bf16_t* QDA = wsp<bf16_t>(C, WS_QDA); const bf16_t* KDA = wsp<bf16_t>(C, WS_KDA); const bf16_t* VDA = wsp<bf16_t>(C, WS_VDA); bf16_t* ODA = wsp<bf16_t>(C, WS_ODA);
            const bf16_t* QM = wsp<bf16_t>(C, WS_QMLA); const bf16_t* KVM = wsp<bf16_t>(C, WS_KVMLA); const bf16_t* KR = wsp<bf16_t>(C, WS_KR); bf16_t* OM = wsp<bf16_t>(C, WS_OMLA);
#ifndef ATT_ONLY
#define ATT_ONLY 3
#endif
            const int nu_m = (ATT_ONLY & 1) ? NB * 4 * 16 + (lastl ? 0 : NB * 4) : 0;
            for (int u = C.vcu; u < nu_m; u += C.G) {
                int h, q0, kx0, ky0, ntx, nt;
                if (u < NB * 4 * 16) { const int qb = u & 15, b = u >> 6; h = (u >> 4) & 3; q0 = b * SEQ + qb * 256; kx0 = b * SEQ; ky0 = MX + b * CTXL; ntx = SEQ / 64; nt = SEQ / 64 + CTXL / 64; }
                else { const int v = u - NB * 4 * 16, b = v >> 2; h = v & 3; q0 = MX + b * CTXL; kx0 = 0; ky0 = q0; ntx = 0; nt = CTXL / 64; }
                att::attn_unit<128, 768, 1024, 64, 1024, 512, 1>(QM + h * 192, QM + h * 192 + 128, KVM + h * 256, KR, KVM + h * 256 + 128, OM + h * 128, q0, kx0, ky0, ntx, nt, C.ldsg); }
            const int nu_d = (ATT_ONLY & 2) ? NB * 8 * 16 + (lastl ? 0 : NB * 8) : 0;
            for (int u = C.vcu; u < nu_d; u += C.G) {
                int hm, q0, kx0, ky0, ntx, nt;
                if (u < NB * 8 * 16) { const int qb = u & 15, b = u >> 7; hm = (u >> 4) & 7; q0 = b * SEQ + qb * 256; kx0 = b * SEQ; ky0 = MX + b * CTXL; ntx = SEQ / 64; nt = SEQ / 64 + CTXL / 64; }
                else { const int v = u - NB * 8 * 16, b = v >> 3; hm = v & 7; q0 = MX + b * CTXL; kx0 = 0; ky0 = q0; ntx = 0; nt = CTXL / 64; }
                att::attn_unit<0, 512, 512, 512, 512, 1024, 2>(QDA, QDA + hm * 64, KDA, KDA + hm * 64, VDA + (hm >> 1) * 128, ODA + hm * 128, q0, kx0, ky0, ntx, nt, C.ldsg); }
            SEAM(pb + 3);
        }
        if (EN(4) && IN(pb + 4)) { phase_damerge(P, C, l, Ml); SEAM(pb + 4); }
        if (EN(5) && IN(pb + 5)) {
            pg8::PairSched S{(const char*)wsp<bf16_t>(C, WS_ODAN), (long)WS_OMLA - (long)WS_ODAN, (const char*)(wsp<bf16_t>(C, WS_WBRA) + (size_t)l * 1024 * 512), (long)WS_WBRB - (long)WS_WBRA, 512, nMl, 4, C.G, (int)blockIdx.x};
            EpiBranch E{C.ws};
            pg8::gemm_phase(C.lds, 512, S, E);
            SEAM(pb + 5);
        }
        if (EN(6) && IN(pb + 6)) {
            pg8::PlainSched S{(const char*)wsp<bf16_t>(C, WS_U), (const char*)(wsp<bf16_t>(C, WS_WOUT) + (size_t)l * 1024 * 1024), 1024, nMl, 4, C.G, (int)blockIdx.x};
            EpiOut E{wsp<float>(C, WS_XS), inp(C, I_X), inp(C, I_CTX), MODl, l == 0 ? 1 : 0};
            pg8::gemm_phase(C.lds, 1024, S, E);
            SEAM(pb + 6);
        }
        if (EN(7) && IN(pb + 7)) { phase_mod2_router(P, C, l, Ml); SEAM(pb + 7); }
        if (EN(8) && IN(pb + 8)) { phase_lists(P, C, Ml); SEAM(pb + 8); }
        if (EN(9) && IN(pb + 9)) {
            LAS int* tile_e = (LAS int*)(C.lds + MISC_OFF + 512);
            const int ntiles = moe_tiles(C, tile_e);
            pg8::MoeSched S{(const char*)wsp<bf16_t>(C, WS_Y), (const char*)(wsp<bf16_t>(C, WS_WGU) + (size_t)l * 32 * 1024 * 1024), 1024, (size_t)1024 * 1024 * 2, ntiles, C.G, C.vcu, tile_e};
            EpiUp E{wsp<bf16_t>(C, WS_ACT), inp(C, I_BGU) + (size_t)l * 32 * 1024};
            pg8::gemm_phase(C.lds, 1024, S, E);
            SEAM(pb + 9);
        }
        if (EN(10) && IN(pb + 10)) {
            LAS int* tile_e = (LAS int*)(C.lds + MISC_OFF + 512);
            const int ntiles = moe_tiles(C, tile_e);
            pg8::MoeSched S{(const char*)wsp<bf16_t>(C, WS_ACT), (const char*)(wsp<bf16_t>(C, WS_WDN) + (size_t)l * 32 * 1024 * 512), 512, (size_t)1024 * 512 * 2, ntiles, C.G, C.vcu, tile_e};
            EpiDown E{wsp<bf16_t>(C, WS_Y), inp(C, I_BDN) + (size_t)l * 32 * 1024};
            pg8::gemm_phase(C.lds, 512, S, E);
            SEAM(pb + 10);
        }
    }
    if (EN(12) && IN(N_PHASES - 1)) phase_final(P, C);
#undef IN
#undef SEAM
}

extern "C" void kernel_launch(void* const* d_in, const int* in_sizes, int n_in, void* d_out, int out_size, void* d_ws, size_t ws_size, hipStream_t stream) {
    static int grid = 0;
    if (grid == 0) {
        if (n_in != 28 || in_sizes[0] != MX * DM || out_size != MX * DM || ws_size < WS_END) { fprintf(stderr, "kernel_launch: shape/workspace mismatch (n_in %d, ws %zu < %zu)\n", n_in, ws_size, (size_t)WS_END); grid = -1; return; }
        int dev = 0, cus = 0, per_cu = 0;
        if (hipGetDevice(&dev) != hipSuccess || hipDeviceGetAttribute(&cus, hipDeviceAttributeMultiprocessorCount, dev) != hipSuccess) { grid = -1; return; }
        if (hipFuncSetAttribute((const void*)dit_fwd, hipFuncAttributeMaxDynamicSharedMemorySize, LDS_BYTES) != hipSuccess) { fprintf(stderr, "kernel_launch: hipFuncSetAttribute failed\n"); grid = -1; return; }
        if (hipOccupancyMaxActiveBlocksPerMultiprocessor(&per_cu, (const void*)dit_fwd, 512, LDS_BYTES) != hipSuccess || per_cu < 1) fprintf(stderr, "kernel_launch: occupancy query says %d\n", per_cu);
        (void)hipGetLastError();
        grid = cus > 1024 ? 1024 : cus;
    }
    if (grid < 0) return;
    if (hipMemsetAsync((char*)d_ws + WS_CTL, 0, CTL_ZERO_BYTES, stream) != hipSuccess) return;
    Params p{};
    for (int i = 0; i < 28; ++i) p.in[i] = (const float*)d_in[i];
    p.out = (float*)d_out; p.ws = (unsigned char*)d_ws;
#if MK_ONE_LAUNCH
    p.ph_lo = 0; p.ph_hi = N_PHASES;
    hipLaunchKernelGGL(dit_fwd, dim3(grid), dim3(512), LDS_BYTES, stream, p);
#else
    for (int k = 0; k < N_PHASES; ++k) { p.ph_lo = k; p.ph_hi = k + 1; hipLaunchKernelGGL(dit_fwd, dim3(grid), dim3(512), LDS_BYTES, stream, p); }
#endif
    const hipError_t le = hipPeekAtLastError();
    if (le != hipSuccess) fprintf(stderr, "kernel_launch: launch failed: %s\n", hipGetErrorName(le));
}
```

```cpp
#include <hip/hip_runtime.h>
#include <cstdio>
#include <cstdint>

#ifndef MK_ONE_LAUNCH
#define MK_ONE_LAUNCH 1
#endif

#define GAS __attribute__((address_space(1)))
#define LAS __attribute__((address_space(3)))
typedef unsigned short bf16_t;
typedef short bf16x8 __attribute__((ext_vector_type(8)));
typedef short s16x4 __attribute__((ext_vector_type(4)));
typedef float f32x4 __attribute__((ext_vector_type(4)));
typedef float f32x16 __attribute__((ext_vector_type(16)));
typedef unsigned u32x4 __attribute__((ext_vector_type(4)));
typedef unsigned u32x2 __attribute__((ext_vector_type(2)));

constexpr int DM = 1024, NB = 8, SEQ = 4096, DEPTH = 4, CTXL = 256;
constexpr int MX = NB * SEQ, MY = NB * CTXL, MT = MX + MY;
constexpr int NIN = 4352;
constexpr int NEXP = 32, DFF = 512;
constexpr int PMAX = 147456;
constexpr float EPS = 1e-6f;

constexpr size_t al256(size_t x) { return (x + 255) & ~(size_t)255; }
constexpr size_t WS_CTL = 0, CTL_ZERO_BYTES = 1u << 20;
constexpr size_t WS_MOD = CTL_ZERO_BYTES;
constexpr size_t WS_ROPE = WS_MOD + al256((size_t)DEPTH * 9 * 6144 * 4);
constexpr size_t WS_RWT = WS_ROPE + 8192;
constexpr size_t WS_WIN = WS_RWT + (size_t)DEPTH * 32 * 1024 * 4;
constexpr size_t WS_WQB = WS_WIN + (size_t)DEPTH * NIN * 1024 * 2;
constexpr size_t WS_WKVB = WS_WQB + (size_t)DEPTH * 768 * 384 * 2;
constexpr size_t WS_WBRA = WS_WKVB + (size_t)DEPTH * 1024 * 256 * 2;
constexpr size_t WS_WBRB = WS_WBRA + (size_t)DEPTH * 1024 * 512 * 2;
constexpr size_t WS_WOUT = WS_WBRB + (size_t)DEPTH * 1024 * 512 * 2;
constexpr size_t WS_WGU = WS_WOUT + (size_t)DEPTH * 1024 * 1024 * 2;
constexpr size_t WS_WDN = WS_WGU + (size_t)DEPTH * 32 * 1024 * 1024 * 2;
constexpr size_t WS_XS = WS_WDN + (size_t)DEPTH * 32 * 1024 * 512 * 2;
constexpr size_t WS_H = WS_XS + (size_t)MT * 1024 * 4;
constexpr size_t WS_QDA = WS_H + (size_t)MT * 1024 * 2;
constexpr size_t WS_KDA = WS_QDA + (size_t)MT * 512 * 2;
constexpr size_t WS_VDA = WS_KDA + (size_t)MT * 512 * 2;
constexpr size_t WS_GATES = WS_VDA + (size_t)MT * 512 * 2;
constexpr size_t WS_CQ = WS_GATES + (size_t)MT * 2048 * 2;
constexpr size_t WS_CKV = WS_CQ + (size_t)MT * 384 * 2;
constexpr size_t WS_KR = WS_CKV + (size_t)MT * 256 * 2;
constexpr size_t WS_ROWSQ = WS_KR + (size_t)MT * 64 * 2;
constexpr size_t WS_QMLA = WS_ROWSQ + (size_t)MT * 12 * 4;
constexpr size_t WS_KVMLA = WS_QMLA + (size_t)MT * 768 * 2;
constexpr size_t WS_ODA = WS_KVMLA + (size_t)MT * 1024 * 2;
constexpr size_t WS_OMLA = WS_ODA + (size_t)MT * 1024 * 2;
constexpr size_t WS_ODAN = WS_OMLA + (size_t)MT * 512 * 2;
constexpr size_t WS_U = WS_ODAN + (size_t)MT * 512 * 2;
constexpr size_t WS_TOPE = WS_U + (size_t)MT * 1024 * 2;
constexpr size_t WS_WTS = WS_TOPE + (size_t)MT * 16;
constexpr size_t WS_YDEST = WS_WTS + (size_t)MT * 16;
constexpr size_t WS_CNTWG = WS_YDEST + (size_t)MT * 16;
constexpr size_t WS_PSTART = WS_CNTWG + 1024 * 32 * 4;
constexpr size_t WS_ACT = WS_PSTART + 256;
constexpr size_t WS_Y = WS_ACT + (size_t)PMAX * 512 * 2;
constexpr size_t WS_END = WS_Y + (size_t)PMAX * 1024 * 2;

constexpr int CW_BAR = 4096;

constexpr int RING_BYTES = 131072;
constexpr int MISC_OFF = RING_BYTES;
constexpr int ROPE_OFF = 135168;
constexpr int LDS_BYTES = 147456;

__device__ __forceinline__ unsigned cvt_pk_bf16(float lo, float hi) { unsigned r; asm volatile("v_cvt_pk_bf16_f32 %0, %1, %2" : "=v"(r) : "v"(lo), "v"(hi)); return r; }
__device__ __forceinline__ float bf_lo(unsigned w) { return __uint_as_float(w << 16); }
__device__ __forceinline__ float bf_hi(unsigned w) { return __uint_as_float(w & 0xffff0000u); }
__device__ __forceinline__ float shx(float v, int o, int lane) { return __int_as_float(__builtin_amdgcn_ds_bpermute((lane ^ o) << 2, __float_as_int(v))); }
__device__ __forceinline__ int shxi(int v, int o, int lane) { return __builtin_amdgcn_ds_bpermute((lane ^ o) << 2, v); }
__device__ __forceinline__ float wave_sum(float v, int lane) {
#pragma unroll
    for (int o = 1; o < 64; o <<= 1) v += shx(v, o, lane);
    return v;
}
__device__ __forceinline__ float xchg32(float x, bool lo_half) {
    auto rr = __builtin_amdgcn_permlane32_swap(__float_as_uint(x), __float_as_uint(x), false, false);
    return __uint_as_float(lo_half ? rr[1] : rr[0]);
}
__device__ __forceinline__ float sigmoidf_(float x) { return 1.0f / (1.0f + __expf(-x)); }
__device__ __forceinline__ int opaque_tid() { int t = threadIdx.x; asm volatile("" : "+v"(t)); return t; }
#define LDS_WAIT() asm volatile("s_waitcnt lgkmcnt(0)" ::: "memory")
#define VM_WAIT() asm volatile("s_waitcnt vmcnt(0)" ::: "memory")

#define XB_TMO      128
#define XB_XCNT(j)  (256  + 64 * (j))
#define XB_XSUB(j)  (1280 + 64 * (j))
#define XB_XGEN(j)  (2304 + 64 * (j))
#define XB_TOP      3328
#define XB_TOPGEN   3392
#define XCD_BAR_WORDS 3456
#define XB_SPIN_CAP (1u << 18)
__device__ __forceinline__ unsigned xb_ld(unsigned* p)              { return __hip_atomic_load(p, __ATOMIC_RELAXED, __HIP_MEMORY_SCOPE_AGENT); }
__device__ __forceinline__ unsigned xb_add(unsigned* p, unsigned v) { return __hip_atomic_fetch_add(p, v, __ATOMIC_RELAXED, __HIP_MEMORY_SCOPE_AGENT); }
__device__ __forceinline__ unsigned xb_xcc_id() { return (unsigned)__builtin_amdgcn_s_getreg((3 << 11) | 20) & 0xFu; }
#define XB_SPIN(cond, bar) do { unsigned _sp = 0; while (cond) { __builtin_amdgcn_s_sleep(1); \
    if ((++_sp & 255u) == 0u) { if (xb_ld(&(bar)[XB_TMO])) break; if (_sp > XB_SPIN_CAP) { atomicAdd(&(bar)[XB_TMO], 1u); break; } } } } while (0)
struct XcdBarrier { unsigned* bar; unsigned x; volatile LAS unsigned* st; };
__device__ __forceinline__ XcdBarrier xcd_barrier_post(unsigned* bar, volatile LAS unsigned* st) {
    XcdBarrier b; b.bar = bar; b.x = xb_xcc_id(); b.st = st;
    if (threadIdx.x == 0) (void)xb_add(&bar[XB_XCNT(b.x)], 1u);
    return b;
}
__device__ __forceinline__ void xcd_barrier_complete(unsigned* bar, unsigned x, unsigned& nloc, unsigned& nx) {
    const unsigned G = gridDim.x * gridDim.y * gridDim.z;
    unsigned sum, cnt, mine, sp = 0u;
    for (;;) {
        sum = 0u; cnt = 0u; mine = 0u;
#pragma unroll
        for (unsigned j = 0; j < 16; ++j) { const unsigned c = xb_ld(&bar[XB_XCNT(j)]); sum += c; cnt += (c > 0u) ? 1u : 0u; mine = (j == x) ? c : mine; }
        if (sum == G) break;
        __builtin_amdgcn_s_sleep(1);
        if ((++sp & 255u) == 0u) { if (xb_ld(&bar[XB_TMO])) break; if (sp > XB_SPIN_CAP) { atomicAdd(&bar[XB_TMO], 1u); break; } }
    }
    nloc = mine > 0u ? mine : 1u; nx = cnt > 0u ? cnt : 1u;
}
__device__ __forceinline__ void xcd_barrier(const XcdBarrier& b) {
    asm volatile("s_waitcnt vmcnt(0)" ::: "memory");
    __syncthreads();
    if (threadIdx.x == 0) {
        unsigned* bar = b.bar; asm volatile("" : "+s"(bar));
        __builtin_amdgcn_s_waitcnt(0);
        unsigned nloc = b.st[0], nx = b.st[1];
        if (nloc == 0u) { xcd_barrier_complete(bar, b.x, nloc, nx); b.st[0] = nloc; b.st[1] = nx; }
        const unsigned old = xb_add(&bar[XB_XSUB(b.x)], 1u);
        const unsigned gen = old / nloc;
        if (old + 1u == (gen + 1u) * nloc) {
            __builtin_amdgcn_fence(__ATOMIC_RELEASE, "agent");
            asm volatile("s_waitcnt vmcnt(0)" ::: "memory");
            const unsigned og = xb_add(&bar[XB_TOP], 1u);
            const unsigned tg = og / nx;
            if (og + 1u == (tg + 1u) * nx) xb_add(&bar[XB_TOPGEN], 1u);
            else XB_SPIN(xb_ld(&bar[XB_TOPGEN]) == tg, bar);
            __builtin_amdgcn_fence(__ATOMIC_ACQUIRE, "agent");
            xb_add(&bar[XB_XGEN(b.x)], 1u);
            asm volatile("s_waitcnt vmcnt(0)" ::: "memory");
        } else {
            XB_SPIN(xb_ld(&bar[XB_XGEN(b.x)]) == gen, bar);
            __builtin_amdgcn_fence(__ATOMIC_ACQUIRE, "agent");
            asm volatile("s_waitcnt vmcnt(0)" ::: "memory");
        }
    }
    __syncthreads();
}

namespace pg8 {
constexpr int BM = 256, BK = 64, HALF = 128, HTB = HALF * BK * 2, STAGE_BYTES = 8 * HTB, NXCD = 8, WGM = 8;
__host__ __device__ __forceinline__ int lds_byte(int r, int c) { const int st = (r >> 4) * 2 + (c >> 5), rr = r & 15, cc = c & 31, ob = rr * 64 + cc * 2; return st * 1024 + (ob ^ (((ob >> 9) & 1) << 5)); }
__host__ __device__ __forceinline__ void stage_rc(int b, int& R, int& C) { const int st = b / 1024, sb = b % 1024, swz = sb ^ (((sb >> 9) & 1) << 5); R = (st >> 1) * 16 + swz / 64; C = (st & 1) * 32 + (swz % 64) / 2; }
__host__ __device__ __forceinline__ int perm32(int rho) { const int n = rho >> 4, i = rho & 15; return 8 * (i >> 2) + 4 * n + (i & 3); }
struct Unit { int pm, pn, z; };

template <class Epi, class Sched>
__device__ __forceinline__ void gemm_phase(LAS unsigned char* lds, const int K, const Sched& S, const Epi& E) {
    const int tid = opaque_tid(), wid = __builtin_amdgcn_readfirstlane(tid >> 6), lane = tid & 63, wr = wid >> 2, wc = wid & 3, fr = lane & 15, fq = lane >> 4;
    const int nt = K / BK;
    unsigned voffA[2], voffB[2];
#pragma unroll
    for (int i = 0; i < 2; ++i) { int R, C; stage_rc(tid * 16 + i * 8192, R, C); const int Rb = (R & ~31) + perm32(R & 31);
        voffA[i] = (unsigned)(R * K + C) * 2u; voffB[i] = (unsigned)(Rb * K + C) * 2u; }
    const size_t kstep = (size_t)(BK * 2);
    const size_t hstep = (size_t)HALF * K * 2;
    const unsigned ldsw = (unsigned)wid * 1024u;
    const int aoff = lds_byte(wr * 64 + fr, fq * 8), boff = lds_byte(wc * 32 + fr, fq * 8);
#define PG8_SA(b, h) (((b) * 2 + (h)) * HTB)
#define PG8_SB(b, h) ((4 + (b) * 2 + (h)) * HTB)
#define PG8_STAGE(bufoff, gbase, voff) do { _Pragma("unroll") for (int _i = 0; _i < 2; ++_i) \
        __builtin_amdgcn_global_load_lds((const unsigned*)((const char*)(gbase) + (voff)[_i]), (LAS unsigned*)(lds + (bufoff) + ldsw + _i * 8192), 16, 0, 0); } while (0)
#define PG8_LDA(dst, b, h) do { _Pragma("unroll") for (int m = 0; m < 4; ++m) _Pragma("unroll") for (int k = 0; k < 2; ++k) dst[m][k] = *(const LAS bf16x8*)(lds + PG8_SA(b, h) + aoff + m * 2048 + k * 1024); } while (0)
#define PG8_LDB(dst, b, h) do { _Pragma("unroll") for (int n = 0; n < 2; ++n) _Pragma("unroll") for (int k = 0; k < 2; ++k) dst[n][k] = *(const LAS bf16x8*)(lds + PG8_SB(b, h) + boff + n * 2048 + k * 1024); } while (0)
#define PG8_MMA(ai, bj, At, Bt) do { __builtin_amdgcn_s_setprio(1); _Pragma("unroll") for (int m = 0; m < 4; ++m) _Pragma("unroll") for (int n = 0; n < 2; ++n) _Pragma("unroll") for (int k = 0; k < 2; ++k) \
        acc[ai][bj][m][n] = __builtin_amdgcn_mfma_f32_16x16x32_bf16(Bt[n][k], At[m][k], acc[ai][bj][m][n], 0, 0, 0); __builtin_amdgcn_s_setprio(0); } while (0)
#define PG8_WAIT_V(n) asm volatile("s_waitcnt vmcnt(" #n ")" ::: "memory")
#define PG8_WAIT_L(n) asm volatile("s_waitcnt lgkmcnt(" #n ")" ::: "memory")
#define PG8_BAR __builtin_amdgcn_s_barrier()
#define PG8_SCHED __builtin_amdgcn_sched_barrier(0)
    Unit cur, nxt; int ui = 0;
    if (!S.next(0, cur)) return;
    f32x4 acc[2][2][4][2];
#pragma unroll
    for (int a = 0; a < 2; ++a)
#pragma unroll
        for (int b = 0; b < 2; ++b)
#pragma unroll
            for (int m = 0; m < 4; ++m)
#pragma unroll
                for (int n = 0; n < 2; ++n) acc[a][b][m][n] = (f32x4){0.f, 0.f, 0.f, 0.f};
    bf16x8 At[4][2], B0[2][2], B1[2][2];
    const char* cA = S.a_tile(cur); const char* cB = S.b_tile(cur);
    PG8_STAGE(PG8_SB(0, 0), cB, voffB); PG8_STAGE(PG8_SB(0, 1), cB + hstep, voffB); PG8_STAGE(PG8_SA(0, 0), cA, voffA); PG8_STAGE(PG8_SA(0, 1), cA + hstep, voffA);
    if (wr == 1) PG8_BAR;
    PG8_WAIT_V(2); PG8_BAR;
    PG8_STAGE(PG8_SB(1, 0), cB + kstep, voffB); PG8_STAGE(PG8_SA(1, 0), cA + kstep, voffA); PG8_STAGE(PG8_SB(1, 1), cB + hstep + kstep, voffB);
    PG8_WAIT_V(6); PG8_BAR;
    for (;;) {
        const bool has_next = S.next(ui + 1, nxt);
        const char* nA = has_next ? S.a_tile(nxt) : cA; const char* nB = has_next ? S.b_tile(nxt) : cB;
        for (int t = 0; t < nt; t += 2) {
            const bool last = (t == nt - 2);
            const char* a1 = cA + (size_t)(t + 1) * kstep;
            const char* a2 = last ? nA : cA + (size_t)(t + 2) * kstep; const char* b2 = last ? nB : cB + (size_t)(t + 2) * kstep;
            const char* a3 = a2 + kstep; const char* b3 = b2 + kstep;
            PG8_LDB(B0, 0, 0); PG8_LDB(B1, 0, 1); PG8_SCHED; PG8_LDA(At, 0, 0); PG8_STAGE(PG8_SA(1, 1), a1 + hstep, voffA);
            PG8_WAIT_V(8); PG8_WAIT_L(0); PG8_BAR; PG8_MMA(0, 0, At, B0); PG8_MMA(0, 1, At, B1); PG8_BAR; PG8_SCHED;
            PG8_LDA(At, 0, 1); PG8_STAGE(PG8_SB(0, 0), b2, voffB); PG8_STAGE(PG8_SB(0, 1), b2 + hstep, voffB); PG8_STAGE(PG8_SA(0, 0), a2, voffA);
            PG8_WAIT_V(8); PG8_WAIT_L(0); PG8_BAR; PG8_MMA(1, 0, At, B0); PG8_MMA(1, 1, At, B1); PG8_BAR; PG8_SCHED;
            PG8_LDB(B0, 1, 0); PG8_LDB(B1, 1, 1); PG8_SCHED; PG8_LDA(At, 1, 0); PG8_STAGE(PG8_SA(0, 1), a2 + hstep, voffA);
            PG8_WAIT_V(8); PG8_WAIT_L(0); PG8_BAR; PG8_MMA(0, 0, At, B0); PG8_MMA(0, 1, At, B1); PG8_BAR; PG8_SCHED;
            PG8_LDA(At, 1, 1); PG8_STAGE(PG8_SB(1, 0), b3, voffB); PG8_STAGE(PG8_SB(1, 1), b3 + hstep, voffB); PG8_STAGE(PG8_SA(1, 0), a3, voffA);
            PG8_WAIT_V(8); PG8_WAIT_L(0); PG8_BAR; PG8_MMA(1, 0, At, B0); PG8_MMA(1, 1, At, B1); PG8_BAR; PG8_SCHED;
        }
        if (wr == 0) PG8_BAR;
        E(acc, cur, wr, wc, fr, fq);
        if (!has_next) break;
#pragma unroll
        for (int a = 0; a < 2; ++a)
#pragma unroll
            for (int b = 0; b < 2; ++b)
#pragma unroll
                for (int m = 0; m < 4; ++m)
#pragma unroll
                    for (int n = 0; n < 2; ++n) acc[a][b][m][n] = (f32x4){0.f, 0.f, 0.f, 0.f};
        cur = nxt; cA = nA; cB = nB; ++ui;
        if (wr == 1) PG8_BAR;
    }
    PG8_WAIT_V(0);
    PG8_BAR;
#undef PG8_SA
#undef PG8_SB
#undef PG8_STAGE
#undef PG8_LDA
#undef PG8_LDB
#undef PG8_MMA
#undef PG8_WAIT_V
#undef PG8_WAIT_L
#undef PG8_BAR
#undef PG8_SCHED
}

__device__ __forceinline__ bool static_next(int i, int G, int c, int nM, int nN, Unit& u) {
    const int nwg = nM * nN; const long L = (long)i * G + c; if (L >= nwg) return false;
    int wgid = (int)L; { const int q = nwg / NXCD, r = nwg % NXCD, xcd = wgid % NXCD, off = wgid / NXCD; wgid = (xcd < r ? xcd * (q + 1) : r * (q + 1) + (xcd - r) * q) + off; }
    const int nig = WGM * nN, gid = wgid / nig, fm = gid * WGM, gsz = (nM - fm) < WGM ? (nM - fm) : WGM;
    u.pm = fm + ((wgid % nig) % gsz); u.pn = (wgid % nig) / gsz; u.z = 0; return true;
}
struct PlainSched {
    const char* A; const char* Bt; int K, nM, nN, G, c;
    __device__ __forceinline__ bool next(int i, Unit& u) const { return static_next(i, G, c, nM, nN, u); }
    __device__ __forceinline__ const char* a_tile(const Unit& u) const { return A + (size_t)u.pm * 256 * K * 2; }
    __device__ __forceinline__ const char* b_tile(const Unit& u) const { return Bt + (size_t)u.pn * 256 * K * 2; }
};
struct PairSched {
    const char* A0; long dA; const char* B0; long dB; int K, nM, nN, G, c;
    __device__ __forceinline__ bool next(int i, Unit& u) const { const bool ok = static_next(i >> 1, G, c, nM, nN, u); u.z = i & 1; return ok; }
    __device__ __forceinline__ const char* a_tile(const Unit& u) const { return A0 + (long)u.z * dA + (size_t)u.pm * 256 * K * 2; }
    __device__ __forceinline__ const char* b_tile(const Unit& u) const { return B0 + (long)u.z * dB + (size_t)u.pn * 256 * K * 2; }
};
struct MoeSched {
    const char* A; const char* Bt; int K; size_t bstride; int ntiles, G, c; const LAS int* tile_e;
    __device__ __forceinline__ bool next(int i, Unit& u) const { const long L = (long)i * G + c; const int t = (int)(L >> 2); if (t >= ntiles) return false;
        u.pm = t; u.pn = (int)(L & 3); u.z = __builtin_amdgcn_readfirstlane(tile_e[t]); return true; }
    __device__ __forceinline__ const char* a_tile(const Unit& u) const { return A + (size_t)u.pm * 256 * K * 2; }
    __device__ __forceinline__ const char* b_tile(const Unit& u) const { return Bt + (size_t)u.z * bstride + (size_t)u.pn * 256 * K * 2; }
};
}
using pg8::Unit;

#define EPI_ROWS(u, wr, fr) const int row0_ = (u).pm * 256 + (wr) * 64 + (fr);
#define EPI_V8(v, acc, ai, bj, m) float v[8] = {acc[ai][bj][m][0][0], acc[ai][bj][m][0][1], acc[ai][bj][m][0][2], acc[ai][bj][m][0][3], acc[ai][bj][m][1][0], acc[ai][bj][m][1][1], acc[ai][bj][m][1][2], acc[ai][bj][m][1][3]}
__device__ __forceinline__ void store8_bf16(bf16_t* p, const float (&v)[8]) {
    u32x4 w; w.x = cvt_pk_bf16(v[0], v[1]); w.y = cvt_pk_bf16(v[2], v[3]); w.z = cvt_pk_bf16(v[4], v[5]); w.w = cvt_pk_bf16(v[6], v[7]);
    *(u32x4*)p = w;
}
__device__ __forceinline__ void rope8(float (&v)[8], int pos, int g, int fq, const LAS float* T) {
    const int p = g ? (pos & 63) : (pos >> 6);
    const LAS f32x4* t = (const LAS f32x4*)(T + p * 32 + (fq & 1) * 16);
    const f32x4 t0 = t[0], t1 = t[1], t2 = t[2], t3 = t[3];
    const float cs[8] = {t0[0], t0[2], t1[0], t1[2], t2[0], t2[2], t3[0], t3[2]};
    const float sn[8] = {t0[1], t0[3], t1[1], t1[3], t2[1], t2[3], t3[1], t3[3]};
    const bool lo = fq < 2;
#pragma unroll
    for (int i = 0; i < 8; ++i) { const float pv = xchg32(v[i], lo); v[i] = lo ? (v[i] * cs[i] - pv * sn[i]) : (v[i] * cs[i] + pv * sn[i]); }
}

struct EpiG1 {
    unsigned char* ws; const LAS float* rope;
    __device__ __forceinline__ void operator()(const f32x4 (&acc)[2][2][4][2], const Unit& u, int wr, int wc, int fr, int fq) const {
        EPI_ROWS(u, wr, fr)
        bf16_t* const qda = (bf16_t*)(ws + WS_QDA); bf16_t* const kda = (bf16_t*)(ws + WS_KDA); bf16_t* const vda = (bf16_t*)(ws + WS_VDA); bf16_t* const gates = (bf16_t*)(ws + WS_GATES);
        bf16_t* const cq = (bf16_t*)(ws + WS_CQ); bf16_t* const ckv = (bf16_t*)(ws + WS_CKV); bf16_t* const kr = (bf16_t*)(ws + WS_KR); float* const rowsq = (float*)(ws + WS_ROWSQ);
        const int pn = u.pn; const bool xrows = u.pm < (MX / 256);
        if (pn < 4) {
            bf16_t* dst = pn < 2 ? qda : kda; const int cb = (pn & 1) * 256 + wc * 32 + 8 * fq;
#pragma unroll
            for (int ai = 0; ai < 2; ++ai)
#pragma unroll
                for (int m = 0; m < 4; ++m) { const int row = row0_ + ai * 128 + m * 16;
#pragma unroll
                    for (int bj = 0; bj < 2; ++bj) { EPI_V8(v, acc, ai, bj, m); if (xrows) rope8(v, row & 4095, wc & 1, fq, rope); store8_bf16(dst + (size_t)row * 512 + cb + bj * 128, v); } }
        } else if (pn < 6) {
            const int cb = (pn - 4) * 256 + wc * 32 + 8 * fq;
#pragma unroll
            for (int ai = 0; ai < 2; ++ai)
#pragma unroll
                for (int m = 0; m < 4; ++m) { const int row = row0_ + ai * 128 + m * 16;
#pragma unroll
                    for (int bj = 0; bj < 2; ++bj) { EPI_V8(v, acc, ai, bj, m); store8_bf16(vda + (size_t)row * 512 + cb + bj * 128, v); } }
        } else if (pn < 14) {
            const int cb = (pn - 6) * 256 + wc * 32 + 8 * fq;
#pragma unroll
            for (int ai = 0; ai < 2; ++ai)
#pragma unroll
                for (int m = 0; m < 4; ++m) { const int row = row0_ + ai * 128 + m * 16;
#pragma unroll
                    for (int bj = 0; bj < 2; ++bj) { EPI_V8(v, acc, ai, bj, m);
#pragma unroll
                        for (int i = 0; i < 8; ++i) v[i] = sigmoidf_(v[i]);
                        store8_bf16(gates + (size_t)row * 2048 + cb + bj * 128, v); } }
        } else if (pn == 14) {
            const int cb = wc * 32 + 8 * fq;
#pragma unroll
            for (int ai = 0; ai < 2; ++ai)
#pragma unroll
                for (int m = 0; m < 4; ++m) { const int row = row0_ + ai * 128 + m * 16; float ss = 0.f;
#pragma unroll
                    for (int bj = 0; bj < 2; ++bj) { EPI_V8(v, acc, ai, bj, m);
#pragma unroll
                        for (int i = 0; i < 8; ++i) ss += v[i] * v[i];
                        store8_bf16(cq + (size_t)row * 384 + cb + bj * 128, v); }
                    ss += shx(ss, 16, fq * 16 + fr); ss += shx(ss, 32, fq * 16 + fr);
                    if (fq == 0) rowsq[(size_t)row * 12 + wc] = ss; }
        } else if (pn == 15) {
            const int cb = wc * 32 + 8 * fq;
#pragma unroll
            for (int ai = 0; ai < 2; ++ai)
#pragma unroll
                for (int m = 0; m < 4; ++m) { const int row = row0_ + ai * 128 + m * 16; float ss = 0.f;
                    { EPI_V8(v, acc, ai, 0, m);
#pragma unroll
                        for (int i = 0; i < 8; ++i) ss += v[i] * v[i];
                        store8_bf16(cq + (size_t)row * 384 + 256 + cb, v); }
                    ss += shx(ss, 16, fq * 16 + fr); ss += shx(ss, 32, fq * 16 + fr);
                    if (fq == 0) rowsq[(size_t)row * 12 + 4 + wc] = ss;
                    if (wc < 2) { EPI_V8(v, acc, ai, 1, m); if (xrows) rope8(v, row & 4095, wc, fq, rope); store8_bf16(kr + (size_t)row * 64 + cb, v); } }
        } else {
            const int cb = wc * 32 + 8 * fq;
#pragma unroll
            for (int ai = 0; ai < 2; ++ai)
#pragma unroll
                for (int m = 0; m < 4; ++m) { const int row = row0_ + ai * 128 + m * 16; float ss = 0.f;
#pragma unroll
                    for (int bj = 0; bj < 2; ++bj) { EPI_V8(v, acc, ai, bj, m);
#pragma unroll
                        for (int i = 0; i < 8; ++i) ss += v[i] * v[i];
                        store8_bf16(ckv + (size_t)row * 256 + cb + bj * 128, v); }
                    ss += shx(ss, 16, fq * 16 + fr); ss += shx(ss, 32, fq * 16 + fr);
                    if (fq == 0) rowsq[(size_t)row * 12 + 8 + wc] = ss; }
        }
    }
};
struct EpiQMla {
    unsigned char* ws; const LAS float* rope;
    __device__ __forceinline__ void operator()(const f32x4 (&acc)[2][2][4][2], const Unit& u, int wr, int wc, int fr, int fq) const {
        EPI_ROWS(u, wr, fr)
        bf16_t* const qmla = (bf16_t*)(ws + WS_QMLA); const float* const rowsq = (const float*)(ws + WS_ROWSQ);
        const bool xrows = u.pm < (MX / 256);
#pragma unroll
        for (int ai = 0; ai < 2; ++ai)
#pragma unroll
            for (int m = 0; m < 4; ++m) { const int row = row0_ + ai * 128 + m * 16;
                const f32x4 q0_ = *(const f32x4*)(rowsq + (size_t)row * 12), q1_ = *(const f32x4*)(rowsq + (size_t)row * 12 + 4);
                const float sc = rsqrtf((((q0_[0] + q0_[1]) + (q0_[2] + q0_[3])) + ((q1_[0] + q1_[1]) + (q1_[2] + q1_[3]))) * (1.0f / 384.0f) + EPS);
#pragma unroll
                for (int bj = 0; bj < 2; ++bj) { const int g32 = u.pn * 8 + bj * 4 + wc, j = g32 % 6;
                    EPI_V8(v, acc, ai, bj, m);
#pragma unroll
                    for (int i = 0; i < 8; ++i) v[i] *= sc;
                    if (xrows && j >= 4) rope8(v, row & 4095, j - 4, fq, rope);
                    store8_bf16(qmla + (size_t)row * 768 + g32 * 32 + 8 * fq, v); } }
    }
};
struct EpiKvMla {
    unsigned char* ws;
    __device__ __forceinline__ void operator()(const f32x4 (&acc)[2][2][4][2], const Unit& u, int wr, int wc, int fr, int fq) const {
        EPI_ROWS(u, wr, fr)
        bf16_t* const kvmla = (bf16_t*)(ws + WS_KVMLA); const float* const rowsq = (const float*)(ws + WS_ROWSQ);
        const int cb = u.pn * 256 + wc * 32 + 8 * fq;
#pragma unroll
        for (int ai = 0; ai < 2; ++ai)
#pragma unroll
            for (int m = 0; m < 4; ++m) { const int row = row0_ + ai * 128 + m * 16;
                const f32x4 q2_ = *(const f32x4*)(rowsq + (size_t)row * 12 + 8);
                const float sc = rsqrtf(((q2_[0] + q2_[1]) + (q2_[2] + q2_[3])) * (1.0f / 256.0f) + EPS);
#pragma unroll
                for (int bj = 0; bj < 2; ++bj) { EPI_V8(v, acc, ai, bj, m);
#pragma unroll
                    for (int i = 0; i < 8; ++i) v[i] *= sc;
                    store8_bf16(kvmla + (size_t)row * 1024 + cb + bj * 128, v); } }
    }
};
struct EpiBranch {
    unsigned char* ws;
    __device__ __forceinline__ void operator()(const f32x4 (&acc)[2][2][4][2], const Unit& u, int wr, int wc, int fr, int fq) const {
        EPI_ROWS(u, wr, fr)
        bf16_t* const U = (bf16_t*)(ws + WS_U); const bf16_t* const gates = (const bf16_t*)(ws + WS_GATES);
        const int cb = u.pn * 256 + wc * 32 + 8 * fq;
#pragma unroll
        for (int ai = 0; ai < 2; ++ai)
#pragma unroll
            for (int m = 0; m < 4; ++m) { const int row = row0_ + ai * 128 + m * 16;
#pragma unroll
                for (int bj = 0; bj < 2; ++bj) { const int col = cb + bj * 128; EPI_V8(v, acc, ai, bj, m);
                    const u32x4 g = *(const u32x4*)(gates + (size_t)row * 2048 + (u.z ? 1024 : 0) + col);
                    const float gv[8] = {bf_lo(g.x), bf_hi(g.x), bf_lo(g.y), bf_hi(g.y), bf_lo(g.z), bf_hi(g.z), bf_lo(g.w), bf_hi(g.w)};
                    bf16_t* up = U + (size_t)row * 1024 + col;
                    if (u.z) { const u32x4 o = *(const u32x4*)up; const float ov[8] = {bf_lo(o.x), bf_hi(o.x), bf_lo(o.y), bf_hi(o.y), bf_lo(o.z), bf_hi(o.z), bf_lo(o.w), bf_hi(o.w)};
#pragma unroll
                        for (int i = 0; i < 8; ++i) v[i] = ov[i] + gv[i] * v[i]; }
                    else {
#pragma unroll
                        for (int i = 0; i < 8; ++i) v[i] = gv[i] * v[i]; }
                    store8_bf16(up, v); } }
    }
};
struct EpiOut {
    float* XS; const float* xin; const float* ctx; const float* mod_l; int first;
    __device__ __forceinline__ void operator()(const f32x4 (&acc)[2][2][4][2], const Unit& u, int wr, int wc, int fr, int fq) const {
        EPI_ROWS(u, wr, fr)
        const int cb = u.pn * 256 + wc * 32 + 8 * fq;
        const bool xrows = u.pm < (MX / 256);
        const int bidx = xrows ? (u.pm >> 4) : 8;
        const float* g1 = mod_l + (size_t)bidx * 6144 + 2048;
        const float* base = first ? (xrows ? xin : ctx - (size_t)MX * 1024) : XS;
#pragma unroll
        for (int bj = 0; bj < 2; ++bj) { const int col = cb + bj * 128;
            const f32x4 ga = *(const f32x4*)(g1 + col), gb = *(const f32x4*)(g1 + col + 4);
#pragma unroll
            for (int ai = 0; ai < 2; ++ai)
#pragma unroll
                for (int m = 0; m < 4; ++m) { const size_t off = (size_t)(row0_ + ai * 128 + m * 16) * 1024 + col;
                    const f32x4 b0 = *(const f32x4*)(base + off), b1 = *(const f32x4*)(base + off + 4);
                    *(f32x4*)(XS + off) = b0 + ga * acc[ai][bj][m][0]; *(f32x4*)(XS + off + 4) = b1 + gb * acc[ai][bj][m][1]; } }
    }
};
struct EpiUp {
    bf16_t* act; const float* bgu;
    __device__ __forceinline__ void operator()(const f32x4 (&acc)[2][2][4][2], const Unit& u, int wr, int wc, int fr, int fq) const {
        EPI_ROWS(u, wr, fr)
        const int j0 = u.pn * 128 + wc * 32 + 8 * fq;
        const float* bg = bgu + (size_t)u.z * 1024 + j0;
        const f32x4 g0 = *(const f32x4*)bg, g1 = *(const f32x4*)(bg + 4), l0 = *(const f32x4*)(bg + 512), l1 = *(const f32x4*)(bg + 516);
        const float bgv[8] = {g0[0], g0[1], g0[2], g0[3], g1[0], g1[1], g1[2], g1[3]}, blv[8] = {l0[0], l0[1], l0[2], l0[3], l1[0], l1[1], l1[2], l1[3]};
#pragma unroll
        for (int ai = 0; ai < 2; ++ai)
#pragma unroll
            for (int m = 0; m < 4; ++m) { const int row = row0_ + ai * 128 + m * 16;
                EPI_V8(gt, acc, ai, 0, m); EPI_V8(ln, acc, ai, 1, m); float o[8];
#pragma unroll
                for (int i = 0; i < 8; ++i) { const float g = fminf(gt[i] + bgv[i], 7.0f); const float li = fminf(fmaxf(ln[i] + blv[i], -7.0f), 7.0f);
                    o[i] = (li + 1.0f) * g * sigmoidf_(1.702f * g); }
                store8_bf16(act + (size_t)row * 512 + j0, o); }
    }
};
struct EpiDown {
    bf16_t* Y; const float* bdn;
    __device__ __forceinline__ void operator()(const f32x4 (&acc)[2][2][4][2], const Unit& u, int wr, int wc, int fr, int fq) const {
        EPI_ROWS(u, wr, fr)
        const int cb = u.pn * 256 + wc * 32 + 8 * fq;
#pragma unroll
        for (int bj = 0; bj < 2; ++bj) { const int col = cb + bj * 128; const float* bp = bdn + (size_t)u.z * 1024 + col;
            const f32x4 b0 = *(const f32x4*)bp, b1 = *(const f32x4*)(bp + 4);
#pragma unroll
            for (int ai = 0; ai < 2; ++ai)
#pragma unroll
                for (int m = 0; m < 4; ++m) { const int row = row0_ + ai * 128 + m * 16;
                    const f32x4 a0 = acc[ai][bj][m][0] + b0, a1 = acc[ai][bj][m][1] + b1;
                    const float v[8] = {a0[0], a0[1], a0[2], a0[3], a1[0], a1[1], a1[2], a1[3]};
                    store8_bf16(Y + (size_t)row * 1024 + col, v); } }
    }
};

namespace att {
constexpr int NW = 8, QBLK = 32, KVBLK = 64;
constexpr int SHM_V = 16384, SHM_KR = 8192, SHM_KN = 16384;
constexpr int OFF_V = 0, OFF_KR = 2 * SHM_V, OFF_KN = OFF_KR + 2 * SHM_KR, OFF_WS = OFF_KN + 2 * SHM_KN;
constexpr float THR = 8.f;
#define KSWZN(row, colB) ((row) * 256 + ((colB) ^ (((row) & 15) << 4)))
#define KSWZR(row, colB) ((row) * 128 + ((colB) ^ ((((row) >> 1) & 7) << 4)))
#define SBAR() __builtin_amdgcn_sched_barrier(0)
__device__ __forceinline__ int crow(int r, int hi) { return (r & 3) + 8 * (r >> 2) + 4 * hi; }
template <int DN> struct SC { static constexpr float SCALE = DN ? 0.07216878364870322f : 0.125f; };
template <int DN>
__device__ __forceinline__ void partialSM(f32x16& p0, f32x16& p1, float& m_reg, float& mn, float& alpha) {
    constexpr float SCALE = SC<DN>::SCALE, C = SCALE * 1.4426950408889634f;
    float pmax = p0[0];
#pragma unroll
    for (int r = 1; r < 16; ++r) pmax = fmaxf(pmax, p0[r]);
#pragma unroll
    for (int r = 0; r < 16; ++r) pmax = fmaxf(pmax, p1[r]);
    { auto rr = __builtin_amdgcn_permlane32_swap(__float_as_uint(pmax), __float_as_uint(pmax), false, false);
      pmax = fmaxf(__uint_as_float(rr[0]), __uint_as_float(rr[1])); }
    if (__builtin_expect(__all(pmax - m_reg <= THR / SCALE), 1)) { mn = m_reg; alpha = 1.f; }
    else { mn = fmaxf(m_reg, pmax); alpha = __builtin_amdgcn_exp2f((m_reg - mn) * C); m_reg = mn; }
    const float mnC = -mn * C;
#pragma unroll
    for (int r = 0; r < 16; ++r) p0[r] = fmaf(p0[r], C, mnC);
#pragma unroll
    for (int r = 0; r < 16; ++r) p1[r] = fmaf(p1[r], C, mnC);
#pragma unroll
    for (int r = 0; r < 16; ++r) p0[r] = __builtin_amdgcn_exp2f(p0[r]);
}
__device__ __forceinline__ void finishSM(f32x16& p0, f32x16& p1, float alpha, float& l_reg, bf16x8& pa0, bf16x8& pa1, bf16x8& pa2, bf16x8& pa3) {
#pragma unroll
    for (int r = 0; r < 16; ++r) p1[r] = __builtin_amdgcn_exp2f(p1[r]);
    float ps = 0;
#pragma unroll
    for (int r = 0; r < 16; ++r) ps += p0[r];
#pragma unroll
    for (int r = 0; r < 16; ++r) ps += p1[r];
    { auto rr = __builtin_amdgcn_permlane32_swap(__float_as_uint(ps), __float_as_uint(ps), false, false);
      ps = __uint_as_float(rr[0]) + __uint_as_float(rr[1]); }
    l_reg = l_reg * alpha + ps;
#define PK4(P, BASE, OUT) do { unsigned a0 = cvt_pk_bf16(P[BASE + 0], P[BASE + 1]), a1 = cvt_pk_bf16(P[BASE + 2], P[BASE + 3]);   \
    unsigned b0 = cvt_pk_bf16(P[BASE + 4], P[BASE + 5]), b1 = cvt_pk_bf16(P[BASE + 6], P[BASE + 7]);                              \
    auto r0 = __builtin_amdgcn_permlane32_swap(a0, b0, false, false); auto r1 = __builtin_amdgcn_permlane32_swap(a1, b1, false, false); \
    u32x4 w = {r0[0], r1[0], r0[1], r1[1]}; OUT = *reinterpret_cast<bf16x8*>(&w); } while (0)
    PK4(p0, 0, pa0); PK4(p0, 8, pa1); PK4(p1, 0, pa2); PK4(p1, 8, pa3);
#undef PK4
}
template <int DN>
__device__ __forceinline__ void qkt(f32x16& p0, f32x16& p1, const char* Kn, const char* Kr, const bf16x8* qn, const bf16x8* qr, int r32, int hi) {
    p0 = f32x16{}; p1 = f32x16{};
    if constexpr (DN > 0) {
#pragma unroll
        for (int d0 = 0; d0 < DN / 16; ++d0) { const int cb = d0 * 32 + hi * 16;
            const bf16x8 b0 = *reinterpret_cast<const bf16x8*>(Kn + KSWZN(r32, cb));
            const bf16x8 b1 = *reinterpret_cast<const bf16x8*>(Kn + KSWZN(32 + r32, cb));
            p0 = __builtin_amdgcn_mfma_f32_32x32x16_bf16(b0, qn[d0], p0, 0, 0, 0);
            p1 = __builtin_amdgcn_mfma_f32_32x32x16_bf16(b1, qn[d0], p1, 0, 0, 0); }
    }
#pragma unroll
    for (int d0 = 0; d0 < 4; ++d0) { const int cb = d0 * 32 + hi * 16;
        const bf16x8 b0 = *reinterpret_cast<const bf16x8*>(Kr + KSWZR(r32, cb));
        const bf16x8 b1 = *reinterpret_cast<const bf16x8*>(Kr + KSWZR(32 + r32, cb));
        p0 = __builtin_amdgcn_mfma_f32_32x32x16_bf16(b0, qr[d0], p0, 0, 0, 0);
        p1 = __builtin_amdgcn_mfma_f32_32x32x16_bf16(b1, qr[d0], p1, 0, 0, 0); }
}
__device__ __forceinline__ int v_st(int k, int c) { const int kk = (k & ~0xC) | ((k & 4) << 1) | ((k & 8) >> 1); return ((kk >> 3) * 4 + (c >> 5)) * 512 + ((kk & 7) * 32 + (c & 31)) * 2; }
__device__ __forceinline__ int v_rd_base(int lane) { return ((lane & 3) << 3) | (((lane >> 2) & 3) << 6) | (((lane >> 4) & 1) << 5) | (((lane >> 5) & 1) << 8); }
constexpr int v_rd_off(int d0, int ks, int half) { return d0 * 512 + ks * 4096 + half * 2048; }
template <int OFF> __device__ __forceinline__ s16x4 tr_read(int vb) {
    s16x4 r; asm volatile("ds_read_b64_tr_b16 %0, %1 offset:%2" : "=&v"(r) : "v"(vb), "i"(OFF) : "memory"); return r;
}
template <int D0> __device__ __forceinline__ void pv_one(f32x16& od, int vb, bf16x8 pa0, bf16x8 pa1, bf16x8 pa2, bf16x8 pa3) {
    const s16x4 l0 = tr_read<v_rd_off(D0, 0, 0)>(vb), h0 = tr_read<v_rd_off(D0, 0, 1)>(vb), l1 = tr_read<v_rd_off(D0, 1, 0)>(vb), h1 = tr_read<v_rd_off(D0, 1, 1)>(vb);
    const s16x4 l2 = tr_read<v_rd_off(D0, 2, 0)>(vb), h2 = tr_read<v_rd_off(D0, 2, 1)>(vb), l3 = tr_read<v_rd_off(D0, 3, 0)>(vb), h3 = tr_read<v_rd_off(D0, 3, 1)>(vb);
    asm volatile("s_waitcnt lgkmcnt(0)" ::: "memory"); SBAR();
#define PK(L, H) (bf16x8){L[0], L[1], L[2], L[3], H[0], H[1], H[2], H[3]}
    od = __builtin_amdgcn_mfma_f32_32x32x16_bf16(pa0, PK(l0, h0), od, 0, 0, 0);
    od = __builtin_amdgcn_mfma_f32_32x32x16_bf16(pa1, PK(l1, h1), od, 0, 0, 0);
    od = __builtin_amdgcn_mfma_f32_32x32x16_bf16(pa2, PK(l2, h2), od, 0, 0, 0);
    od = __builtin_amdgcn_mfma_f32_32x32x16_bf16(pa3, PK(l3, h3), od, 0, 0, 0);
#undef PK
}
__device__ __forceinline__ void pv_d0(f32x16* o, int vb, bf16x8 pa0, bf16x8 pa1, bf16x8 pa2, bf16x8 pa3) {
    pv_one<0>(o[0], vb, pa0, pa1, pa2, pa3); pv_one<1>(o[1], vb, pa0, pa1, pa2, pa3); pv_one<2>(o[2], vb, pa0, pa1, pa2, pa3); pv_one<3>(o[3], vb, pa0, pa1, pa2, pa3);
}
template <int DN, int LDQ, int LDKN, int LDKR, int LDV, int LDO, int SDEPTH>
__device__ __forceinline__ void attn_unit(const bf16_t* __restrict__ Qn, const bf16_t* __restrict__ Qr, const bf16_t* __restrict__ Kng, const bf16_t* __restrict__ Krg,
                                          const bf16_t* __restrict__ Vg, bf16_t* __restrict__ Ob, const int q0, const int kx0, const int ky0, const int ntx, const int NT, char* lds) {
    const int tid = opaque_tid(), wid = tid >> 6, lane = tid & 63, r32 = lane & 31, hi = lane >> 5;
    char* V_lds = lds + OFF_V; char* KR_lds = lds + OFF_KR; char* KN_lds = lds + OFF_KN;
    float* ws = (float*)(lds + OFF_WS) + wid * 64; float* li_l = ws; float* al_l = ws + 32;
    float m_reg = -1e30f, l_reg = 0; f32x16 o[4] = {}; bf16x8 qn[DN ? DN / 16 : 1], qr[4];
    { const size_t qrow = (size_t)(q0 + wid * QBLK + r32);
      if constexpr (DN > 0) {
#pragma unroll
          for (int d0 = 0; d0 < DN / 16; ++d0) qn[d0] = *reinterpret_cast<const bf16x8*>(Qn + qrow * LDQ + hi * 8 + d0 * 16);
      }
#pragma unroll
      for (int d0 = 0; d0 < 4; ++d0) qr[d0] = *reinterpret_cast<const bf16x8*>(Qr + qrow * LDQ + hi * 8 + d0 * 16); }
    const int sr = tid >> 4, sc = (tid & 15) * 8, vst0 = v_st(sr, sc), vst1 = v_st(32 + sr, sc);
    const int rr_ = tid >> 3, rc_ = (tid & 7) * 8;
    const int vb0 = (int)(uintptr_t)V_lds + v_rd_base(lane);
    struct { bf16x8 vs0, vs1, kn0, kn1, kr0; } st_[SDEPTH];
#define KROW(j) __builtin_amdgcn_readfirstlane((j) < ntx ? kx0 + (j) * KVBLK : ky0 + ((j) - ntx) * KVBLK)
    const unsigned ovV0 = (unsigned)(sr * LDV + sc) * 2u, ovV1 = (unsigned)((32 + sr) * LDV + sc) * 2u, ovN0 = (unsigned)(sr * LDKN + sc) * 2u, ovN1 = (unsigned)((32 + sr) * LDKN + sc) * 2u, ovR = (unsigned)(rr_ * LDKR + rc_) * 2u;
#define SLOAD(i, j) do { const size_t k0_ = (size_t)KROW(j); const char* vb_ = (const char*)(Vg + k0_ * LDV); const char* rb_ = (const char*)(Krg + k0_ * LDKR); \
    st_[i].vs0 = *reinterpret_cast<const bf16x8*>(vb_ + ovV0); st_[i].vs1 = *reinterpret_cast<const bf16x8*>(vb_ + ovV1); \
    if constexpr (DN > 0) { const char* nb_ = (const char*)(Kng + k0_ * LDKN); st_[i].kn0 = *reinterpret_cast<const bf16x8*>(nb_ + ovN0); st_[i].kn1 = *reinterpret_cast<const bf16x8*>(nb_ + ovN1); } \
    st_[i].kr0 = *reinterpret_cast<const bf16x8*>(rb_ + ovR); } while (0)
#define SWRITE(b, i) do { *(bf16x8*)(V_lds + (b) * SHM_V + vst0) = st_[i].vs0; *(bf16x8*)(V_lds + (b) * SHM_V + vst1) = st_[i].vs1; \
    if constexpr (DN > 0) { *(bf16x8*)(KN_lds + (b) * SHM_KN + KSWZN(sr, sc * 2)) = st_[i].kn0; *(bf16x8*)(KN_lds + (b) * SHM_KN + KSWZN(32 + sr, sc * 2)) = st_[i].kn1; } \
    *(bf16x8*)(KR_lds + (b) * SHM_KR + KSWZR(rr_, rc_ * 2)) = st_[i].kr0; } while (0)
#define SWAIT() do { if constexpr (SDEPTH == 2) { if constexpr (DN > 0) asm volatile("s_waitcnt vmcnt(5)" ::: "memory"); else asm volatile("s_waitcnt vmcnt(3)" ::: "memory"); } else asm volatile("s_waitcnt vmcnt(0)" ::: "memory"); } while (0)
#define RESC(a) do { if (__any((a) < 1.f)) { if (hi == 0) al_l[r32] = (a); asm volatile("s_waitcnt lgkmcnt(0)" ::: "memory"); \
    _Pragma("unroll") for (int d = 0; d < 4; ++d) _Pragma("unroll") for (int r = 0; r < 16; ++r) o[d][r] *= al_l[crow(r, hi)]; } } while (0)
    f32x16 pA0, pA1, pB0, pB1; float mnA, mnB, alA, alB; bf16x8 pa0, pa1, pa2, pa3;
    constexpr int SE = 0, SO = SDEPTH - 1;
    SLOAD(SE, 0); asm volatile("s_waitcnt vmcnt(0)" ::: "memory"); SWRITE(0, SE); __syncthreads();
    qkt<DN>(pA0, pA1, KN_lds, KR_lds, qn, qr, r32, hi); partialSM<DN>(pA0, pA1, m_reg, mnA, alA);
    SLOAD(SO, 1); if constexpr (SDEPTH == 2) { if (2 < NT) SLOAD(SE, 2); }
    SWAIT(); SWRITE(1, SO); __syncthreads();
    for (int j = 1; j + 1 < NT; j += 2) {
        SBAR(); qkt<DN>(pB0, pB1, KN_lds + SHM_KN, KR_lds + SHM_KR, qn, qr, r32, hi);
        finishSM(pA0, pA1, alA, l_reg, pa0, pa1, pa2, pa3); SBAR();
        SLOAD(SO, j + SDEPTH); SBAR();
        pv_d0(o, vb0, pa0, pa1, pa2, pa3); partialSM<DN>(pB0, pB1, m_reg, mnB, alB);
        __syncthreads(); SWAIT(); SWRITE(0, SE);
        RESC(alB); __syncthreads();
        SBAR(); qkt<DN>(pA0, pA1, KN_lds, KR_lds, qn, qr, r32, hi);
        finishSM(pB0, pB1, alB, l_reg, pa0, pa1, pa2, pa3); SBAR();
        if (SDEPTH == 1 || j + 3 < NT) SLOAD(SE, j + 1 + SDEPTH); SBAR();
        pv_d0(o, vb0 + SHM_V, pa0, pa1, pa2, pa3); partialSM<DN>(pA0, pA1, m_reg, mnA, alA);
        __syncthreads(); SWAIT(); SWRITE(1, SO);
        RESC(alA); __syncthreads();
    }
    SBAR(); qkt<DN>(pB0, pB1, KN_lds + SHM_KN, KR_lds + SHM_KR, qn, qr, r32, hi);
    finishSM(pA0, pA1, alA, l_reg, pa0, pa1, pa2, pa3); SBAR();
    pv_d0(o, vb0, pa0, pa1, pa2, pa3); partialSM<DN>(pB0, pB1, m_reg, mnB, alB);
    __syncthreads(); RESC(alB);
    finishSM(pB0, pB1, alB, l_reg, pa0, pa1, pa2, pa3); SBAR();
    pv_d0(o, vb0 + SHM_V, pa0, pa1, pa2, pa3);
    if (hi == 0) li_l[r32] = l_reg; asm volatile("s_waitcnt lgkmcnt(0)" ::: "memory");
    const int tz = opaque_tid(), wid2 = tz >> 6, r32b = tz & 31, hib = (tz >> 5) & 1;
    const float* li2 = (const float*)(lds + OFF_WS) + wid2 * 64;
    float rli[16];
#pragma unroll
    for (int r = 0; r < 16; ++r) rli[r] = __builtin_amdgcn_rcpf(li2[crow(r, hib)]);
    bf16_t* Ow = Ob + (size_t)(q0 + wid2 * QBLK) * LDO;
#pragma unroll
    for (int r = 0; r < 16; ++r) { const int orow = crow(r, hib);
#pragma unroll
        for (int d0 = 0; d0 < 4; ++d0) { const unsigned w = cvt_pk_bf16(o[d0][r] * rli[r], 0.f); Ow[(size_t)orow * LDO + d0 * 32 + r32b] = (bf16_t)(w & 0xffffu); } }
    __syncthreads();
#undef KROW
#undef SLOAD
#undef SWRITE
#undef SWAIT
#undef RESC
}
}

struct Params { const float* in[28]; float* out; unsigned char* ws; int ph_lo, ph_hi; };
struct Ctx { LAS unsigned char* lds; char* ldsg; int tid, lane, wave, vcu, G; unsigned char* ws; };
enum { I_X = 0, I_C, I_CTX, I_CCTX, I_ADAW, I_ADAB, I_N1G, I_N2G, I_WIN, I_LQ1, I_LK1, I_LQ2, I_LK2, I_SUBLN, I_QAG, I_KVAG, I_WQB, I_WKVB, I_WBRA, I_WBRB, I_WOUT, I_RW, I_RB, I_WGU, I_BGU, I_WDN, I_BDN, I_FG };
template <typename T> __device__ __forceinline__ T* wsp(const Ctx& C, size_t off) { return (T*)(C.ws + off); }
constexpr int PTRTAB_OFF = MISC_OFF + 3072;
__device__ __forceinline__ const float* inp(const Ctx& C, int i) {
    const unsigned long long v = ((volatile LAS unsigned long long*)(C.lds + PTRTAB_OFF))[i];
    const unsigned lo = __builtin_amdgcn_readfirstlane((unsigned)v), hi = __builtin_amdgcn_readfirstlane((unsigned)(v >> 32));
    return (const float*)(((unsigned long long)hi << 32) | lo);
}

__device__ __forceinline__ void p0_transpose_item(const float* W, int K, int N, bf16_t* WT, int k0, int n0d, int n0s, const float* gain, LAS float* scr, int lane) {
#pragma unroll 8
    for (int i = 0; i < 32; ++i) { const int kk = 2 * i + (lane >> 5); float w = 0.f;
        if (n0s >= 0) { w = W[(size_t)(k0 + kk) * N + n0s + (lane & 31)]; if (gain) w *= gain[k0 + kk]; }
        scr[kk * 33 + (lane & 31)] = w; }
    LDS_WAIT(); asm volatile("" ::: "memory");
    const int c = lane & 7;
#pragma unroll
    for (int j = 0; j < 4; ++j) { const int n = (lane >> 3) + 8 * j; const LAS float* s = scr + (8 * c) * 33 + n;
        u32x4 o; o.x = cvt_pk_bf16(s[0 * 33], s[1 * 33]); o.y = cvt_pk_bf16(s[2 * 33], s[3 * 33]); o.z = cvt_pk_bf16(s[4 * 33], s[5 * 33]); o.w = cvt_pk_bf16(s[6 * 33], s[7 * 33]);
        *(u32x4*)(WT + (size_t)(n0d + n) * K + k0 + 8 * c) = o; }
    LDS_WAIT(); asm volatile("" ::: "memory");
}
__device__ __forceinline__ int win_src_col(int n) {
    if (n < 1536) return n; if (n < 3584) return 2240 + (n - 1536); if (n < 3968) return 1536 + (n - 3584);
    if (n < 4032) return 2176 + (n - 3968); if (n < 4096) return -1; return 1920 + (n - 4096);
}
__device__ __forceinline__ void phase_prologue(const Params& P, const Ctx& C0) {
    Ctx C = C0; { const int t_ = opaque_tid(); C.tid = t_; C.lane = t_ & 63; C.wave = __builtin_amdgcn_readfirstlane(t_ >> 6); asm volatile("" : "+s"(C.ws)); asm volatile("" : "+s"(C.vcu)); asm volatile("" : "+s"(C.G)); }
    LAS float* scr = (LAS float*)(C.lds + C.wave * 8448);
    const int gw = C.vcu * 8 + C.wave, NGW = C.G * 8;
    constexpr int I_IN = 16 * (NIN / 32), I_QB = 6 * 24, I_KVB = 4 * 32, I_BR = 8 * 32, I_OUT = 16 * 32, I_GU = 32 * 16 * 32, I_DN = 32 * 8 * 32;
    constexpr int PER_L = I_IN + I_QB + I_KVB + 2 * I_BR + I_OUT + I_GU + I_DN;
    for (int it = gw; it < DEPTH * PER_L; it += NGW) {
        const int l = it / PER_L; int r = it % PER_L;
        if (r < I_IN) { const int nb = r % (NIN / 32), kb = r / (NIN / 32);
            p0_transpose_item(inp(C, I_WIN) + (size_t)l * 1024 * 4288, 1024, 4288, wsp<bf16_t>(C, WS_WIN) + (size_t)l * NIN * 1024, kb * 64, nb * 32, win_src_col(nb * 32), nullptr, scr, C.lane); continue; } r -= I_IN;
        if (r < I_QB) { const int nb = r % 24, kb = r / 24;
            p0_transpose_item(inp(C, I_WQB) + (size_t)l * 384 * 768, 384, 768, wsp<bf16_t>(C, WS_WQB) + (size_t)l * 768 * 384, kb * 64, nb * 32, nb * 32, inp(C, I_QAG) + l * 384, scr, C.lane); continue; } r -= I_QB;
        if (r < I_KVB) { const int nb = r % 32, kb = r / 32;
            p0_transpose_item(inp(C, I_WKVB) + (size_t)l * 256 * 1024, 256, 1024, wsp<bf16_t>(C, WS_WKVB) + (size_t)l * 1024 * 256, kb * 64, nb * 32, nb * 32, inp(C, I_KVAG) + l * 256, scr, C.lane); continue; } r -= I_KVB;
        if (r < I_BR) { const int nb = r % 32, kb = r / 32;
            p0_transpose_item(inp(C, I_WBRA) + (size_t)l * 512 * 1024, 512, 1024, wsp<bf16_t>(C, WS_WBRA) + (size_t)l * 1024 * 512, kb * 64, nb * 32, nb * 32, nullptr, scr, C.lane); continue; } r -= I_BR;
        if (r < I_BR) { const int nb = r % 32, kb = r / 32;
            p0_transpose_item(inp(C, I_WBRB) + (size_t)l * 512 * 1024, 512, 1024, wsp<bf16_t>(C, WS_WBRB) + (size_t)l * 1024 * 512, kb * 64, nb * 32, nb * 32, nullptr, scr, C.lane); continue; } r -= I_BR;
        if (r < I_OUT) { const int nb = r % 32, kb = r / 32;
            p0_transpose_item(inp(C, I_WOUT) + (size_t)l * 1024 * 1024, 1024, 1024, wsp<bf16_t>(C, WS_WOUT) + (size_t)l * 1024 * 1024, kb * 64, nb * 32, nb * 32, nullptr, scr, C.lane); continue; } r -= I_OUT;
        if (r < I_GU) { const int e = r / 512, q = r % 512, nb = q % 32, kb = q / 32; const int n0 = nb * 32;
            const int src = 512 * ((n0 >> 7) & 1) + 128 * (n0 >> 8) + (n0 & 127);
            p0_transpose_item(inp(C, I_WGU) + ((size_t)l * 32 + e) * 1024 * 1024, 1024, 1024, wsp<bf16_t>(C, WS_WGU) + ((size_t)l * 32 + e) * 1024 * 1024, kb * 64, n0, src, nullptr, scr, C.lane); continue; } r -= I_GU;
        { const int e = r / 256, q = r % 256, nb = q % 32, kb = q / 32;
            p0_transpose_item(inp(C, I_WDN) + ((size_t)l * 32 + e) * 512 * 1024, 512, 1024, wsp<bf16_t>(C, WS_WDN) + ((size_t)l * 32 + e) * 1024 * 512, kb * 64, nb * 32, nb * 32, nullptr, scr, C.lane); }
    }
    { float* rwt = wsp<float>(C, WS_RWT); const float* rw = inp(C, I_RW);
      for (int i = C.vcu * 512 + C.tid; i < DEPTH * 32 * 1024; i += C.G * 512) { const int l = i >> 15, e = (i >> 10) & 31, d = i & 1023; rwt[i] = rw[((size_t)l * 1024 + d) * 32 + e]; }
 }
    __syncthreads();
    { LAS float* s = (LAS float*)(C.lds + 69632); LAS float* red = (LAS float*)(C.lds + 106496);
      const float* const cc = inp(C, I_C); const float* const cx = inp(C, I_CCTX);
      for (int i = C.tid; i < 9 * 1024; i += 512) { const float v = i < 8192 ? cc[i] : cx[i - 8192]; s[i] = v / (1.0f + __expf(-v)); }
      __syncthreads();
      const int cl = C.tid & 31, kg = C.tid >> 5; float* MOD = wsp<float>(C, WS_MOD); const float* const adaw = inp(C, I_ADAW); const float* const adab = inp(C, I_ADAB);
      for (int blk = C.vcu; blk < DEPTH * 192; blk += C.G) { const int l = blk / 192, col = (blk % 192) * 32 + cl;
          const float* w = adaw + (size_t)l * 1024 * 6144 + col; float a[9];
#pragma unroll
          for (int r = 0; r < 9; ++r) a[r] = 0.f;
          for (int kk = 0; kk < 64; ++kk) { const int k = kg * 64 + kk; const float wv = w[(size_t)k * 6144];
#pragma unroll
              for (int r = 0; r < 9; ++r) a[r] += s[r * 1024 + k] * wv; }
#pragma unroll
          for (int r = 0; r < 9; ++r) red[(kg * 32 + cl) * 9 + r] = a[r];
          __syncthreads();
          if (C.tid < 288) { const int c2 = C.tid & 31, r = C.tid >> 5; float t = 0.f;
              for (int g = 0; g < 16; ++g) t += red[(g * 32 + c2) * 9 + r];
              const int col2 = (blk % 192) * 32 + c2; MOD[((size_t)l * 9 + r) * 6144 + col2] = t + adab[(size_t)l * 6144 + col2]; }
          __syncthreads(); } }
}

__device__ __forceinline__ void phase_mod1(const Params& P, const Ctx& C0, const int l) {
    Ctx C = C0; { const int t_ = opaque_tid(); C.tid = t_; C.lane = t_ & 63; C.wave = __builtin_amdgcn_readfirstlane(t_ >> 6); asm volatile("" : "+s"(C.ws)); asm volatile("" : "+s"(C.vcu)); asm volatile("" : "+s"(C.G)); }
    const int gw = C.vcu * 8 + C.wave, NGW = C.G * 8;
    const float* MOD = wsp<float>(C, WS_MOD); float* XS = wsp<float>(C, WS_XS); bf16_t* H = wsp<bf16_t>(C, WS_H);
    const int* YD = wsp<int>(C, WS_YDEST); const float* WT = wsp<float>(C, WS_WTS); const bf16_t* Y = wsp<bf16_t>(C, WS_Y);
    const float* ng = inp(C, I_N1G) + l * 1024; const float* const xin = inp(C, I_X); const float* const cin = inp(C, I_CTX);
    for (int m = gw; m < MT; m += NGW) {
        const int bidx = m < MX ? (m >> 12) : 8;
        const float* src = l == 0 ? (m < MX ? xin + (size_t)m * 1024 : cin + (size_t)(m - MX) * 1024) : XS + (size_t)m * 1024;
        f32x4 v[4];
#pragma unroll
        for (int j = 0; j < 4; ++j) v[j] = ((const f32x4*)src)[C.lane + 64 * j];
        if (l > 0) {
            f32x4 f[4];
#pragma unroll
            for (int j = 0; j < 4; ++j) f[j] = (f32x4){0.f, 0.f, 0.f, 0.f};
#pragma unroll
            for (int k = 0; k < 4; ++k) { const int dst = YD[m * 4 + k]; const float w = WT[m * 4 + k]; const u32x2* yr = (const u32x2*)(Y + (size_t)dst * 1024);
#pragma unroll
                for (int j = 0; j < 4; ++j) { const u32x2 y = yr[C.lane + 64 * j]; f[j] += w * (f32x4){bf_lo(y.x), bf_hi(y.x), bf_lo(y.y), bf_hi(y.y)}; } }
            const float* g2 = MOD + ((size_t)(l - 1) * 9 + bidx) * 6144 + 5 * 1024;
#pragma unroll
            for (int j = 0; j < 4; ++j) { v[j] += ((const f32x4*)g2)[C.lane + 64 * j] * f[j]; ((f32x4*)(XS + (size_t)m * 1024))[C.lane + 64 * j] = v[j]; }
        }
        float ss = 0.f;
#pragma unroll
        for (int j = 0; j < 4; ++j) ss += (v[j].x * v[j].x + v[j].y * v[j].y) + (v[j].z * v[j].z + v[j].w * v[j].w);
        const float rstd = rsqrtf(wave_sum(ss, C.lane) * (1.0f / 1024.0f) + EPS);
        const float* sh = MOD + ((size_t)l * 9 + bidx) * 6144; const float* sc = sh + 1024;
        u32x2* o8 = (u32x2*)(H + (size_t)m * 1024);
#pragma unroll
        for (int j = 0; j < 4; ++j) { const f32x4 g = ((const f32x4*)ng)[C.lane + 64 * j], s1 = ((const f32x4*)sc)[C.lane + 64 * j], s0 = ((const f32x4*)sh)[C.lane + 64 * j];
            const f32x4 h = v[j] * rstd * g * (1.0f + s1) + s0; u32x2 w; w.x = cvt_pk_bf16(h.x, h.y); w.y = cvt_pk_bf16(h.z, h.w); o8[C.lane + 64 * j] = w; }
    }
}
__device__ __forceinline__ void phase_final(const Params& P, const Ctx& C0) {
    Ctx C = C0; { const int t_ = opaque_tid(); C.tid = t_; C.lane = t_ & 63; C.wave = __builtin_amdgcn_readfirstlane(t_ >> 6); asm volatile("" : "+s"(C.ws)); asm volatile("" : "+s"(C.vcu)); asm volatile("" : "+s"(C.G)); }
    const int gw = C.vcu * 8 + C.wave, NGW = C.G * 8;
    const float* MOD = wsp<float>(C, WS_MOD); const float* XS = wsp<float>(C, WS_XS);
    const int* YD = wsp<int>(C, WS_YDEST); const float* WT = wsp<float>(C, WS_WTS); const bf16_t* Y = wsp<bf16_t>(C, WS_Y);
    const float* fg = inp(C, I_FG); float* const outp = (float*)inp(C, 28);
    for (int m = gw; m < MX; m += NGW) {
        const int bidx = m >> 12;
        f32x4 v[4], f[4];
#pragma unroll
        for (int j = 0; j < 4; ++j) { v[j] = ((const f32x4*)(XS + (size_t)m * 1024))[C.lane + 64 * j]; f[j] = (f32x4){0.f, 0.f, 0.f, 0.f}; }
#pragma unroll
        for (int k = 0; k < 4; ++k) { const int dst = YD[m * 4 + k]; const float w = WT[m * 4 + k]; const u32x2* yr = (const u32x2*)(Y + (size_t)dst * 1024);
#pragma unroll
            for (int j = 0; j < 4; ++j) { const u32x2 y = yr[C.lane + 64 * j]; f[j] += w * (f32x4){bf_lo(y.x), bf_hi(y.x), bf_lo(y.y), bf_hi(y.y)}; } }
        const float* g2 = MOD + ((size_t)(DEPTH - 1) * 9 + bidx) * 6144 + 5 * 1024;
        float ss = 0.f;
#pragma unroll
        for (int j = 0; j < 4; ++j) { v[j] += ((const f32x4*)g2)[C.lane + 64 * j] * f[j]; ss += (v[j].x * v[j].x + v[j].y * v[j].y) + (v[j].z * v[j].z + v[j].w * v[j].w); }
        const float rstd = rsqrtf(wave_sum(ss, C.lane) * (1.0f / 1024.0f) + EPS);
#pragma unroll
        for (int j = 0; j < 4; ++j) ((f32x4*)(outp + (size_t)m * 1024))[C.lane + 64 * j] = v[j] * rstd * ((const f32x4*)fg)[C.lane + 64 * j];
    }
}
__device__ __forceinline__ void phase_damerge(const Params& P, const Ctx& C0, const int l, const int Ml) {
    Ctx C = C0; { const int t_ = opaque_tid(); C.tid = t_; C.lane = t_ & 63; C.wave = __builtin_amdgcn_readfirstlane(t_ >> 6); asm volatile("" : "+s"(C.ws)); asm volatile("" : "+s"(C.vcu)); asm volatile("" : "+s"(C.G)); }
    const int gw = C.vcu * 8 + C.wave, NGW = C.G * 8;
    const float lam_init = 0.8f - 0.6f * expf(-0.3f * (float)l);
    const float d1 = wave_sum(inp(C, I_LQ1)[l * 64 + C.lane] * inp(C, I_LK1)[l * 64 + C.lane], C.lane), d2 = wave_sum(inp(C, I_LQ2)[l * 64 + C.lane] * inp(C, I_LK2)[l * 64 + C.lane], C.lane);
    const float lam = expf(d1) - expf(d2) + lam_init;
    const float gA = inp(C, I_SUBLN)[l * 128 + 2 * C.lane] * (1.0f - lam_init), gB = inp(C, I_SUBLN)[l * 128 + 2 * C.lane + 1] * (1.0f - lam_init);
    const unsigned* ODA = wsp<unsigned>(C, WS_ODA); unsigned* ODAN = wsp<unsigned>(C, WS_ODAN);
    for (int m = gw; m < Ml; m += NGW) {
#pragma unroll
        for (int h = 0; h < 4; ++h) { const unsigned a = ODA[(size_t)m * 512 + h * 128 + C.lane], b = ODA[(size_t)m * 512 + h * 128 + 64 + C.lane];
            const float o0 = bf_lo(a) - lam * bf_lo(b), o1 = bf_hi(a) - lam * bf_hi(b);
            const float r = rsqrtf(wave_sum(o0 * o0 + o1 * o1, C.lane) * (1.0f / 128.0f) + EPS);
            ODAN[(size_t)m * 256 + h * 64 + C.lane] = cvt_pk_bf16(o0 * r * gA, o1 * r * gB); }
    }
}
__device__ __forceinline__ void phase_mod2_router(const Params& P, const Ctx& C0, const int l, const int Ml) {
    Ctx C = C0; { const int t_ = opaque_tid(); C.tid = t_; C.lane = t_ & 63; C.wave = __builtin_amdgcn_readfirstlane(t_ >> 6); asm volatile("" : "+s"(C.ws)); asm volatile("" : "+s"(C.vcu)); asm volatile("" : "+s"(C.G)); }
    LAS float* rwt = (LAS float*)C.lds;
    LAS int* hist = (LAS int*)(C.lds + MISC_OFF + 256);
    { const f32x4* src = (const f32x4*)(wsp<float>(C, WS_RWT) + (size_t)l * 32768); LAS f32x4* d = (LAS f32x4*)rwt;
      for (int i = C.tid; i < 8192; i += 512) d[i] = src[i];
      if (C.tid < 32) hist[C.tid] = 0; }
    __syncthreads();
    const float* MOD = wsp<float>(C, WS_MOD); const float* XS = wsp<float>(C, WS_XS); bf16_t* H = wsp<bf16_t>(C, WS_H);
    int* TOPE = wsp<int>(C, WS_TOPE); float* WT = wsp<float>(C, WS_WTS);
    const float* ng = inp(C, I_N2G) + l * 1024; const float rbias = inp(C, I_RB)[l * 32 + (C.lane >> 1)];
    const int wg = blockIdx.x, RPW = (Ml + C.G - 1) / C.G, m_lo = wg * RPW, m_hi = (m_lo + RPW < Ml) ? m_lo + RPW : Ml;
    for (int m = m_lo + C.wave; m < m_hi; m += 8) {
        const int bidx = m < MX ? (m >> 12) : 8;
        f32x4 v[4]; float ss = 0.f;
#pragma unroll
        for (int j = 0; j < 4; ++j) { v[j] = ((const f32x4*)(XS + (size_t)m * 1024))[C.lane + 64 * j]; ss += (v[j].x * v[j].x + v[j].y * v[j].y) + (v[j].z * v[j].z + v[j].w * v[j].w); }
        const float rstd = rsqrtf(wave_sum(ss, C.lane) * (1.0f / 1024.0f) + EPS);
        const float* sh = MOD + ((size_t)l * 9 + bidx) * 6144 + 3 * 1024; const float* sc = sh + 1024;
        u32x2* o8 = (u32x2*)(H + (size_t)m * 1024);
#pragma unroll
        for (int j = 0; j < 4; ++j) { const f32x4 g = ((const f32x4*)ng)[C.lane + 64 * j], s1 = ((const f32x4*)sc)[C.lane + 64 * j], s0 = ((const f32x4*)sh)[C.lane + 64 * j];
            v[j] = v[j] * rstd * g * (1.0f + s1) + s0; u32x2 w; w.x = cvt_pk_bf16(v[j].x, v[j].y); w.y = cvt_pk_bf16(v[j].z, v[j].w); o8[C.lane + 64 * j] = w; }
        float a[32];
#pragma unroll
        for (int e = 0; e < 32; ++e) { float t = 0.f;
#pragma unroll
            for (int j = 0; j < 4; ++j) { const f32x4 w = ((const LAS f32x4*)(rwt + e * 1024))[C.lane + 64 * j]; t += (v[j].x * w.x + v[j].y * w.y) + (v[j].z * w.z + v[j].w * w.w); }
            a[e] = t; }
#define RS_STEP(N, OFF, BIT) _Pragma("unroll") for (int e = 0; e < N; ++e) { const bool up = (C.lane >> BIT) & 1; const float keep = up ? a[e + N] : a[e], send = up ? a[e] : a[e + N]; a[e] = keep + shx(send, OFF, C.lane); }
        RS_STEP(16, 32, 5) RS_STEP(8, 16, 4) RS_STEP(4, 8, 3) RS_STEP(2, 4, 2) RS_STEP(1, 2, 1)
#undef RS_STEP
        float lg = a[0] + shx(a[0], 1, C.lane) + rbias;
        const int myE = C.lane >> 1;
        float tv[4]; int ti[4];
#pragma unroll
        for (int k = 0; k < 4; ++k) { float bv = lg; int bi = myE;
#pragma unroll
            for (int o = 1; o < 64; o <<= 1) { const float ov = shx(bv, o, C.lane); const int oi = shxi(bi, o, C.lane); if (ov > bv || (ov == bv && oi < bi)) { bv = ov; bi = oi; } }
            tv[k] = bv; ti[k] = bi; if (myE == bi) lg = -3.0e38f; }
        const float e1 = __expf(tv[1] - tv[0]), e2 = __expf(tv[2] - tv[0]), e3 = __expf(tv[3] - tv[0]); const float inv = 1.0f / (1.0f + e1 + e2 + e3);
        if (C.lane < 4) { const int e = C.lane == 0 ? ti[0] : C.lane == 1 ? ti[1] : C.lane == 2 ? ti[2] : ti[3];
            const float w = (C.lane == 0 ? 1.0f : C.lane == 1 ? e1 : C.lane == 2 ? e2 : e3) * inv;
            const int rank = atomicAdd((int*)(hist + e), 1);
            TOPE[m * 4 + C.lane] = e | (rank << 8); WT[m * 4 + C.lane] = w; }
    }
    __syncthreads();
    if (C.tid < 32) wsp<int>(C, WS_CNTWG)[wg * 32 + C.tid] = hist[C.tid];
    __syncthreads();
}
__device__ __forceinline__ void phase_lists(const Params& P, const Ctx& C0, const int Ml) {
    Ctx C = C0; { const int t_ = opaque_tid(); C.tid = t_; C.lane = t_ & 63; C.wave = __builtin_amdgcn_readfirstlane(t_ >> 6); asm volatile("" : "+s"(C.ws)); asm volatile("" : "+s"(C.vcu)); asm volatile("" : "+s"(C.G)); }
    LAS int* part = (LAS int*)(C.lds);
    LAS int* tot = (LAS int*)(C.lds + 4096);
    LAS int* base = (LAS int*)(C.lds + 4096 + 128);
    LAS int* pst = (LAS int*)(C.lds + 4096 + 256);
    const int* CNT = wsp<int>(C, WS_CNTWG); const int wg = blockIdx.x;
    { const int e = C.tid & 31, seg = C.tid >> 5; int s = 0, sb = 0;
      for (int w = seg; w < C.G; w += 16) { const int c = CNT[w * 32 + e]; s += c; if (w < wg) sb += c; }
      part[seg * 32 + e] = s; part[512 + seg * 32 + e] = sb; }
    __syncthreads();
    if (C.tid < 32) { int s = 0, sb = 0; for (int g = 0; g < 16; ++g) { s += part[g * 32 + C.tid]; sb += part[512 + g * 32 + C.tid]; } tot[C.tid] = s; base[C.tid] = sb; }
    __syncthreads();
    if (C.tid == 0) { int p = 0; for (int e = 0; e < 32; ++e) { pst[e] = p; p += (tot[e] + 255) & ~255; } pst[32] = p;
        if (wg == 0) { int* PS = wsp<int>(C, WS_PSTART); for (int e = 0; e <= 32; ++e) PS[e] = pst[e]; } }
    __syncthreads();
    const int* TOPE = wsp<int>(C, WS_TOPE); int* YD = wsp<int>(C, WS_YDEST); const bf16_t* H = wsp<bf16_t>(C, WS_H); bf16_t* XG = wsp<bf16_t>(C, WS_Y);
    const int RPW = (Ml + C.G - 1) / C.G, m_lo = wg * RPW, m_hi = (m_lo + RPW < Ml) ? m_lo + RPW : Ml;
    for (int m = m_lo + C.wave; m < m_hi; m += 8) {
        const u32x4 h0 = ((const u32x4*)(H + (size_t)m * 1024))[C.lane], h1 = ((const u32x4*)(H + (size_t)m * 1024))[C.lane + 64];
#pragma unroll
        for (int k = 0; k < 4; ++k) { const int t = TOPE[m * 4 + k], e = t & 255, rank = t >> 8; const int dst = pst[e] + base[e] + rank;
            if (C.lane == 0) YD[m * 4 + k] = dst;
            ((u32x4*)(XG + (size_t)dst * 1024))[C.lane] = h0; ((u32x4*)(XG + (size_t)dst * 1024))[C.lane + 64] = h1; }
    }
    for (int e = C.wave; e < 32; e += 8) { const int lo = pst[e] + tot[e], hi = pst[e + 1];
        for (int r = lo + wg; r < hi; r += C.G) { ((u32x4*)(XG + (size_t)r * 1024))[C.lane] = (u32x4){0u, 0u, 0u, 0u}; ((u32x4*)(XG + (size_t)r * 1024))[C.lane + 64] = (u32x4){0u, 0u, 0u, 0u}; } }
    __syncthreads();
}
__device__ __forceinline__ int moe_tiles(const Ctx& C0, LAS int* tile_e) {
    Ctx C = C0; { const int t_ = opaque_tid(); C.tid = t_; C.lane = t_ & 63; C.wave = __builtin_amdgcn_readfirstlane(t_ >> 6); asm volatile("" : "+s"(C.ws)); asm volatile("" : "+s"(C.vcu)); asm volatile("" : "+s"(C.G)); }
    const int* PS = wsp<int>(C, WS_PSTART);
    const int ntiles = PS[32] >> 8;
    for (int t = C.tid; t < ntiles; t += 512) { int e = 0;
#pragma unroll 1
        for (int j = 1; j < 32; ++j) if ((PS[j] >> 8) <= t) e = j;
        tile_e[t] = e; }
    __syncthreads();
    return __builtin_amdgcn_readfirstlane(ntiles);
}

constexpr int PH_PER_LAYER = 11, N_PHASES = 1 + DEPTH * PH_PER_LAYER + 1;
__global__ void __launch_bounds__(512, 2) dit_fwd(Params P) {
    extern __shared__ __attribute__((aligned(16))) unsigned char lds_raw[];
    Ctx C; C.lds = (LAS unsigned char*)lds_raw; C.ldsg = (char*)lds_raw; C.tid = threadIdx.x; C.lane = C.tid & 63; C.wave = __builtin_amdgcn_readfirstlane(C.tid >> 6);
    C.G = gridDim.x; { const int bx = blockIdx.x; C.vcu = (C.G % 8 == 0) ? (bx % 8) * (C.G / 8) + bx / 8 : bx; }
    C.ws = P.ws;
    volatile LAS unsigned* MISC = (volatile LAS unsigned*)(C.lds + MISC_OFF);
    if (C.tid < 64) MISC[C.tid] = 0u;
    if (C.tid == 64) { LAS unsigned long long* tab = (LAS unsigned long long*)(C.lds + PTRTAB_OFF);
#pragma unroll
        for (int i = 0; i < 28; ++i) tab[i] = (unsigned long long)P.in[i];
        tab[28] = (unsigned long long)P.out; }
    { LAS float* T = (LAS float*)(C.lds + ROPE_OFF);
      for (int i = C.tid; i < 1024; i += 512) { const int p = i >> 4, f = i & 15; const float fr = powf(10000.0f, -(float)(2 * f) / 32.0f); const float a = (float)p * fr; T[2 * i] = cosf(a); T[2 * i + 1] = sinf(a); } }
    __syncthreads();
    unsigned* barw = (unsigned*)(C.ws + WS_CTL) + CW_BAR;
    XcdBarrier bar; bar.bar = barw; bar.x = 0; bar.st = nullptr;
    const int lo = P.ph_lo, hi = P.ph_hi;
    const bool multi = (hi - lo) > 1;
    if (multi) bar = xcd_barrier_post(barw, MISC + 8);
#ifndef PH_MASK
#define PH_MASK 0xffff
#endif
#define IN(k) (lo <= (k) && (k) < hi)
#define EN(p) ((PH_MASK >> (p)) & 1)
#define SEAM(k) do { if (IN((k) + 1)) xcd_barrier(bar); } while (0)
    if (EN(11) && IN(0)) { phase_prologue(P, C); SEAM(0); }
    for (int l = 0; l < DEPTH; ++l) {
        const int pb = 1 + l * PH_PER_LAYER;
        const bool lastl = (l == DEPTH - 1);
        const int Ml = lastl ? MX : MT;
        const int nMl = Ml / 256;
        const float* MODl = wsp<float>(C, WS_MOD) + (size_t)l * 9 * 6144;
        if (EN(0) && IN(pb + 0)) { phase_mod1(P, C, l); SEAM(pb + 0); }
        if (EN(1) && IN(pb + 1)) {
            pg8::PlainSched S{(const char*)wsp<bf16_t>(C, WS_H), (const char*)(wsp<bf16_t>(C, WS_WIN) + (size_t)l * NIN * 1024), 1024, MT / 256, NIN / 256, C.G, (int)blockIdx.x};
            EpiG1 E{C.ws, (const LAS float*)(C.lds + ROPE_OFF)};
            pg8::gemm_phase(C.lds, 1024, S, E);
            SEAM(pb + 1);
        }
        if (EN(2) && IN(pb + 2)) {
            { pg8::PlainSched S{(const char*)wsp<bf16_t>(C, WS_CQ), (const char*)(wsp<bf16_t>(C, WS_WQB) + (size_t)l * 768 * 384), 384, MT / 256, 3, C.G, (int)blockIdx.x};
              EpiQMla E{C.ws, (const LAS float*)(C.lds + ROPE_OFF)};
              pg8::gemm_phase(C.lds, 384, S, E); }
            { pg8::PlainSched S{(const char*)wsp<bf16_t>(C, WS_CKV), (const char*)(wsp<bf16_t>(C, WS_WKVB) + (size_t)l * 1024 * 256), 256, MT / 256, 4, C.G, (int)blockIdx.x};
              EpiKvMla E{C.ws};
              pg8::gemm_phase(C.lds, 256, S, E); }
            SEAM(pb + 2);
        }
        if (EN(3) && IN(pb + 3)) {
            const bf16_t* QDA = wsp<bf16_t>(C, WS_QDA); const bf16_t* KDA = wsp<bf16_t>(C, WS_KDA); const bf16_t* VDA = wsp<bf16_t>(C, WS_VDA); bf16_t* ODA = wsp<bf16_t>(C, WS_ODA);
            const bf16_t* QM = wsp<bf16_t>(C, WS_QMLA); const bf16_t* KVM = wsp<bf16_t>(C, WS_KVMLA); const bf16_t* KR = wsp<bf16_t>(C, WS_KR); bf16_t* OM = wsp<bf16_t>(C, WS_OMLA);
#ifndef ATT_ONLY
#define ATT_ONLY 3
#endif
            const int nu_m = (ATT_ONLY & 1) ? NB * 4 * 16 + (lastl ? 0 : NB * 4) : 0;
            for (int u = C.vcu; u < nu_m; u += C.G) {
                int h, q0, kx0, ky0, ntx, nt;
                if (u < NB * 4 * 16) { const int qb = u & 15, b = u >> 6; h = (u >> 4) & 3; q0 = b * SEQ + qb * 256; kx0 = b * SEQ; ky0 = MX + b * CTXL; ntx = SEQ / 64; nt = SEQ / 64 + CTXL / 64; }
                else { const int v = u - NB * 4 * 16, b = v >> 2; h = v & 3; q0 = MX + b * CTXL; kx0 = 0; ky0 = q0; ntx = 0; nt = CTXL / 64; }
                att::attn_unit<128, 768, 1024, 64, 1024, 512, 1>(QM + h * 192, QM + h * 192 + 128, KVM + h * 256, KR, KVM + h * 256 + 128, OM + h * 128, q0, kx0, ky0, ntx, nt, C.ldsg); }
            const int nu_d = (ATT_ONLY & 2) ? NB * 8 * 16 + (lastl ? 0 : NB * 8) : 0;
            for (int u = C.vcu; u < nu_d; u += C.G) {
                int hm, q0, kx0, ky0, ntx, nt;
                if (u < NB * 8 * 16) { const int qb = u & 15, b = u >> 7; hm = (u >> 4) & 7; q0 = b * SEQ + qb * 256; kx0 = b * SEQ; ky0 = MX + b * CTXL; ntx = SEQ / 64; nt = SEQ / 64 + CTXL / 64; }
                else { const int v = u - NB * 8 * 16, b = v >> 3; hm = v & 7; q0 = MX + b * CTXL; kx0 = 0; ky0 = q0; ntx = 0; nt = CTXL / 64; }
                att::attn_unit<0, 512, 512, 512, 512, 1024, 2>(QDA, QDA + hm * 64, KDA, KDA + hm * 64, VDA + (hm >> 1) * 128, ODA + hm * 128, q0, kx0, ky0, ntx, nt, C.ldsg); }
            SEAM(pb + 3);
        }
        if (EN(4) && IN(pb + 4)) { phase_damerge(P, C, l, Ml); SEAM(pb + 4); }
        if (EN(5) && IN(pb + 5)) {
            pg8::PairSched S{(const char*)wsp<bf16_t>(C, WS_ODAN), (long)WS_OMLA - (long)WS_ODAN, (const char*)(wsp<bf16_t>(C, WS_WBRA) + (size_t)l * 1024 * 512), (long)WS_WBRB - (long)WS_WBRA, 512, nMl, 4, C.G, (int)blockIdx.x};
            EpiBranch E{C.ws};
            pg8::gemm_phase(C.lds, 512, S, E);
            SEAM(pb + 5);
        }
        if (EN(6) && IN(pb + 6)) {
            pg8::PlainSched S{(const char*)wsp<bf16_t>(C, WS_U), (const char*)(wsp<bf16_t>(C, WS_WOUT) + (size_t)l * 1024 * 1024), 1024, nMl, 4, C.G, (int)blockIdx.x};
            EpiOut E{wsp<float>(C, WS_XS), inp(C, I_X), inp(C, I_CTX), MODl, l == 0 ? 1 : 0};
            pg8::gemm_phase(C.lds, 1024, S, E);
            SEAM(pb + 6);
        }
        if (EN(7) && IN(pb + 7)) { phase_mod2_router(P, C, l, Ml); SEAM(pb + 7); }
        if (EN(8) && IN(pb + 8)) { phase_lists(P, C, Ml); SEAM(pb + 8); }
        if (EN(9) && IN(pb + 9)) {
            LAS int* tile_e = (LAS int*)(C.lds + MISC_OFF + 512);
            const int ntiles = moe_tiles(C, tile_e);
            pg8::MoeSched S{(const char*)wsp<bf16_t>(C, WS_Y), (const char*)(wsp<bf16_t>(C, WS_WGU) + (size_t)l * 32 * 1024 * 1024), 1024, (size_t)1024 * 1024 * 2, ntiles, C.G, C.vcu, tile_e};
            EpiUp E{wsp<bf16_t>(C, WS_ACT), inp(C, I_BGU) + (size_t)l * 32 * 1024};
            pg8::gemm_phase(C.lds, 1024, S, E);
            SEAM(pb + 9);
        }
        if (EN(10) && IN(pb + 10)) {
            LAS int* tile_e = (LAS int*)(C.lds + MISC_OFF + 512);
            const int ntiles = moe_tiles(C, tile_e);
            pg8::MoeSched S{(const char*)wsp<bf16_t>(C, WS_ACT), (const char*)(wsp<bf16_t>(C, WS_WDN) + (size_t)l * 32 * 1024 * 512), 512, (size_t)1024 * 512 * 2, ntiles, C.G, C.vcu, tile_e};
            EpiDown E{wsp<bf16_t>(C, WS_Y), inp(C, I_BDN) + (size_t)l * 32 * 1024};
            pg8::gemm_phase(C.lds, 512, S, E);
            SEAM(pb + 10);
        }
    }
    if (EN(12) && IN(N_PHASES - 1)) phase_final(P, C);
#undef IN
#undef SEAM
}

extern "C" void kernel_launch(void* const* d_in, const int* in_sizes, int n_in, void* d_out, int out_size, void* d_ws, size_t ws_size, hipStream_t stream) {
    static int grid = 0;
    if (grid == 0) {
        if (n_in != 28 || in_sizes[0] != MX * DM || out_size != MX * DM || ws_size < WS_END) { fprintf(stderr, "kernel_launch: shape/workspace mismatch (n_in %d, ws %zu < %zu)\n", n_in, ws_size, (size_t)WS_END); grid = -1; return; }
        int dev = 0, cus = 0, per_cu = 0;
        if (hipGetDevice(&dev) != hipSuccess || hipDeviceGetAttribute(&cus, hipDeviceAttributeMultiprocessorCount, dev) != hipSuccess) { grid = -1; return; }
        if (hipFuncSetAttribute((const void*)dit_fwd, hipFuncAttributeMaxDynamicSharedMemorySize, LDS_BYTES) != hipSuccess) { fprintf(stderr, "kernel_launch: hipFuncSetAttribute failed\n"); grid = -1; return; }
        if (hipOccupancyMaxActiveBlocksPerMultiprocessor(&per_cu, (const void*)dit_fwd, 512, LDS_BYTES) != hipSuccess || per_cu < 1) fprintf(stderr, "kernel_launch: occupancy query says %d\n", per_cu);
        (void)hipGetLastError();
        grid = cus > 1024 ? 1024 : cus;
    }
    if (grid < 0) return;
    if (hipMemsetAsync((char*)d_ws + WS_CTL, 0, CTL_ZERO_BYTES, stream) != hipSuccess) return;
    Params p{};
    for (int i = 0; i < 28; ++i) p.in[i] = (const float*)d_in[i];
    p.out = (float*)d_out; p.ws = (unsigned char*)d_ws;
#if MK_ONE_LAUNCH
    p.ph_lo = 0; p.ph_hi = N_PHASES;
    hipLaunchKernelGGL(dit_fwd, dim3(grid), dim3(512), LDS_BYTES, stream, p);
#else
    for (int k = 0; k < N_PHASES; ++k) { p.ph_lo = k; p.ph_hi = k + 1; hipLaunchKernelGGL(dit_fwd, dim3(grid), dim3(512), LDS_BYTES, stream, p); }
#endif
    const hipError_t le = hipPeekAtLastError();
    if (le != hipSuccess) fprintf(stderr, "kernel_launch: launch failed: %s\n", hipGetErrorName(le));
}
```

```cpp
#include <hip/hip_runtime.h>
#include <cstdio>
#include <cstdint>

#ifndef MK_ONE_LAUNCH
#define MK_ONE_LAUNCH 1
#endif

#define GAS __attribute__((address_space(1)))
#define LAS __attribute__((address_space(3)))
typedef unsigned short bf16_t;
typedef short bf16x8 __attribute__((ext_vector_type(8)));
typedef short s16x4 __attribute__((ext_vector_type(4)));
typedef float f32x4 __attribute__((ext_vector_type(4)));
typedef float f32x16 __attribute__((ext_vector_type(16)));
typedef unsigned u32x4 __attribute__((ext_vector_type(4)));
typedef unsigned u32x2 __attribute__((ext_vector_type(2)));

constexpr int DM = 1024, NB = 8, SEQ = 4096, DEPTH = 4, CTXL = 256;
constexpr int MX = NB * SEQ, MY = NB * CTXL, MT = MX + MY;
constexpr int NIN = 4352;
constexpr int NEXP = 32, DFF = 512;
constexpr int PMAX = 147456;
constexpr float EPS = 1e-6f;

constexpr size_t al256(size_t x) { return (x + 255) & ~(size_t)255; }
constexpr size_t WS_CTL = 0, CTL_ZERO_BYTES = 1u << 20;
constexpr size_t WS_MOD = CTL_ZERO_BYTES;
constexpr size_t WS_ROPE = WS_MOD + al256((size_t)DEPTH * 9 * 6144 * 4);
constexpr size_t WS_RWT = WS_ROPE + 8192;
constexpr size_t WS_WIN = WS_RWT + (size_t)DEPTH * 32 * 1024 * 4;
constexpr size_t WS_WQB = WS_WIN + (size_t)DEPTH * NIN * 1024 * 2;
constexpr size_t WS_WKVB = WS_WQB + (size_t)DEPTH * 768 * 384 * 2;
constexpr size_t WS_WBRA = WS_WKVB + (size_t)DEPTH * 1024 * 256 * 2;
constexpr size_t WS_WBRB = WS_WBRA + (size_t)DEPTH * 1024 * 512 * 2;
constexpr size_t WS_WOUT = WS_WBRB + (size_t)DEPTH * 1024 * 512 * 2;
constexpr size_t WS_WGU = WS_WOUT + (size_t)DEPTH * 1024 * 1024 * 2;
constexpr size_t WS_WDN = WS_WGU + (size_t)DEPTH * 32 * 1024 * 1024 * 2;
constexpr size_t WS_XS = WS_WDN + (size_t)DEPTH * 32 * 1024 * 512 * 2;
constexpr size_t WS_H = WS_XS + (size_t)MT * 1024 * 4;
constexpr size_t WS_QDA = WS_H + (size_t)MT * 1024 * 2;
constexpr size_t WS_KDA = WS_QDA + (size_t)MT * 512 * 2;
constexpr size_t WS_VDA = WS_KDA + (size_t)MT * 512 * 2;
constexpr size_t WS_GATES = WS_VDA + (size_t)MT * 512 * 2;
constexpr size_t WS_CQ = WS_GATES + (size_t)MT * 2048 * 2;
constexpr size_t WS_CKV = WS_CQ + (size_t)MT * 384 * 2;
constexpr size_t WS_KR = WS_CKV + (size_t)MT * 256 * 2;
constexpr size_t WS_ROWSQ = WS_KR + (size_t)MT * 64 * 2;
constexpr size_t WS_QMLA = WS_ROWSQ + (size_t)MT * 12 * 4;
constexpr size_t WS_KVMLA = WS_QMLA + (size_t)MT * 768 * 2;
constexpr size_t WS_ODA = WS_KVMLA + (size_t)MT * 1024 * 2;
constexpr size_t WS_OMLA = WS_ODA + (size_t)MT * 1024 * 2;
constexpr size_t WS_ODAN = WS_OMLA + (size_t)MT * 512 * 2;
constexpr size_t WS_U = WS_ODAN + (size_t)MT * 512 * 2;
constexpr size_t WS_TOPE = WS_U + (size_t)MT * 1024 * 2;
constexpr size_t WS_WTS = WS_TOPE + (size_t)MT * 16;
constexpr size_t WS_YDEST = WS_WTS + (size_t)MT * 16;
constexpr size_t WS_CNTWG = WS_YDEST + (size_t)MT * 16;
constexpr size_t WS_PSTART = WS_CNTWG + 1024 * 32 * 4;
constexpr size_t WS_ROWLIST = WS_PSTART + 256;
constexpr size_t WS_ACT = WS_ROWLIST + (size_t)PMAX * 4;
constexpr size_t WS_Y = WS_ACT + (size_t)PMAX * 512 * 2;
constexpr size_t WS_END = WS_Y + (size_t)PMAX * 1024 * 2;

constexpr int CW_BAR = 4096;

constexpr int RING_BYTES = 131072;
constexpr int MISC_OFF = RING_BYTES;
constexpr int ROPE_OFF = 135168;
constexpr int LDS_BYTES = 147456;

__device__ __forceinline__ unsigned cvt_pk_bf16(float lo, float hi) { unsigned r; asm volatile("v_cvt_pk_bf16_f32 %0, %1, %2" : "=v"(r) : "v"(lo), "v"(hi)); return r; }
__device__ __forceinline__ float bf_lo(unsigned w) { return __uint_as_float(w << 16); }
__device__ __forceinline__ float bf_hi(unsigned w) { return __uint_as_float(w & 0xffff0000u); }
__device__ __forceinline__ float shx(float v, int o, int lane) { return __int_as_float(__builtin_amdgcn_ds_bpermute((lane ^ o) << 2, __float_as_int(v))); }
__device__ __forceinline__ int shxi(int v, int o, int lane) { return __builtin_amdgcn_ds_bpermute((lane ^ o) << 2, v); }
__device__ __forceinline__ float wave_sum(float v, int lane) {
#pragma unroll
    for (int o = 1; o < 64; o <<= 1) v += shx(v, o, lane);
    return v;
}
__device__ __forceinline__ float xchg32(float x, bool lo_half) {
    auto rr = __builtin_amdgcn_permlane32_swap(__float_as_uint(x), __float_as_uint(x), false, false);
    return __uint_as_float(lo_half ? rr[1] : rr[0]);
}
__device__ __forceinline__ float sigmoidf_(float x) { return 1.0f / (1.0f + __expf(-x)); }
__device__ __forceinline__ int opaque_tid() { int t = threadIdx.x; asm volatile("" : "+v"(t)); return t; }
#define LDS_WAIT() asm volatile("s_waitcnt lgkmcnt(0)" ::: "memory")
#define VM_WAIT() asm volatile("s_waitcnt vmcnt(0)" ::: "memory")

#define XB_TMO      128
#define XB_XCNT(j)  (256  + 64 * (j))
#define XB_XSUB(j)  (1280 + 64 * (j))
#define XB_XGEN(j)  (2304 + 64 * (j))
#define XB_TOP      3328
#define XB_TOPGEN   3392
#define XCD_BAR_WORDS 3456
#define XB_SPIN_CAP (1u << 18)
__device__ __forceinline__ unsigned xb_ld(unsigned* p)              { return __hip_atomic_load(p, __ATOMIC_RELAXED, __HIP_MEMORY_SCOPE_AGENT); }
__device__ __forceinline__ unsigned xb_add(unsigned* p, unsigned v) { return __hip_atomic_fetch_add(p, v, __ATOMIC_RELAXED, __HIP_MEMORY_SCOPE_AGENT); }
__device__ __forceinline__ unsigned xb_xcc_id() { return (unsigned)__builtin_amdgcn_s_getreg((3 << 11) | 20) & 0xFu; }
#define XB_SPIN(cond, bar) do { unsigned _sp = 0; while (cond) { __builtin_amdgcn_s_sleep(1); \
    if ((++_sp & 255u) == 0u) { if (xb_ld(&(bar)[XB_TMO])) break; if (_sp > XB_SPIN_CAP) { atomicAdd(&(bar)[XB_TMO], 1u); break; } } } } while (0)
struct XcdBarrier { unsigned* bar; unsigned x; volatile LAS unsigned* st; };
__device__ __forceinline__ XcdBarrier xcd_barrier_post(unsigned* bar, volatile LAS unsigned* st) {
    XcdBarrier b; b.bar = bar; b.x = xb_xcc_id(); b.st = st;
    if (threadIdx.x == 0) (void)xb_add(&bar[XB_XCNT(b.x)], 1u);
    return b;
}
__device__ __forceinline__ void xcd_barrier_complete(unsigned* bar, unsigned x, unsigned& nloc, unsigned& nx) {
    const unsigned G = gridDim.x * gridDim.y * gridDim.z;
    unsigned sum, cnt, mine, sp = 0u;
    for (;;) {
        sum = 0u; cnt = 0u; mine = 0u;
#pragma unroll
        for (unsigned j = 0; j < 16; ++j) { const unsigned c = xb_ld(&bar[XB_XCNT(j)]); sum += c; cnt += (c > 0u) ? 1u : 0u; mine = (j == x) ? c : mine; }
        if (sum == G) break;
        __builtin_amdgcn_s_sleep(1);
        if ((++sp & 255u) == 0u) { if (xb_ld(&bar[XB_TMO])) break; if (sp > XB_SPIN_CAP) { atomicAdd(&bar[XB_TMO], 1u); break; } }
    }
    nloc = mine > 0u ? mine : 1u; nx = cnt > 0u ? cnt : 1u;
}
__device__ __forceinline__ void xcd_barrier(const XcdBarrier& b) {
    asm volatile("s_waitcnt vmcnt(0)" ::: "memory");
    __syncthreads();
    if (threadIdx.x == 0) {
        unsigned* bar = b.bar; asm volatile("" : "+s"(bar));
        __builtin_amdgcn_s_waitcnt(0);
        unsigned nloc = b.st[0], nx = b.st[1];
        if (nloc == 0u) { xcd_barrier_complete(bar, b.x, nloc, nx); b.st[0] = nloc; b.st[1] = nx; }
        const unsigned old = xb_add(&bar[XB_XSUB(b.x)], 1u);
        const unsigned gen = old / nloc;
        if (old + 1u == (gen + 1u) * nloc) {
            __builtin_amdgcn_fence(__ATOMIC_RELEASE, "agent");
            asm volatile("s_waitcnt vmcnt(0)" ::: "memory");
            const unsigned og = xb_add(&bar[XB_TOP], 1u);
            const unsigned tg = og / nx;
            if (og + 1u == (tg + 1u) * nx) xb_add(&bar[XB_TOPGEN], 1u);
            else XB_SPIN(xb_ld(&bar[XB_TOPGEN]) == tg, bar);
            __builtin_amdgcn_fence(__ATOMIC_ACQUIRE, "agent");
            xb_add(&bar[XB_XGEN(b.x)], 1u);
            asm volatile("s_waitcnt vmcnt(0)" ::: "memory");
        } else {
            XB_SPIN(xb_ld(&bar[XB_XGEN(b.x)]) == gen, bar);
            __builtin_amdgcn_fence(__ATOMIC_ACQUIRE, "agent");
            asm volatile("s_waitcnt vmcnt(0)" ::: "memory");
        }
    }
    __syncthreads();
}

namespace pg8 {
constexpr int BM = 256, BK = 64, HALF = 128, HTB = HALF * BK * 2, STAGE_BYTES = 8 * HTB, NXCD = 8, WGM = 8;
__host__ __device__ __forceinline__ int lds_byte(int r, int c) { const int st = (r >> 4) * 2 + (c >> 5), rr = r & 15, cc = c & 31, ob = rr * 64 + cc * 2; return st * 1024 + (ob ^ (((ob >> 9) & 1) << 5)); }
__host__ __device__ __forceinline__ void stage_rc(int b, int& R, int& C) { const int st = b / 1024, sb = b % 1024, swz = sb ^ (((sb >> 9) & 1) << 5); R = (st >> 1) * 16 + swz / 64; C = (st & 1) * 32 + (swz % 64) / 2; }
__host__ __device__ __forceinline__ int perm32(int rho) { const int n = rho >> 4, i = rho & 15; return 8 * (i >> 2) + 4 * n + (i & 3); }
struct Unit { int pm, pn, z; };

template <class Epi, class Sched, bool GATHER = false>
__device__ __forceinline__ void gemm_phase(LAS unsigned char* lds, const int K, const Sched& S, const Epi& E) {
    const int tid = opaque_tid(), wid = __builtin_amdgcn_readfirstlane(tid >> 6), lane = tid & 63, wr = wid >> 2, wc = wid & 3, fr = lane & 15, fq = lane >> 4;
    const int nt = K / BK;
    unsigned voffA[2], voffB[2];
#pragma unroll
    for (int i = 0; i < 2; ++i) { int R, C; stage_rc(tid * 16 + i * 8192, R, C); const int Rb = (R & ~31) + perm32(R & 31);
        voffA[i] = (unsigned)(R * K + C) * 2u; voffB[i] = (unsigned)(Rb * K + C) * 2u; }
    unsigned gA[4] = {0u, 0u, 0u, 0u}, gN[4] = {0u, 0u, 0u, 0u};
#define PG8_GLOAD(dst, u) do { int R0_, C0_; stage_rc(tid * 16, R0_, C0_); const int* rl_ = S.rowlist + (size_t)(u).pm * 256 + R0_; \
        _Pragma("unroll") for (int h_ = 0; h_ < 2; ++h_) _Pragma("unroll") for (int i_ = 0; i_ < 2; ++i_) dst[h_ * 2 + i_] = (unsigned)rl_[h_ * 128 + i_ * 64] * (unsigned)(K * 2) + (unsigned)(C0_ * 2); } while (0)
    const size_t kstep = (size_t)(BK * 2);
    const size_t hstep = (size_t)HALF * K * 2;
    const unsigned ldsw = (unsigned)wid * 1024u;
    const int aoff = lds_byte(wr * 64 + fr, fq * 8), boff = lds_byte(wc * 32 + fr, fq * 8);
#define PG8_SA(b, h) (((b) * 2 + (h)) * HTB)
#define PG8_SB(b, h) ((4 + (b) * 2 + (h)) * HTB)
#define PG8_STAGE(bufoff, gbase, voff) do { _Pragma("unroll") for (int _i = 0; _i < 2; ++_i) \
        __builtin_amdgcn_global_load_lds((const unsigned*)((const char*)(gbase) + (voff)[_i]), (LAS unsigned*)(lds + (bufoff) + ldsw + _i * 8192), 16, 0, 0); } while (0)
#define PG8_STAGE_A(bufoff, ptr, h) do { if constexpr (GATHER) { PG8_STAGE(bufoff, ptr, gA + 2 * (h)); } else { PG8_STAGE(bufoff, (ptr) + (h) * hstep, voffA); } } while (0)
#define PG8_LDA(dst, b, h) do { _Pragma("unroll") for (int m = 0; m < 4; ++m) _Pragma("unroll") for (int k = 0; k < 2; ++k) dst[m][k] = *(const LAS bf16x8*)(lds + PG8_SA(b, h) + aoff + m * 2048 + k * 1024); } while (0)
#define PG8_LDB(dst, b, h) do { _Pragma("unroll") for (int n = 0; n < 2; ++n) _Pragma("unroll") for (int k = 0; k < 2; ++k) dst[n][k] = *(const LAS bf16x8*)(lds + PG8_SB(b, h) + boff + n * 2048 + k * 1024); } while (0)
#define PG8_MMA(ai, bj, At, Bt) do { __builtin_amdgcn_s_setprio(1); _Pragma("unroll") for (int m = 0; m < 4; ++m) _Pragma("unroll") for (int n = 0; n < 2; ++n) _Pragma("unroll") for (int k = 0; k < 2; ++k) \
        acc[ai][bj][m][n] = __builtin_amdgcn_mfma_f32_16x16x32_bf16(Bt[n][k], At[m][k], acc[ai][bj][m][n], 0, 0, 0); __builtin_amdgcn_s_setprio(0); } while (0)
#define PG8_WAIT_V(n) asm volatile("s_waitcnt vmcnt(" #n ")" ::: "memory")
#define PG8_WAIT_L(n) asm volatile("s_waitcnt lgkmcnt(" #n ")" ::: "memory")
#define PG8_BAR __builtin_amdgcn_s_barrier()
#define PG8_SCHED __builtin_amdgcn_sched_barrier(0)
    Unit cur, nxt; int ui = 0;
    if (!S.next(0, cur)) return;
    f32x4 acc[2][2][4][2];
#pragma unroll
    for (int a = 0; a < 2; ++a)
#pragma unroll
        for (int b = 0; b < 2; ++b)
#pragma unroll
            for (int m = 0; m < 4; ++m)
#pragma unroll
                for (int n = 0; n < 2; ++n) acc[a][b][m][n] = (f32x4){0.f, 0.f, 0.f, 0.f};
    bf16x8 At[4][2], B0[2][2], B1[2][2];
    const char* cA = S.a_tile(cur); const char* cB = S.b_tile(cur);
    if constexpr (GATHER) { PG8_GLOAD(gA, cur); }
    PG8_STAGE(PG8_SB(0, 0), cB, voffB); PG8_STAGE(PG8_SB(0, 1), cB + hstep, voffB); PG8_STAGE_A(PG8_SA(0, 0), cA, 0); PG8_STAGE_A(PG8_SA(0, 1), cA, 1);
    if (wr == 1) PG8_BAR;
    PG8_WAIT_V(2); PG8_BAR;
    PG8_STAGE(PG8_SB(1, 0), cB + kstep, voffB); PG8_STAGE_A(PG8_SA(1, 0), cA + kstep, 0); PG8_STAGE(PG8_SB(1, 1), cB + hstep + kstep, voffB);
    PG8_WAIT_V(6); PG8_BAR;
    for (;;) {
        const bool has_next = S.next(ui + 1, nxt);
        const char* nA = has_next ? S.a_tile(nxt) : cA; const char* nB = has_next ? S.b_tile(nxt) : cB;
        if constexpr (GATHER) { if (has_next) { PG8_GLOAD(gN, nxt); } }
        for (int t = 0; t < nt; t += 2) {
            const bool last = (t == nt - 2);
            const char* a1 = cA + (size_t)(t + 1) * kstep;
            const char* a2 = last ? nA : cA + (size_t)(t + 2) * kstep; const char* b2 = last ? nB : cB + (size_t)(t + 2) * kstep;
            const char* a3 = a2 + kstep; const char* b3 = b2 + kstep;
            PG8_LDB(B0, 0, 0); PG8_LDB(B1, 0, 1); PG8_SCHED; PG8_LDA(At, 0, 0); PG8_STAGE_A(PG8_SA(1, 1), a1, 1);
            if constexpr (GATHER) { if (last && has_next) { gA[0] = gN[0]; gA[1] = gN[1]; gA[2] = gN[2]; gA[3] = gN[3]; } }
            PG8_WAIT_V(8); PG8_WAIT_L(0); PG8_BAR; PG8_MMA(0, 0, At, B0); PG8_MMA(0, 1, At, B1); PG8_BAR; PG8_SCHED;
            PG8_LDA(At, 0, 1); PG8_STAGE(PG8_SB(0, 0), b2, voffB); PG8_STAGE(PG8_SB(0, 1), b2 + hstep, voffB); PG8_STAGE_A(PG8_SA(0, 0), a2, 0);
            PG8_WAIT_V(8); PG8_WAIT_L(0); PG8_BAR; PG8_MMA(1, 0, At, B0); PG8_MMA(1, 1, At, B1); PG8_BAR; PG8_SCHED;
            PG8_LDB(B0, 1, 0); PG8_LDB(B1, 1, 1); PG8_SCHED; PG8_LDA(At, 1, 0); PG8_STAGE_A(PG8_SA(0, 1), a2, 1);
            PG8_WAIT_V(8); PG8_WAIT_L(0); PG8_BAR; PG8_MMA(0, 0, At, B0); PG8_MMA(0, 1, At, B1); PG8_BAR; PG8_SCHED;
            PG8_LDA(At, 1, 1); PG8_STAGE(PG8_SB(1, 0), b3, voffB); PG8_STAGE(PG8_SB(1, 1), b3 + hstep, voffB); PG8_STAGE_A(PG8_SA(1, 0), a3, 0);
            PG8_WAIT_V(8); PG8_WAIT_L(0); PG8_BAR; PG8_MMA(1, 0, At, B0); PG8_MMA(1, 1, At, B1); PG8_BAR; PG8_SCHED;
        }
        if (wr == 0) PG8_BAR;
        E(acc, cur, wr, wc, fr, fq);
        if (!has_next) break;
#pragma unroll
        for (int a = 0; a < 2; ++a)
#pragma unroll
            for (int b = 0; b < 2; ++b)
#pragma unroll
                for (int m = 0; m < 4; ++m)
#pragma unroll
                    for (int n = 0; n < 2; ++n) acc[a][b][m][n] = (f32x4){0.f, 0.f, 0.f, 0.f};
        cur = nxt; cA = nA; cB = nB; ++ui;
        if (wr == 1) PG8_BAR;
    }
    PG8_WAIT_V(0);
    PG8_BAR;
#undef PG8_SA
#undef PG8_SB
#undef PG8_STAGE
#undef PG8_STAGE_A
#undef PG8_GLOAD
#undef PG8_LDA
#undef PG8_LDB
#undef PG8_MMA
#undef PG8_WAIT_V
#undef PG8_WAIT_L
#undef PG8_BAR
#undef PG8_SCHED
}

__device__ __forceinline__ bool static_next(int i, int G, int c, int nM, int nN, Unit& u) {
    const int nwg = nM * nN; const long L = (long)i * G + c; if (L >= nwg) return false;
    int wgid = (int)L; { const int q = nwg / NXCD, r = nwg % NXCD, xcd = wgid % NXCD, off = wgid / NXCD; wgid = (xcd < r ? xcd * (q + 1) : r * (q + 1) + (xcd - r) * q) + off; }
    const int nig = WGM * nN, gid = wgid / nig, fm = gid * WGM, gsz = (nM - fm) < WGM ? (nM - fm) : WGM;
    u.pm = fm + ((wgid % nig) % gsz); u.pn = (wgid % nig) / gsz; u.z = 0; return true;
}
struct PlainSched {
    const char* A; const char* Bt; int K, nM, nN, G, c; static constexpr const int* rowlist = nullptr;
    __device__ __forceinline__ bool next(int i, Unit& u) const { return static_next(i, G, c, nM, nN, u); }
    __device__ __forceinline__ const char* a_tile(const Unit& u) const { return A + (size_t)u.pm * 256 * K * 2; }
    __device__ __forceinline__ const char* b_tile(const Unit& u) const { return Bt + (size_t)u.pn * 256 * K * 2; }
};
struct PairSched {
    const char* A0; long dA; const char* B0; long dB; int K, nM, nN, G, c; static constexpr const int* rowlist = nullptr;
    __device__ __forceinline__ bool next(int i, Unit& u) const { const bool ok = static_next(i >> 1, G, c, nM, nN, u); u.z = i & 1; return ok; }
    __device__ __forceinline__ const char* a_tile(const Unit& u) const { return A0 + (long)u.z * dA + (size_t)u.pm * 256 * K * 2; }
    __device__ __forceinline__ const char* b_tile(const Unit& u) const { return B0 + (long)u.z * dB + (size_t)u.pn * 256 * K * 2; }
};
struct MoeSched {
    const char* A; const char* Bt; int K; size_t bstride; int ntiles, G, c; const LAS int* tile_e; const int* rowlist;
    __device__ __forceinline__ bool next(int i, Unit& u) const { const long L = (long)i * G + c; const int t = (int)(L >> 2); if (t >= ntiles) return false;
        u.pm = t; u.pn = (int)(L & 3); u.z = __builtin_amdgcn_readfirstlane(tile_e[t]); return true; }
    __device__ __forceinline__ const char* a_tile(const Unit& u) const { return rowlist ? A : A + (size_t)u.pm * 256 * K * 2; }
    __device__ __forceinline__ const char* b_tile(const Unit& u) const { return Bt + (size_t)u.z * bstride + (size_t)u.pn * 256 * K * 2; }
};
}
using pg8::Unit;

#define EPI_ROWS(u, wr, fr) const int row0_ = (u).pm * 256 + (wr) * 64 + (fr);
#define EPI_V8(v, acc, ai, bj, m) float v[8] = {acc[ai][bj][m][0][0], acc[ai][bj][m][0][1], acc[ai][bj][m][0][2], acc[ai][bj][m][0][3], acc[ai][bj][m][1][0], acc[ai][bj][m][1][1], acc[ai][bj][m][1][2], acc[ai][bj][m][1][3]}
__device__ __forceinline__ void store8_bf16(bf16_t* p, const float (&v)[8]) {
    u32x4 w; w.x = cvt_pk_bf16(v[0], v[1]); w.y = cvt_pk_bf16(v[2], v[3]); w.z = cvt_pk_bf16(v[4], v[5]); w.w = cvt_pk_bf16(v[6], v[7]);
    *(u32x4*)p = w;
}
__device__ __forceinline__ void rope8(float (&v)[8], int pos, int g, int fq, const LAS float* T) {
    const int p = g ? (pos & 63) : (pos >> 6);
    const LAS f32x4* t = (const LAS f32x4*)(T + p * 32 + (fq & 1) * 16);
    const f32x4 t0 = t[0], t1 = t[1], t2 = t[2], t3 = t[3];
    const float cs[8] = {t0[0], t0[2], t1[0], t1[2], t2[0], t2[2], t3[0], t3[2]};
    const float sn[8] = {t0[1], t0[3], t1[1], t1[3], t2[1], t2[3], t3[1], t3[3]};
    const bool lo = fq < 2;
#pragma unroll
    for (int i = 0; i < 8; ++i) { const float pv = xchg32(v[i], lo); v[i] = lo ? (v[i] * cs[i] - pv * sn[i]) : (v[i] * cs[i] + pv * sn[i]); }
}

struct EpiG1 {
    unsigned char* ws; const LAS float* rope;
    __device__ __forceinline__ void operator()(const f32x4 (&acc)[2][2][4][2], const Unit& u, int wr, int wc, int fr, int fq) const {
        EPI_ROWS(u, wr, fr)
        bf16_t* const qda = (bf16_t*)(ws + WS_QDA); bf16_t* const kda = (bf16_t*)(ws + WS_KDA); bf16_t* const vda = (bf16_t*)(ws + WS_VDA); bf16_t* const gates = (bf16_t*)(ws + WS_GATES);
        bf16_t* const cq = (bf16_t*)(ws + WS_CQ); bf16_t* const ckv = (bf16_t*)(ws + WS_CKV); bf16_t* const kr = (bf16_t*)(ws + WS_KR); float* const rowsq = (float*)(ws + WS_ROWSQ);
        const int pn = u.pn; const bool xrows = u.pm < (MX / 256);
        if (pn < 4) {
            bf16_t* dst = pn < 2 ? qda : kda; const int cb = (pn & 1) * 256 + wc * 32 + 8 * fq;
#pragma unroll
            for (int ai = 0; ai < 2; ++ai)
#pragma unroll
                for (int m = 0; m < 4; ++m) { const int row = row0_ + ai * 128 + m * 16;
#pragma unroll
                    for (int bj = 0; bj < 2; ++bj) { EPI_V8(v, acc, ai, bj, m); if (xrows) rope8(v, row & 4095, wc & 1, fq, rope); store8_bf16(dst + (size_t)row * 512 + cb + bj * 128, v); } }
        } else if (pn < 6) {
            const int cb = (pn - 4) * 256 + wc * 32 + 8 * fq;
#pragma unroll
            for (int ai = 0; ai < 2; ++ai)
#pragma unroll
                for (int m = 0; m < 4; ++m) { const int row = row0_ + ai * 128 + m * 16;
#pragma unroll
                    for (int bj = 0; bj < 2; ++bj) { EPI_V8(v, acc, ai, bj, m); store8_bf16(vda + (size_t)row * 512 + cb + bj * 128, v); } }
        } else if (pn < 14) {
            const int cb = (pn - 6) * 256 + wc * 32 + 8 * fq;
#pragma unroll
            for (int ai = 0; ai < 2; ++ai)
#pragma unroll
                for (int m = 0; m < 4; ++m) { const int row = row0_ + ai * 128 + m * 16;
#pragma unroll
                    for (int bj = 0; bj < 2; ++bj) { EPI_V8(v, acc, ai, bj, m);
#pragma unroll
                        for (int i = 0; i < 8; ++i) v[i] = sigmoidf_(v[i]);
                        store8_bf16(gates + (size_t)row * 2048 + cb + bj * 128, v); } }
        } else if (pn == 14) {
            const int cb = wc * 32 + 8 * fq;
#pragma unroll
            for (int ai = 0; ai < 2; ++ai)
#pragma unroll
                for (int m = 0; m < 4; ++m) { const int row = row0_ + ai * 128 + m * 16; float ss = 0.f;
#pragma unroll
                    for (int bj = 0; bj < 2; ++bj) { EPI_V8(v, acc, ai, bj, m);
#pragma unroll
                        for (int i = 0; i < 8; ++i) ss += v[i] * v[i];
                        store8_bf16(cq + (size_t)row * 384 + cb + bj * 128, v); }
                    ss += shx(ss, 16, fq * 16 + fr); ss += shx(ss, 32, fq * 16 + fr);
                    if (fq == 0) rowsq[(size_t)row * 12 + wc] = ss; }
        } else if (pn == 15) {
            const int cb = wc * 32 + 8 * fq;
#pragma unroll
            for (int ai = 0; ai < 2; ++ai)
#pragma unroll
                for (int m = 0; m < 4; ++m) { const int row = row0_ + ai * 128 + m * 16; float ss = 0.f;
                    { EPI_V8(v, acc, ai, 0, m);
#pragma unroll
                        for (int i = 0; i < 8; ++i) ss += v[i] * v[i];
                        store8_bf16(cq + (size_t)row * 384 + 256 + cb, v); }
                    ss += shx(ss, 16, fq * 16 + fr); ss += shx(ss, 32, fq * 16 + fr);
                    if (fq == 0) rowsq[(size_t)row * 12 + 4 + wc] = ss;
                    if (wc < 2) { EPI_V8(v, acc, ai, 1, m); if (xrows) rope8(v, row & 4095, wc, fq, rope); store8_bf16(kr + (size_t)row * 64 + cb, v); } }
        } else {
            const int cb = wc * 32 + 8 * fq;
#pragma unroll
            for (int ai = 0; ai < 2; ++ai)
#pragma unroll
                for (int m = 0; m < 4; ++m) { const int row = row0_ + ai * 128 + m * 16; float ss = 0.f;
#pragma unroll
                    for (int bj = 0; bj < 2; ++bj) { EPI_V8(v, acc, ai, bj, m);
#pragma unroll
                        for (int i = 0; i < 8; ++i) ss += v[i] * v[i];
                        store8_bf16(ckv + (size_t)row * 256 + cb + bj * 128, v); }
                    ss += shx(ss, 16, fq * 16 + fr); ss += shx(ss, 32, fq * 16 + fr);
                    if (fq == 0) rowsq[(size_t)row * 12 + 8 + wc] = ss; }
        }
    }
};
struct EpiQMla {
    unsigned char* ws; const LAS float* rope;
    __device__ __forceinline__ void operator()(const f32x4 (&acc)[2][2][4][2], const Unit& u, int wr, int wc, int fr, int fq) const {
        EPI_ROWS(u, wr, fr)
        bf16_t* const qmla = (bf16_t*)(ws + WS_QMLA); const float* const rowsq = (const float*)(ws + WS_ROWSQ);
        const bool xrows = u.pm < (MX / 256);
#pragma unroll
        for (int ai = 0; ai < 2; ++ai)
#pragma unroll
            for (int m = 0; m < 4; ++m) { const int row = row0_ + ai * 128 + m * 16;
                const f32x4 q0_ = *(const f32x4*)(rowsq + (size_t)row * 12), q1_ = *(const f32x4*)(rowsq + (size_t)row * 12 + 4);
                const float sc = rsqrtf((((q0_[0] + q0_[1]) + (q0_[2] + q0_[3])) + ((q1_[0] + q1_[1]) + (q1_[2] + q1_[3]))) * (1.0f / 384.0f) + EPS);
#pragma unroll
                for (int bj = 0; bj < 2; ++bj) { const int g32 = u.pn * 8 + bj * 4 + wc, j = g32 % 6;
                    EPI_V8(v, acc, ai, bj, m);
#pragma unroll
                    for (int i = 0; i < 8; ++i) v[i] *= sc;
                    if (xrows && j >= 4) rope8(v, row & 4095, j - 4, fq, rope);
                    store8_bf16(qmla + (size_t)row * 768 + g32 * 32 + 8 * fq, v); } }
    }
};
struct EpiKvMla {
    unsigned char* ws;
    __device__ __forceinline__ void operator()(const f32x4 (&acc)[2][2][4][2], const Unit& u, int wr, int wc, int fr, int fq) const {
        EPI_ROWS(u, wr, fr)
        bf16_t* const kvmla = (bf16_t*)(ws + WS_KVMLA); const float* const rowsq = (const float*)(ws + WS_ROWSQ);
        const int cb = u.pn * 256 + wc * 32 + 8 * fq;
#pragma unroll
        for (int ai = 0; ai < 2; ++ai)
#pragma unroll
            for (int m = 0; m < 4; ++m) { const int row = row0_ + ai * 128 + m * 16;
                const f32x4 q2_ = *(const f32x4*)(rowsq + (size_t)row * 12 + 8);
                const float sc = rsqrtf(((q2_[0] + q2_[1]) + (q2_[2] + q2_[3])) * (1.0f / 256.0f) + EPS);
#pragma unroll
                for (int bj = 0; bj < 2; ++bj) { EPI_V8(v, acc, ai, bj, m);
#pragma unroll
                    for (int i = 0; i < 8; ++i) v[i] *= sc;
                    store8_bf16(kvmla + (size_t)row * 1024 + cb + bj * 128, v); } }
    }
};
struct EpiBranch {
    unsigned char* ws;
    __device__ __forceinline__ void operator()(const f32x4 (&acc)[2][2][4][2], const Unit& u, int wr, int wc, int fr, int fq) const {
        EPI_ROWS(u, wr, fr)
        bf16_t* const U = (bf16_t*)(ws + WS_U); const bf16_t* const gates = (const bf16_t*)(ws + WS_GATES);
        const int cb = u.pn * 256 + wc * 32 + 8 * fq;
#pragma unroll
        for (int ai = 0; ai < 2; ++ai)
#pragma unroll
            for (int m = 0; m < 4; ++m) { const int row = row0_ + ai * 128 + m * 16;
#pragma unroll
                for (int bj = 0; bj < 2; ++bj) { const int col = cb + bj * 128; EPI_V8(v, acc, ai, bj, m);
                    const u32x4 g = *(const u32x4*)(gates + (size_t)row * 2048 + (u.z ? 1024 : 0) + col);
                    const float gv[8] = {bf_lo(g.x), bf_hi(g.x), bf_lo(g.y), bf_hi(g.y), bf_lo(g.z), bf_hi(g.z), bf_lo(g.w), bf_hi(g.w)};
                    bf16_t* up = U + (size_t)row * 1024 + col;
                    if (u.z) { const u32x4 o = *(const u32x4*)up; const float ov[8] = {bf_lo(o.x), bf_hi(o.x), bf_lo(o.y), bf_hi(o.y), bf_lo(o.z), bf_hi(o.z), bf_lo(o.w), bf_hi(o.w)};
#pragma unroll
                        for (int i = 0; i < 8; ++i) v[i] = ov[i] + gv[i] * v[i]; }
                    else {
#pragma unroll
                        for (int i = 0; i < 8; ++i) v[i] = gv[i] * v[i]; }
                    store8_bf16(up, v); } }
    }
};
struct EpiOut {
    float* XS; const float* xin; const float* ctx; const float* mod_l; int first;
    __device__ __forceinline__ void operator()(const f32x4 (&acc)[2][2][4][2], const Unit& u, int wr, int wc, int fr, int fq) const {
        EPI_ROWS(u, wr, fr)
        const int cb = u.pn * 256 + wc * 32 + 8 * fq;
        const bool xrows = u.pm < (MX / 256);
        const int bidx = xrows ? (u.pm >> 4) : 8;
        const float* g1 = mod_l + (size_t)bidx * 6144 + 2048;
        const float* base = first ? (xrows ? xin : ctx - (size_t)MX * 1024) : XS;
#pragma unroll
        for (int bj = 0; bj < 2; ++bj) { const int col = cb + bj * 128;
            const f32x4 ga = *(const f32x4*)(g1 + col), gb = *(const f32x4*)(g1 + col + 4);
#pragma unroll
            for (int ai = 0; ai < 2; ++ai)
#pragma unroll
                for (int m = 0; m < 4; ++m) { const size_t off = (size_t)(row0_ + ai * 128 + m * 16) * 1024 + col;
                    const f32x4 b0 = *(const f32x4*)(base + off), b1 = *(const f32x4*)(base + off + 4);
                    *(f32x4*)(XS + off) = b0 + ga * acc[ai][bj][m][0]; *(f32x4*)(XS + off + 4) = b1 + gb * acc[ai][bj][m][1]; } }
    }
};
struct EpiUp {
    bf16_t* act; const float* bgu;
    __device__ __forceinline__ void operator()(const f32x4 (&acc)[2][2][4][2], const Unit& u, int wr, int wc, int fr, int fq) const {
        EPI_ROWS(u, wr, fr)
        const int j0 = u.pn * 128 + wc * 32 + 8 * fq;
        const float* bg = bgu + (size_t)u.z * 1024 + j0;
        const f32x4 g0 = *(const f32x4*)bg, g1 = *(const f32x4*)(bg + 4), l0 = *(const f32x4*)(bg + 512), l1 = *(const f32x4*)(bg + 516);
        const float bgv[8] = {g0[0], g0[1], g0[2], g0[3], g1[0], g1[1], g1[2], g1[3]}, blv[8] = {l0[0], l0[1], l0[2], l0[3], l1[0], l1[1], l1[2], l1[3]};
#pragma unroll
        for (int ai = 0; ai < 2; ++ai)
#pragma unroll
            for (int m = 0; m < 4; ++m) { const int row = row0_ + ai * 128 + m * 16;
                EPI_V8(gt, acc, ai, 0, m); EPI_V8(ln, acc, ai, 1, m); float o[8];
#pragma unroll
                for (int i = 0; i < 8; ++i) { const float g = fminf(gt[i] + bgv[i], 7.0f); const float li = fminf(fmaxf(ln[i] + blv[i], -7.0f), 7.0f);
                    o[i] = (li + 1.0f) * g * sigmoidf_(1.702f * g); }
                store8_bf16(act + (size_t)row * 512 + j0, o); }
    }
};
struct EpiDown {
    bf16_t* Y; const float* bdn;
    __device__ __forceinline__ void operator()(const f32x4 (&acc)[2][2][4][2], const Unit& u, int wr, int wc, int fr, int fq) const {
        EPI_ROWS(u, wr, fr)
        const int cb = u.pn * 256 + wc * 32 + 8 * fq;
#pragma unroll
        for (int bj = 0; bj < 2; ++bj) { const int col = cb + bj * 128; const float* bp = bdn + (size_t)u.z * 1024 + col;
            const f32x4 b0 = *(const f32x4*)bp, b1 = *(const f32x4*)(bp + 4);
#pragma unroll
            for (int ai = 0; ai < 2; ++ai)
#pragma unroll
                for (int m = 0; m < 4; ++m) { const int row = row0_ + ai * 128 + m * 16;
                    const f32x4 a0 = acc[ai][bj][m][0] + b0, a1 = acc[ai][bj][m][1] + b1;
                    const float v[8] = {a0[0], a0[1], a0[2], a0[3], a1[0], a1[1], a1[2], a1[3]};
                    store8_bf16(Y + (size_t)row * 1024 + col, v); } }
    }
};

namespace att {
constexpr int NW = 8, QBLK = 32, KVBLK = 64;
constexpr int SHM_V = 16384, SHM_KR = 8192, SHM_KN = 16384;
constexpr int OFF_V = 0, OFF_KR = 2 * SHM_V, OFF_KN = OFF_KR + 2 * SHM_KR, OFF_WS = OFF_KN + 2 * SHM_KN;
constexpr float THR = 8.f;
#define KSWZN(row, colB) ((row) * 256 + ((colB) ^ (((row) & 15) << 4)))
#define KSWZR(row, colB) ((row) * 128 + ((colB) ^ ((((row) >> 1) & 7) << 4)))
#define SBAR() __builtin_amdgcn_sched_barrier(0)
__device__ __forceinline__ int crow(int r, int hi) { return (r & 3) + 8 * (r >> 2) + 4 * hi; }
template <int DN> struct SC { static constexpr float SCALE = DN ? 0.07216878364870322f : 0.125f; };
template <int DN>
__device__ __forceinline__ void partialSM(f32x16& p0, f32x16& p1, float& m_reg, float& mn, float& alpha) {
    constexpr float SCALE = SC<DN>::SCALE, C = SCALE * 1.4426950408889634f;
    float pmax = p0[0];
#pragma unroll
    for (int r = 1; r < 16; ++r) pmax = fmaxf(pmax, p0[r]);
#pragma unroll
    for (int r = 0; r < 16; ++r) pmax = fmaxf(pmax, p1[r]);
    { auto rr = __builtin_amdgcn_permlane32_swap(__float_as_uint(pmax), __float_as_uint(pmax), false, false);
      pmax = fmaxf(__uint_as_float(rr[0]), __uint_as_float(rr[1])); }
    if (__builtin_expect(__all(pmax - m_reg <= THR / SCALE), 1)) { mn = m_reg; alpha = 1.f; }
    else { mn = fmaxf(m_reg, pmax); alpha = __builtin_amdgcn_exp2f((m_reg - mn) * C); m_reg = mn; }
    const float mnC = -mn * C;
#pragma unroll
    for (int r = 0; r < 16; ++r) p0[r] = fmaf(p0[r], C, mnC);
#pragma unroll
    for (int r = 0; r < 16; ++r) p1[r] = fmaf(p1[r], C, mnC);
#pragma unroll
    for (int r = 0; r < 16; ++r) p0[r] = __builtin_amdgcn_exp2f(p0[r]);
}
__device__ __forceinline__ void finishSM(f32x16& p0, f32x16& p1, float alpha, float& l_reg, bf16x8& pa0, bf16x8& pa1, bf16x8& pa2, bf16x8& pa3) {
#pragma unroll
    for (int r = 0; r < 16; ++r) p1[r] = __builtin_amdgcn_exp2f(p1[r]);
    float ps = 0;
#pragma unroll
    for (int r = 0; r < 16; ++r) ps += p0[r];
#pragma unroll
    for (int r = 0; r < 16; ++r) ps += p1[r];
    { auto rr = __builtin_amdgcn_permlane32_swap(__float_as_uint(ps), __float_as_uint(ps), false, false);
      ps = __uint_as_float(rr[0]) + __uint_as_float(rr[1]); }
    l_reg = l_reg * alpha + ps;
#define PK4(P, BASE, OUT) do { unsigned a0 = cvt_pk_bf16(P[BASE + 0], P[BASE + 1]), a1 = cvt_pk_bf16(P[BASE + 2], P[BASE + 3]);   \
    unsigned b0 = cvt_pk_bf16(P[BASE + 4], P[BASE + 5]), b1 = cvt_pk_bf16(P[BASE + 6], P[BASE + 7]);                              \
    auto r0 = __builtin_amdgcn_permlane32_swap(a0, b0, false, false); auto r1 = __builtin_amdgcn_permlane32_swap(a1, b1, false, false); \
    u32x4 w = {r0[0], r1[0], r0[1], r1[1]}; OUT = *reinterpret_cast<bf16x8*>(&w); } while (0)
    PK4(p0, 0, pa0); PK4(p0, 8, pa1); PK4(p1, 0, pa2); PK4(p1, 8, pa3);
#undef PK4
}
template <int DN>
__device__ __forceinline__ void qkt(f32x16& p0, f32x16& p1, const char* Kn, const char* Kr, const bf16x8* qn, const bf16x8* qr, int r32, int hi) {
    p0 = f32x16{}; p1 = f32x16{};
    if constexpr (DN > 0) {
#pragma unroll
        for (int d0 = 0; d0 < DN / 16; ++d0) { const int cb = d0 * 32 + hi * 16;
            const bf16x8 b0 = *reinterpret_cast<const bf16x8*>(Kn + KSWZN(r32, cb));
            const bf16x8 b1 = *reinterpret_cast<const bf16x8*>(Kn + KSWZN(32 + r32, cb));
            p0 = __builtin_amdgcn_mfma_f32_32x32x16_bf16(b0, qn[d0], p0, 0, 0, 0);
            p1 = __builtin_amdgcn_mfma_f32_32x32x16_bf16(b1, qn[d0], p1, 0, 0, 0); }
    }
#pragma unroll
    for (int d0 = 0; d0 < 4; ++d0) { const int cb = d0 * 32 + hi * 16;
        const bf16x8 b0 = *reinterpret_cast<const bf16x8*>(Kr + KSWZR(r32, cb));
        const bf16x8 b1 = *reinterpret_cast<const bf16x8*>(Kr + KSWZR(32 + r32, cb));
        p0 = __builtin_amdgcn_mfma_f32_32x32x16_bf16(b0, qr[d0], p0, 0, 0, 0);
        p1 = __builtin_amdgcn_mfma_f32_32x32x16_bf16(b1, qr[d0], p1, 0, 0, 0); }
}
__device__ __forceinline__ int v_st(int k, int c) { const int kk = (k & ~0xC) | ((k & 4) << 1) | ((k & 8) >> 1); return ((kk >> 3) * 4 + (c >> 5)) * 512 + ((kk & 7) * 32 + (c & 31)) * 2; }
__device__ __forceinline__ int v_rd_base(int lane) { return ((lane & 3) << 3) | (((lane >> 2) & 3) << 6) | (((lane >> 4) & 1) << 5) | (((lane >> 5) & 1) << 8); }
constexpr int v_rd_off(int d0, int ks, int half) { return d0 * 512 + ks * 4096 + half * 2048; }
template <int OFF> __device__ __forceinline__ s16x4 tr_read(int vb) {
    s16x4 r; asm volatile("ds_read_b64_tr_b16 %0, %1 offset:%2" : "=&v"(r) : "v"(vb), "i"(OFF) : "memory"); return r;
}
template <int D0> __device__ __forceinline__ void pv_one(f32x16& od, int vb, bf16x8 pa0, bf16x8 pa1, bf16x8 pa2, bf16x8 pa3) {
    const s16x4 l0 = tr_read<v_rd_off(D0, 0, 0)>(vb), h0 = tr_read<v_rd_off(D0, 0, 1)>(vb), l1 = tr_read<v_rd_off(D0, 1, 0)>(vb), h1 = tr_read<v_rd_off(D0, 1, 1)>(vb);
    const s16x4 l2 = tr_read<v_rd_off(D0, 2, 0)>(vb), h2 = tr_read<v_rd_off(D0, 2, 1)>(vb), l3 = tr_read<v_rd_off(D0, 3, 0)>(vb), h3 = tr_read<v_rd_off(D0, 3, 1)>(vb);
    asm volatile("s_waitcnt lgkmcnt(0)" ::: "memory"); SBAR();
#define PK(L, H) (bf16x8){L[0], L[1], L[2], L[3], H[0], H[1], H[2], H[3]}
    od = __builtin_amdgcn_mfma_f32_32x32x16_bf16(pa0, PK(l0, h0), od, 0, 0, 0);
    od = __builtin_amdgcn_mfma_f32_32x32x16_bf16(pa1, PK(l1, h1), od, 0, 0, 0);
    od = __builtin_amdgcn_mfma_f32_32x32x16_bf16(pa2, PK(l2, h2), od, 0, 0, 0);
    od = __builtin_amdgcn_mfma_f32_32x32x16_bf16(pa3, PK(l3, h3), od, 0, 0, 0);
#undef PK
}
__device__ __forceinline__ void pv_d0(f32x16* o, int vb, bf16x8 pa0, bf16x8 pa1, bf16x8 pa2, bf16x8 pa3) {
    pv_one<0>(o[0], vb, pa0, pa1, pa2, pa3); pv_one<1>(o[1], vb, pa0, pa1, pa2, pa3); pv_one<2>(o[2], vb, pa0, pa1, pa2, pa3); pv_one<3>(o[3], vb, pa0, pa1, pa2, pa3);
}
template <int DN, int LDQ, int LDKN, int LDKR, int LDV, int LDO, int SDEPTH>
__device__ __forceinline__ void attn_unit(const bf16_t* __restrict__ Qn, const bf16_t* __restrict__ Qr, const bf16_t* __restrict__ Kng, const bf16_t* __restrict__ Krg,
                                          const bf16_t* __restrict__ Vg, bf16_t* __restrict__ Ob, const int q0, const int kx0, const int ky0, const int ntx, const int NT, char* lds) {
    const int tid = opaque_tid(), wid = tid >> 6, lane = tid & 63, r32 = lane & 31, hi = lane >> 5;
    char* V_lds = lds + OFF_V; char* KR_lds = lds + OFF_KR; char* KN_lds = lds + OFF_KN;
    float* ws = (float*)(lds + OFF_WS) + wid * 64; float* li_l = ws; float* al_l = ws + 32;
    float m_reg = -1e30f, l_reg = 0; f32x16 o[4] = {}; bf16x8 qn[DN ? DN / 16 : 1], qr[4];
    { const size_t qrow = (size_t)(q0 + wid * QBLK + r32);
      if constexpr (DN > 0) {
#pragma unroll
          for (int d0 = 0; d0 < DN / 16; ++d0) qn[d0] = *reinterpret_cast<const bf16x8*>(Qn + qrow * LDQ + hi * 8 + d0 * 16);
      }
#pragma unroll
      for (int d0 = 0; d0 < 4; ++d0) qr[d0] = *reinterpret_cast<const bf16x8*>(Qr + qrow * LDQ + hi * 8 + d0 * 16); }
    const int sr = tid >> 4, sc = (tid & 15) * 8, vst0 = v_st(sr, sc), vst1 = v_st(32 + sr, sc);
    const int rr_ = tid >> 3, rc_ = (tid & 7) * 8;
    const int vb0 = (int)(uintptr_t)V_lds + v_rd_base(lane);
    struct { bf16x8 vs0, vs1, kn0, kn1, kr0; } st_[SDEPTH];
#define KROW(j) __builtin_amdgcn_readfirstlane((j) < ntx ? kx0 + (j) * KVBLK : ky0 + ((j) - ntx) * KVBLK)
    const unsigned ovV0 = (unsigned)(sr * LDV + sc) * 2u, ovV1 = (unsigned)((32 + sr) * LDV + sc) * 2u, ovN0 = (unsigned)(sr * LDKN + sc) * 2u, ovN1 = (unsigned)((32 + sr) * LDKN + sc) * 2u, ovR = (unsigned)(rr_ * LDKR + rc_) * 2u;
#define SLOAD(i, j) do { const size_t k0_ = (size_t)KROW(j); const char* vb_ = (const char*)(Vg + k0_ * LDV); const char* rb_ = (const char*)(Krg + k0_ * LDKR); \
    st_[i].vs0 = *reinterpret_cast<const bf16x8*>(vb_ + ovV0); st_[i].vs1 = *reinterpret_cast<const bf16x8*>(vb_ + ovV1); \
    if constexpr (DN > 0) { const char* nb_ = (const char*)(Kng + k0_ * LDKN); st_[i].kn0 = *reinterpret_cast<const bf16x8*>(nb_ + ovN0); st_[i].kn1 = *reinterpret_cast<const bf16x8*>(nb_ + ovN1); } \
    st_[i].kr0 = *reinterpret_cast<const bf16x8*>(rb_ + ovR); } while (0)
#define SWRITE(b, i) do { *(bf16x8*)(V_lds + (b) * SHM_V + vst0) = st_[i].vs0; *(bf16x8*)(V_lds + (b) * SHM_V + vst1) = st_[i].vs1; \
    if constexpr (DN > 0) { *(bf16x8*)(KN_lds + (b) * SHM_KN + KSWZN(sr, sc * 2)) = st_[i].kn0; *(bf16x8*)(KN_lds + (b) * SHM_KN + KSWZN(32 + sr, sc * 2)) = st_[i].kn1; } \
    *(bf16x8*)(KR_lds + (b) * SHM_KR + KSWZR(rr_, rc_ * 2)) = st_[i].kr0; } while (0)
#define SWAIT() do { if constexpr (SDEPTH == 2) { if constexpr (DN > 0) asm volatile("s_waitcnt vmcnt(5)" ::: "memory"); else asm volatile("s_waitcnt vmcnt(3)" ::: "memory"); } else asm volatile("s_waitcnt vmcnt(0)" ::: "memory"); } while (0)
#define RESC(a) do { if (__any((a) < 1.f)) { if (hi == 0) al_l[r32] = (a); asm volatile("s_waitcnt lgkmcnt(0)" ::: "memory"); \
    _Pragma("unroll") for (int d = 0; d < 4; ++d) _Pragma("unroll") for (int r = 0; r < 16; ++r) o[d][r] *= al_l[crow(r, hi)]; } } while (0)
    f32x16 pA0, pA1, pB0, pB1; float mnA, mnB, alA, alB; bf16x8 pa0, pa1, pa2, pa3;
    constexpr int SE = 0, SO = SDEPTH - 1;
    SLOAD(SE, 0); asm volatile("s_waitcnt vmcnt(0)" ::: "memory"); SWRITE(0, SE); __syncthreads();
    qkt<DN>(pA0, pA1, KN_lds, KR_lds, qn, qr, r32, hi); partialSM<DN>(pA0, pA1, m_reg, mnA, alA);
    SLOAD(SO, 1); if constexpr (SDEPTH == 2) { if (2 < NT) SLOAD(SE, 2); }
    SWAIT(); SWRITE(1, SO); __syncthreads();
    for (int j = 1; j + 1 < NT; j += 2) {
        SBAR(); qkt<DN>(pB0, pB1, KN_lds + SHM_KN, KR_lds + SHM_KR, qn, qr, r32, hi);
        finishSM(pA0, pA1, alA, l_reg, pa0, pa1, pa2, pa3); SBAR();
        SLOAD(SO, j + SDEPTH); SBAR();
        pv_d0(o, vb0, pa0, pa1, pa2, pa3); partialSM<DN>(pB0, pB1, m_reg, mnB, alB);
        __syncthreads(); SWAIT(); SWRITE(0, SE);
        RESC(alB); __syncthreads();
        SBAR(); qkt<DN>(pA0, pA1, KN_lds, KR_lds, qn, qr, r32, hi);
        finishSM(pB0, pB1, alB, l_reg, pa0, pa1, pa2, pa3); SBAR();
        if (SDEPTH == 1 || j + 3 < NT) SLOAD(SE, j + 1 + SDEPTH); SBAR();
        pv_d0(o, vb0 + SHM_V, pa0, pa1, pa2, pa3); partialSM<DN>(pA0, pA1, m_reg, mnA, alA);
        __syncthreads(); SWAIT(); SWRITE(1, SO);
        RESC(alA); __syncthreads();
    }
    SBAR(); qkt<DN>(pB0, pB1, KN_lds + SHM_KN, KR_lds + SHM_KR, qn, qr, r32, hi);
    finishSM(pA0, pA1, alA, l_reg, pa0, pa1, pa2, pa3); SBAR();
    pv_d0(o, vb0, pa0, pa1, pa2, pa3); partialSM<DN>(pB0, pB1, m_reg, mnB, alB);
    __syncthreads(); RESC(alB);
    finishSM(pB0, pB1, alB, l_reg, pa0, pa1, pa2, pa3); SBAR();
    pv_d0(o, vb0 + SHM_V, pa0, pa1, pa2, pa3);
    if (hi == 0) li_l[r32] = l_reg; asm volatile("s_waitcnt lgkmcnt(0)" ::: "memory");
    const int tz = opaque_tid(), wid2 = tz >> 6, r32b = tz & 31, hib = (tz >> 5) & 1;
    const float* li2 = (const float*)(lds + OFF_WS) + wid2 * 64;
    float rli[16];
#pragma unroll
    for (int r = 0; r < 16; ++r) rli[r] = __builtin_amdgcn_rcpf(li2[crow(r, hib)]);
    bf16_t* Ow = Ob + (size_t)(q0 + wid2 * QBLK) * LDO;
#pragma unroll
    for (int r = 0; r < 16; ++r) { const int orow = crow(r, hib);
#pragma unroll
        for (int d0 = 0; d0 < 4; ++d0) { const unsigned w = cvt_pk_bf16(o[d0][r] * rli[r], 0.f); Ow[(size_t)orow * LDO + d0 * 32 + r32b] = (bf16_t)(w & 0xffffu); } }
    __syncthreads();
#undef KROW
#undef SLOAD
#undef SWRITE
#undef SWAIT
#undef RESC
}
}

struct Params { const float* in[28]; float* out; unsigned char* ws; int ph_lo, ph_hi; };
struct Ctx { LAS unsigned char* lds; char* ldsg; int tid, lane, wave, vcu, G; unsigned char* ws; };
enum { I_X = 0, I_C, I_CTX, I_CCTX, I_ADAW, I_ADAB, I_N1G, I_N2G, I_WIN, I_LQ1, I_LK1, I_LQ2, I_LK2, I_SUBLN, I_QAG, I_KVAG, I_WQB, I_WKVB, I_WBRA, I_WBRB, I_WOUT, I_RW, I_RB, I_WGU, I_BGU, I_WDN, I_BDN, I_FG };
template <typename T> __device__ __forceinline__ T* wsp(const Ctx& C, size_t off) { return (T*)(C.ws + off); }
constexpr int PTRTAB_OFF = MISC_OFF + 3072;
__device__ __forceinline__ const float* inp(const Ctx& C, int i) {
    const unsigned long long v = ((volatile LAS unsigned long long*)(C.lds + PTRTAB_OFF))[i];
    const unsigned lo = __builtin_amdgcn_readfirstlane((unsigned)v), hi = __builtin_amdgcn_readfirstlane((unsigned)(v >> 32));
    return (const float*)(((unsigned long long)hi << 32) | lo);
}

__device__ __forceinline__ void p0_transpose_item(const float* W, int K, int N, bf16_t* WT, int k0, int n0d, int n0s, const float* gain, LAS float* scr, int lane) {
    float w_[32];
#pragma unroll
    for (int i = 0; i < 32; ++i) { const int kk = 2 * i + (lane >> 5); w_[i] = (n0s >= 0) ? W[(size_t)(k0 + kk) * N + n0s + (lane & 31)] : 0.f; }
    if (gain) {
#pragma unroll
        for (int i = 0; i < 32; ++i) w_[i] *= gain[k0 + 2 * i + (lane >> 5)]; }
#pragma unroll
    for (int i = 0; i < 32; ++i) scr[(2 * i + (lane >> 5)) * 33 + (lane & 31)] = w_[i];
    LDS_WAIT(); asm volatile("" ::: "memory");
    const int c = lane & 7;
#pragma unroll
    for (int j = 0; j < 4; ++j) { const int n = (lane >> 3) + 8 * j; const LAS float* s = scr + (8 * c) * 33 + n;
        u32x4 o; o.x = cvt_pk_bf16(s[0 * 33], s[1 * 33]); o.y = cvt_pk_bf16(s[2 * 33], s[3 * 33]); o.z = cvt_pk_bf16(s[4 * 33], s[5 * 33]); o.w = cvt_pk_bf16(s[6 * 33], s[7 * 33]);
        *(u32x4*)(WT + (size_t)(n0d + n) * K + k0 + 8 * c) = o; }
    LDS_WAIT(); asm volatile("" ::: "memory");
}
__device__ __forceinline__ int win_src_col(int n) {
    if (n < 1536) return n; if (n < 3584) return 2240 + (n - 1536); if (n < 3968) return 1536 + (n - 3584);
    if (n < 4032) return 2176 + (n - 3968); if (n < 4096) return -1; return 1920 + (n - 4096);
}
__device__ __forceinline__ void phase_prologue(const Params& P, const Ctx& C0) {
    Ctx C = C0; { const int t_ = opaque_tid(); C.tid = t_; C.lane = t_ & 63; C.wave = __builtin_amdgcn_readfirstlane(t_ >> 6); asm volatile("" : "+s"(C.ws)); asm volatile("" : "+s"(C.vcu)); asm volatile("" : "+s"(C.G)); }
    LAS float* scr = (LAS float*)(C.lds + C.wave * 8448);
    const int gw = C.vcu * 8 + C.wave, NGW = C.G * 8;
    constexpr int I_IN = 16 * (NIN / 32), I_QB = 6 * 24, I_KVB = 4 * 32, I_BR = 8 * 32, I_OUT = 16 * 32, I_GU = 32 * 16 * 32, I_DN = 32 * 8 * 32;
    constexpr int PER_L = I_IN + I_QB + I_KVB + 2 * I_BR + I_OUT + I_GU + I_DN;
    for (int it = gw; it < DEPTH * PER_L; it += NGW) {
        const int l = it / PER_L; int r = it % PER_L;
        if (r < I_IN) { const int nb = r % (NIN / 32), kb = r / (NIN / 32);
            p0_transpose_item(inp(C, I_WIN) + (size_t)l * 1024 * 4288, 1024, 4288, wsp<bf16_t>(C, WS_WIN) + (size_t)l * NIN * 1024, kb * 64, nb * 32, win_src_col(nb * 32), nullptr, scr, C.lane); continue; } r -= I_IN;
        if (r < I_QB) { const int nb = r % 24, kb = r / 24;
            p0_transpose_item(inp(C, I_WQB) + (size_t)l * 384 * 768, 384, 768, wsp<bf16_t>(C, WS_WQB) + (size_t)l * 768 * 384, kb * 64, nb * 32, nb * 32, inp(C, I_QAG) + l * 384, scr, C.lane); continue; } r -= I_QB;
        if (r < I_KVB) { const int nb = r % 32, kb = r / 32;
            p0_transpose_item(inp(C, I_WKVB) + (size_t)l * 256 * 1024, 256, 1024, wsp<bf16_t>(C, WS_WKVB) + (size_t)l * 1024 * 256, kb * 64, nb * 32, nb * 32, inp(C, I_KVAG) + l * 256, scr, C.lane); continue; } r -= I_KVB;
        if (r < I_BR) { const int nb = r % 32, kb = r / 32;
            p0_transpose_item(inp(C, I_WBRA) + (size_t)l * 512 * 1024, 512, 1024, wsp<bf16_t>(C, WS_WBRA) + (size_t)l * 1024 * 512, kb * 64, nb * 32, nb * 32, nullptr, scr, C.lane); continue; } r -= I_BR;
        if (r < I_BR) { const int nb = r % 32, kb = r / 32;
            p0_transpose_item(inp(C, I_WBRB) + (size_t)l * 512 * 1024, 512, 1024, wsp<bf16_t>(C, WS_WBRB) + (size_t)l * 1024 * 512, kb * 64, nb * 32, nb * 32, nullptr, scr, C.lane); continue; } r -= I_BR;
        if (r < I_OUT) { const int nb = r % 32, kb = r / 32;
            p0_transpose_item(inp(C, I_WOUT) + (size_t)l * 1024 * 1024, 1024, 1024, wsp<bf16_t>(C, WS_WOUT) + (size_t)l * 1024 * 1024, kb * 64, nb * 32, nb * 32, nullptr, scr, C.lane); continue; } r -= I_OUT;
        if (r < I_GU) { const int e = r / 512, q = r % 512, nb = q % 32, kb = q / 32; const int n0 = nb * 32;
            const int src = 512 * ((n0 >> 7) & 1) + 128 * (n0 >> 8) + (n0 & 127);
            p0_transpose_item(inp(C, I_WGU) + ((size_t)l * 32 + e) * 1024 * 1024, 1024, 1024, wsp<bf16_t>(C, WS_WGU) + ((size_t)l * 32 + e) * 1024 * 1024, kb * 64, n0, src, nullptr, scr, C.lane); continue; } r -= I_GU;
        { const int e = r / 256, q = r % 256, nb = q % 32, kb = q / 32;
            p0_transpose_item(inp(C, I_WDN) + ((size_t)l * 32 + e) * 512 * 1024, 512, 1024, wsp<bf16_t>(C, WS_WDN) + ((size_t)l * 32 + e) * 1024 * 512, kb * 64, nb * 32, nb * 32, nullptr, scr, C.lane); }
    }
    { float* rwt = wsp<float>(C, WS_RWT); const float* rw = inp(C, I_RW);
      for (int i = C.vcu * 512 + C.tid; i < DEPTH * 32 * 1024; i += C.G * 512) { const int l = i >> 15, e = (i >> 10) & 31, d = i & 1023; rwt[i] = rw[((size_t)l * 1024 + d) * 32 + e]; }
 }
    __syncthreads();
    { LAS float* s = (LAS float*)(C.lds + 69632); LAS float* red = (LAS float*)(C.lds + 106496);
      const float* const cc = inp(C, I_C); const float* const cx = inp(C, I_CCTX);
      for (int i = C.tid; i < 9 * 1024; i += 512) { const float v = i < 8192 ? cc[i] : cx[i - 8192]; s[i] = v / (1.0f + __expf(-v)); }
      __syncthreads();
      const int cl = C.tid & 31, kg = C.tid >> 5; float* MOD = wsp<float>(C, WS_MOD); const float* const adaw = inp(C, I_ADAW); const float* const adab = inp(C, I_ADAB);
      for (int blk = C.vcu; blk < DEPTH * 192; blk += C.G) { const int l = blk / 192, col = (blk % 192) * 32 + cl;
          const float* w = adaw + (size_t)l * 1024 * 6144 + col; float a[9];
#pragma unroll
          for (int r = 0; r < 9; ++r) a[r] = 0.f;
#pragma unroll 16
          for (int kk = 0; kk < 64; ++kk) { const int k = kg * 64 + kk; const float wv = w[(size_t)k * 6144];
#pragma unroll
              for (int r = 0; r < 9; ++r) a[r] += s[r * 1024 + k] * wv; }
#pragma unroll
          for (int r = 0; r < 9; ++r) red[(kg * 32 + cl) * 9 + r] = a[r];
          __syncthreads();
          if (C.tid < 288) { const int c2 = C.tid & 31, r = C.tid >> 5; float t = 0.f;
              for (int g = 0; g < 16; ++g) t += red[(g * 32 + c2) * 9 + r];
              const int col2 = (blk % 192) * 32 + c2; MOD[((size_t)l * 9 + r) * 6144 + col2] = t + adab[(size_t)l * 6144 + col2]; }
          __syncthreads(); } }
}

__device__ __forceinline__ void phase_mod1(const Params& P, const Ctx& C0, const int l) {
    Ctx C = C0; { const int t_ = opaque_tid(); C.tid = t_; C.lane = t_ & 63; C.wave = __builtin_amdgcn_readfirstlane(t_ >> 6); asm volatile("" : "+s"(C.ws)); asm volatile("" : "+s"(C.vcu)); asm volatile("" : "+s"(C.G)); }
    const int gw = C.vcu * 8 + C.wave, NGW = C.G * 8;
    const float* MOD = wsp<float>(C, WS_MOD); float* XS = wsp<float>(C, WS_XS); bf16_t* H = wsp<bf16_t>(C, WS_H);
    const int* YD = wsp<int>(C, WS_YDEST); const float* WT = wsp<float>(C, WS_WTS); const bf16_t* Y = wsp<bf16_t>(C, WS_Y);
    const float* ng = inp(C, I_N1G) + l * 1024; const float* const xin = inp(C, I_X); const float* const cin = inp(C, I_CTX);
    for (int m = gw; m < MT; m += NGW) {
        const int bidx = m < MX ? (m >> 12) : 8;
        const float* src = l == 0 ? (m < MX ? xin + (size_t)m * 1024 : cin + (size_t)(m - MX) * 1024) : XS + (size_t)m * 1024;
        f32x4 v[4];
#pragma unroll
        for (int j = 0; j < 4; ++j) v[j] = ((const f32x4*)src)[C.lane + 64 * j];
        if (l > 0) {
            f32x4 f[4];
#pragma unroll
            for (int j = 0; j < 4; ++j) f[j] = (f32x4){0.f, 0.f, 0.f, 0.f};
#pragma unroll
            for (int k = 0; k < 4; ++k) { const int dst = YD[m * 4 + k]; const float w = WT[m * 4 + k]; const u32x2* yr = (const u32x2*)(Y + (size_t)dst * 1024);
#pragma unroll
                for (int j = 0; j < 4; ++j) { const u32x2 y = yr[C.lane + 64 * j]; f[j] += w * (f32x4){bf_lo(y.x), bf_hi(y.x), bf_lo(y.y), bf_hi(y.y)}; } }
            const float* g2 = MOD + ((size_t)(l - 1) * 9 + bidx) * 6144 + 5 * 1024;
#pragma unroll
            for (int j = 0; j < 4; ++j) { v[j] += ((const f32x4*)g2)[C.lane + 64 * j] * f[j]; ((f32x4*)(XS + (size_t)m * 1024))[C.lane + 64 * j] = v[j]; }
        }
        float ss = 0.f;
#pragma unroll
        for (int j = 0; j < 4; ++j) ss += (v[j].x * v[j].x + v[j].y * v[j].y) + (v[j].z * v[j].z + v[j].w * v[j].w);
        const float rstd = rsqrtf(wave_sum(ss, C.lane) * (1.0f / 1024.0f) + EPS);
        const float* sh = MOD + ((size_t)l * 9 + bidx) * 6144; const float* sc = sh + 1024;
        u32x2* o8 = (u32x2*)(H + (size_t)m * 1024);
#pragma unroll
        for (int j = 0; j < 4; ++j) { const f32x4 g = ((const f32x4*)ng)[C.lane + 64 * j], s1 = ((const f32x4*)sc)[C.lane + 64 * j], s0 = ((const f32x4*)sh)[C.lane + 64 * j];
            const f32x4 h = v[j] * rstd * g * (1.0f + s1) + s0; u32x2 w; w.x = cvt_pk_bf16(h.x, h.y); w.y = cvt_pk_bf16(h.z, h.w); o8[C.lane + 64 * j] = w; }
    }
}
__device__ __forceinline__ void phase_final(const Params& P, const Ctx& C0) {
    Ctx C = C0; { const int t_ = opaque_tid(); C.tid = t_; C.lane = t_ & 63; C.wave = __builtin_amdgcn_readfirstlane(t_ >> 6); asm volatile("" : "+s"(C.ws)); asm volatile("" : "+s"(C.vcu)); asm volatile("" : "+s"(C.G)); }
    const int gw = C.vcu * 8 + C.wave, NGW = C.G * 8;
    const float* MOD = wsp<float>(C, WS_MOD); const float* XS = wsp<float>(C, WS_XS);
    const int* YD = wsp<int>(C, WS_YDEST); const float* WT = wsp<float>(C, WS_WTS); const bf16_t* Y = wsp<bf16_t>(C, WS_Y);
    const float* fg = inp(C, I_FG); float* const outp = (float*)inp(C, 28);
    for (int m = gw; m < MX; m += NGW) {
        const int bidx = m >> 12;
        f32x4 v[4], f[4];
#pragma unroll
        for (int j = 0; j < 4; ++j) { v[j] = ((const f32x4*)(XS + (size_t)m * 1024))[C.lane + 64 * j]; f[j] = (f32x4){0.f, 0.f, 0.f, 0.f}; }
#pragma unroll
        for (int k = 0; k < 4; ++k) { const int dst = YD[m * 4 + k]; const float w = WT[m * 4 + k]; const u32x2* yr = (const u32x2*)(Y + (size_t)dst * 1024);
#pragma unroll
            for (int j = 0; j < 4; ++j) { const u32x2 y = yr[C.lane + 64 * j]; f[j] += w * (f32x4){bf_lo(y.x), bf_hi(y.x), bf_lo(y.y), bf_hi(y.y)}; } }
        const float* g2 = MOD + ((size_t)(DEPTH - 1) * 9 + bidx) * 6144 + 5 * 1024;
        float ss = 0.f;
#pragma unroll
        for (int j = 0; j < 4; ++j) { v[j] += ((const f32x4*)g2)[C.lane + 64 * j] * f[j]; ss += (v[j].x * v[j].x + v[j].y * v[j].y) + (v[j].z * v[j].z + v[j].w * v[j].w); }
        const float rstd = rsqrtf(wave_sum(ss, C.lane) * (1.0f / 1024.0f) + EPS);
#pragma unroll
        for (int j = 0; j < 4; ++j) ((f32x4*)(outp + (size_t)m * 1024))[C.lane + 64 * j] = v[j] * rstd * ((const f32x4*)fg)[C.lane + 64 * j];
    }
}
__device__ __forceinline__ void phase_damerge(const Params& P, const Ctx& C0, const int l, const int Ml) {
    Ctx C = C0; { const int t_ = opaque_tid(); C.tid = t_; C.lane = t_ & 63; C.wave = __builtin_amdgcn_readfirstlane(t_ >> 6); asm volatile("" : "+s"(C.ws)); asm volatile("" : "+s"(C.vcu)); asm volatile("" : "+s"(C.G)); }
    const int gw = C.vcu * 8 + C.wave, NGW = C.G * 8;
    const float lam_init = 0.8f - 0.6f * expf(-0.3f * (float)l);
    const float d1 = wave_sum(inp(C, I_LQ1)[l * 64 + C.lane] * inp(C, I_LK1)[l * 64 + C.lane], C.lane), d2 = wave_sum(inp(C, I_LQ2)[l * 64 + C.lane] * inp(C, I_LK2)[l * 64 + C.lane], C.lane);
    const float lam = expf(d1) - expf(d2) + lam_init;
    const float gA = inp(C, I_SUBLN)[l * 128 + 2 * C.lane] * (1.0f - lam_init), gB = inp(C, I_SUBLN)[l * 128 + 2 * C.lane + 1] * (1.0f - lam_init);
    const unsigned* ODA = wsp<unsigned>(C, WS_ODA); unsigned* ODAN = wsp<unsigned>(C, WS_ODAN);
    for (int m = gw; m < Ml; m += NGW) {
#pragma unroll
        for (int h = 0; h < 4; ++h) { const unsigned a = ODA[(size_t)m * 512 + h * 128 + C.lane], b = ODA[(size_t)m * 512 + h * 128 + 64 + C.lane];
            const float o0 = bf_lo(a) - lam * bf_lo(b), o1 = bf_hi(a) - lam * bf_hi(b);
            const float r = rsqrtf(wave_sum(o0 * o0 + o1 * o1, C.lane) * (1.0f / 128.0f) + EPS);
            ODAN[(size_t)m * 256 + h * 64 + C.lane] = cvt_pk_bf16(o0 * r * gA, o1 * r * gB); }
    }
}
__device__ __forceinline__ void phase_mod2_router(const Params& P, const Ctx& C0, const int l, const int Ml) {
    Ctx C = C0; { const int t_ = opaque_tid(); C.tid = t_; C.lane = t_ & 63; C.wave = __builtin_amdgcn_readfirstlane(t_ >> 6); asm volatile("" : "+s"(C.ws)); asm volatile("" : "+s"(C.vcu)); asm volatile("" : "+s"(C.G)); }
    LAS float* rwt = (LAS float*)C.lds;
    LAS int* hist = (LAS int*)(C.lds + MISC_OFF + 256);
    { const f32x4* src = (const f32x4*)(wsp<float>(C, WS_RWT) + (size_t)l * 32768); LAS f32x4* d = (LAS f32x4*)rwt;
      for (int i = C.tid; i < 8192; i += 512) d[i] = src[i];
      if (C.tid < 32) hist[C.tid] = 0; }
    __syncthreads();
    const float* MOD = wsp<float>(C, WS_MOD); const float* XS = wsp<float>(C, WS_XS); bf16_t* H = wsp<bf16_t>(C, WS_H);
    int* TOPE = wsp<int>(C, WS_TOPE); float* WT = wsp<float>(C, WS_WTS);
    const float* ng = inp(C, I_N2G) + l * 1024; const float rbias = inp(C, I_RB)[l * 32 + (C.lane >> 1)];
    const int wg = blockIdx.x, RPW = (Ml + C.G - 1) / C.G, m_lo = wg * RPW, m_hi = (m_lo + RPW < Ml) ? m_lo + RPW : Ml;
    f32x4 gv[4], nv[4];
#pragma unroll
    for (int j = 0; j < 4; ++j) { gv[j] = ((const f32x4*)ng)[C.lane + 64 * j]; nv[j] = (f32x4){0.f, 0.f, 0.f, 0.f}; }
    if (m_lo + C.wave < m_hi) {
#pragma unroll
        for (int j = 0; j < 4; ++j) nv[j] = ((const f32x4*)(XS + (size_t)(m_lo + C.wave) * 1024))[C.lane + 64 * j]; }
    for (int m = m_lo + C.wave; m < m_hi; m += 8) {
        const int bidx = m < MX ? (m >> 12) : 8;
        f32x4 v[4]; float ss = 0.f;
#pragma unroll
        for (int j = 0; j < 4; ++j) { v[j] = nv[j]; ss += (v[j].x * v[j].x + v[j].y * v[j].y) + (v[j].z * v[j].z + v[j].w * v[j].w); }
        if (m + 8 < m_hi) {
#pragma unroll
            for (int j = 0; j < 4; ++j) nv[j] = ((const f32x4*)(XS + (size_t)(m + 8) * 1024))[C.lane + 64 * j]; }
        const float rstd = rsqrtf(wave_sum(ss, C.lane) * (1.0f / 1024.0f) + EPS);
        const float* sh = MOD + ((size_t)l * 9 + bidx) * 6144 + 3 * 1024; const float* sc = sh + 1024;
        u32x2* o8 = (u32x2*)(H + (size_t)m * 1024);
#pragma unroll
        for (int j = 0; j < 4; ++j) { const f32x4 s1 = ((const f32x4*)sc)[C.lane + 64 * j], s0 = ((const f32x4*)sh)[C.lane + 64 * j];
            v[j] = v[j] * rstd * gv[j] * (1.0f + s1) + s0; u32x2 w; w.x = cvt_pk_bf16(v[j].x, v[j].y); w.y = cvt_pk_bf16(v[j].z, v[j].w); o8[C.lane + 64 * j] = w; }
        float a[32];
#pragma unroll
        for (int e = 0; e < 32; ++e) { float t = 0.f;
#pragma unroll
            for (int j = 0; j < 4; ++j) { const f32x4 w = ((const LAS f32x4*)(rwt + e * 1024))[C.lane + 64 * j]; t += (v[j].x * w.x + v[j].y * w.y) + (v[j].z * w.z + v[j].w * w.w); }
            a[e] = t; }
#define RS_STEP(N, OFF, BIT) _Pragma("unroll") for (int e = 0; e < N; ++e) { const bool up = (C.lane >> BIT) & 1; const float keep = up ? a[e + N] : a[e], send = up ? a[e] : a[e + N]; a[e] = keep + shx(send, OFF, C.lane); }
        RS_STEP(16, 32, 5) RS_STEP(8, 16, 4) RS_STEP(4, 8, 3) RS_STEP(2, 4, 2) RS_STEP(1, 2, 1)
#undef RS_STEP
        float lg = a[0] + shx(a[0], 1, C.lane) + rbias;
        const int myE = C.lane >> 1;
        float tv[4]; int ti[4];
#pragma unroll
        for (int k = 0; k < 4; ++k) { float bv = lg; int bi = myE;
#pragma unroll
            for (int o = 1; o < 64; o <<= 1) { const float ov = shx(bv, o, C.lane); const int oi = shxi(bi, o, C.lane); if (ov > bv || (ov == bv && oi < bi)) { bv = ov; bi = oi; } }
            tv[k] = bv; ti[k] = bi; if (myE == bi) lg = -3.0e38f; }
        const float e1 = __expf(tv[1] - tv[0]), e2 = __expf(tv[2] - tv[0]), e3 = __expf(tv[3] - tv[0]); const float inv = 1.0f / (1.0f + e1 + e2 + e3);
        if (C.lane < 4) { const int e = C.lane == 0 ? ti[0] : C.lane == 1 ? ti[1] : C.lane == 2 ? ti[2] : ti[3];
            const float w = (C.lane == 0 ? 1.0f : C.lane == 1 ? e1 : C.lane == 2 ? e2 : e3) * inv;
            const int rank = atomicAdd((int*)(hist + e), 1);
            TOPE[m * 4 + C.lane] = e | (rank << 8); WT[m * 4 + C.lane] = w; }
    }
    __syncthreads();
    if (C.tid < 32) wsp<int>(C, WS_CNTWG)[wg * 32 + C.tid] = hist[C.tid];
    __syncthreads();
}
__device__ __forceinline__ void phase_lists(const Params& P, const Ctx& C0, const int Ml) {
    Ctx C = C0; { const int t_ = opaque_tid(); C.tid = t_; C.lane = t_ & 63; C.wave = __builtin_amdgcn_readfirstlane(t_ >> 6); asm volatile("" : "+s"(C.ws)); asm volatile("" : "+s"(C.vcu)); asm volatile("" : "+s"(C.G)); }
    LAS int* part = (LAS int*)(C.lds);
    LAS int* tot = (LAS int*)(C.lds + 4096);
    LAS int* base = (LAS int*)(C.lds + 4096 + 128);
    LAS int* pst = (LAS int*)(C.lds + 4096 + 256);
    const int* CNT = wsp<int>(C, WS_CNTWG); const int wg = blockIdx.x;
    { const int e = C.tid & 31, seg = C.tid >> 5; int s = 0, sb = 0;
      for (int w = seg; w < C.G; w += 16) { const int c = CNT[w * 32 + e]; s += c; if (w < wg) sb += c; }
      part[seg * 32 + e] = s; part[512 + seg * 32 + e] = sb; }
    __syncthreads();
    if (C.tid < 32) { int s = 0, sb = 0; for (int g = 0; g < 16; ++g) { s += part[g * 32 + C.tid]; sb += part[512 + g * 32 + C.tid]; } tot[C.tid] = s; base[C.tid] = sb; }
    __syncthreads();
    if (C.tid == 0) { int p = 0; for (int e = 0; e < 32; ++e) { pst[e] = p; p += (tot[e] + 255) & ~255; } pst[32] = p;
        if (wg == 0) { int* PS = wsp<int>(C, WS_PSTART); for (int e = 0; e <= 32; ++e) PS[e] = pst[e]; } }
    __syncthreads();
    const int* TOPE = wsp<int>(C, WS_TOPE); int* YD = wsp<int>(C, WS_YDEST); int* RL = wsp<int>(C, WS_ROWLIST);
    const int RPW = (Ml + C.G - 1) / C.G, m_lo = wg * RPW, m_hi = (m_lo + RPW < Ml) ? m_lo + RPW : Ml;
    for (int i = m_lo * 4 + C.tid; i < m_hi * 4; i += 512) { const int t = TOPE[i], e = t & 255, rank = t >> 8; const int dst = pst[e] + base[e] + rank;
        YD[i] = dst; RL[dst] = i >> 2; }
    for (int e = 0; e < 32; ++e) { const int lo = pst[e] + tot[e], hi = pst[e + 1];
        for (int r = lo + wg * 512 + C.tid; r < hi; r += C.G * 512) RL[r] = 0; }
    __syncthreads();
}
__device__ __forceinline__ int moe_tiles(const Ctx& C0, LAS int* tile_e) {
    Ctx C = C0; { const int t_ = opaque_tid(); C.tid = t_; C.lane = t_ & 63; C.wave = __builtin_amdgcn_readfirstlane(t_ >> 6); asm volatile("" : "+s"(C.ws)); asm volatile("" : "+s"(C.vcu)); asm volatile("" : "+s"(C.G)); }
    const int* PS = wsp<int>(C, WS_PSTART);
    const int ntiles = PS[32] >> 8;
    for (int t = C.tid; t < ntiles; t += 512) { int e = 0;
#pragma unroll 1
        for (int j = 1; j < 32; ++j) if ((PS[j] >> 8) <= t) e = j;
        tile_e[t] = e; }
    __syncthreads();
    return __builtin_amdgcn_readfirstlane(ntiles);
}

constexpr int PH_PER_LAYER = 11, N_PHASES = 1 + DEPTH * PH_PER_LAYER + 1;
__global__ void __launch_bounds__(512, 2) dit_fwd(Params P) {
    extern __shared__ __attribute__((aligned(16))) unsigned char lds_raw[];
    Ctx C; C.lds = (LAS unsigned char*)lds_raw; C.ldsg = (char*)lds_raw; C.tid = threadIdx.x; C.lane = C.tid & 63; C.wave = __builtin_amdgcn_readfirstlane(C.tid >> 6);
    C.G = gridDim.x; { const int bx = blockIdx.x; C.vcu = (C.G % 8 == 0) ? (bx % 8) * (C.G / 8) + bx / 8 : bx; }
    C.ws = P.ws;
    volatile LAS unsigned* MISC = (volatile LAS unsigned*)(C.lds + MISC_OFF);
    if (C.tid < 64) MISC[C.tid] = 0u;
    if (C.tid == 64) { LAS unsigned long long* tab = (LAS unsigned long long*)(C.lds + PTRTAB_OFF);
#pragma unroll
        for (int i = 0; i < 28; ++i) tab[i] = (unsigned long long)P.in[i];
        tab[28] = (unsigned long long)P.out; }
    { LAS float* T = (LAS float*)(C.lds + ROPE_OFF);
      for (int i = C.tid; i < 1024; i += 512) { const int p = i >> 4, f = i & 15; const float fr = powf(10000.0f, -(float)(2 * f) / 32.0f); const float a = (float)p * fr; T[2 * i] = cosf(a); T[2 * i + 1] = sinf(a); } }
    __syncthreads();
    unsigned* barw = (unsigned*)(C.ws + WS_CTL) + CW_BAR;
    XcdBarrier bar; bar.bar = barw; bar.x = 0; bar.st = nullptr;
    const int lo = P.ph_lo, hi = P.ph_hi;
    const bool multi = (hi - lo) > 1;
    if (multi) bar = xcd_barrier_post(barw, MISC + 8);
#ifndef PH_MASK
#define PH_MASK 0xffff
#endif
#define IN(k) (lo <= (k) && (k) < hi)
#define EN(p) ((PH_MASK >> (p)) & 1)
#ifndef DUP_MASK
#define DUP_MASK 0
#endif
#define NREP(p) (((DUP_MASK >> (p)) & 1) ? 2 : 1)
#define SEAM(k) do { if (IN((k) + 1)) xcd_barrier(bar); } while (0)
    if (EN(11) && IN(0)) { for (int rep = 0; rep < NREP(11); ++rep) { if (rep) xcd_barrier(bar); phase_prologue(P, C); } SEAM(0); }
    for (int l = 0; l < DEPTH; ++l) {
        const int pb = 1 + l * PH_PER_LAYER;
        const bool lastl = (l == DEPTH - 1);
        const int Ml = lastl ? MX : MT;
        const int nMl = Ml / 256;
        const float* MODl = wsp<float>(C, WS_MOD) + (size_t)l * 9 * 6144;
        if (EN(0) && IN(pb + 0)) { phase_mod1(P, C, l); SEAM(pb + 0); }
        if (EN(1) && IN(pb + 1)) { for (int rep = 0; rep < NREP(1); ++rep) { if (rep) xcd_barrier(bar);
            pg8::PlainSched S{(const char*)wsp<bf16_t>(C, WS_H), (const char*)(wsp<bf16_t>(C, WS_WIN) + (size_t)l * NIN * 1024), 1024, MT / 256, NIN / 256, C.G, (int)blockIdx.x};
            EpiG1 E{C.ws, (const LAS float*)(C.lds + ROPE_OFF)};
            pg8::gemm_phase(C.lds, 1024, S, E);
            } SEAM(pb + 1);
        }
        if (EN(2) && IN(pb + 2)) { for (int rep = 0; rep < NREP(2); ++rep) { if (rep) xcd_barrier(bar);
            { pg8::PlainSched S{(const char*)wsp<bf16_t>(C, WS_CQ), (const char*)(wsp<bf16_t>(C, WS_WQB) + (size_t)l * 768 * 384), 384, MT / 256, 3, C.G, (int)blockIdx.x};
              EpiQMla E{C.ws, (const LAS float*)(C.lds + ROPE_OFF)};
              pg8::gemm_phase(C.lds, 384, S, E); }
            { pg8::PlainSched S{(const char*)wsp<bf16_t>(C, WS_CKV), (const char*)(wsp<bf16_t>(C, WS_WKVB) + (size_t)l * 1024 * 256), 256, MT / 256, 4, C.G, (int)blockIdx.x};
              EpiKvMla E{C.ws};
              pg8::gemm_phase(C.lds, 256, S, E); }
            } SEAM(pb + 2);
        }
        if (EN(3) && IN(pb + 3)) { for (int rep = 0; rep < NREP(3); ++rep) { if (rep) xcd_barrier(bar);
            const bf16_t* QDA = wsp<bf16_t>(C, WS_QDA); const bf16_t* KDA = wsp<bf16_t>(C, WS_KDA); const bf16_t* VDA = wsp<bf16_t>(C, WS_VDA); bf16_t* ODA = wsp<bf16_t>(C, WS_ODA);
            const bf16_t* QM = wsp<bf16_t>(C, WS_QMLA); const bf16_t* KVM = wsp<bf16_t>(C, WS_KVMLA); const bf16_t* KR = wsp<bf16_t>(C, WS_KR); bf16_t* OM = wsp<bf16_t>(C, WS_OMLA);
#ifndef ATT_ONLY
#define ATT_ONLY 3
#endif
            const int nu_m = (ATT_ONLY & 1) ? NB * 4 * 16 + (lastl ? 0 : NB * 4) : 0;
            for (int u = C.vcu; u < nu_m; u += C.G) {
                int h, q0, kx0, ky0, ntx, nt;
                if (u < NB * 4 * 16) { const int qb = u & 15, b = u >> 6; h = (u >> 4) & 3; q0 = b * SEQ + qb * 256; kx0 = b * SEQ; ky0 = MX + b * CTXL; ntx = SEQ / 64; nt = SEQ / 64 + CTXL / 64; }
                else { const int v = u - NB * 4 * 16, b = v >> 2; h = v & 3; q0 = MX + b * CTXL; kx0 = 0; ky0 = q0; ntx = 0; nt = CTXL / 64; }
                att::attn_unit<128, 768, 1024, 64, 1024, 512, 1>(QM + h * 192, QM + h * 192 + 128, KVM + h * 256, KR, KVM + h * 256 + 128, OM + h * 128, q0, kx0, ky0, ntx, nt, C.ldsg); }
            const int nu_d = (ATT_ONLY & 2) ? NB * 8 * 16 + (lastl ? 0 : NB * 8) : 0;
            for (int u = C.vcu; u < nu_d; u += C.G) {
                int hm, q0, kx0, ky0, ntx, nt;
                if (u < NB * 8 * 16) { const int qb = u & 15, b = u >> 7; hm = (u >> 4) & 7; q0 = b * SEQ + qb * 256; kx0 = b * SEQ; ky0 = MX + b * CTXL; ntx = SEQ / 64; nt = SEQ / 64 + CTXL / 64; }
                else { const int v = u - NB * 8 * 16, b = v >> 3; hm = v & 7; q0 = MX + b * CTXL; kx0 = 0; ky0 = q0; ntx = 0; nt = CTXL / 64; }
                att::attn_unit<0, 512, 512, 512, 512, 1024, 2>(QDA, QDA + hm * 64, KDA, KDA + hm * 64, VDA + (hm >> 1) * 128, ODA + hm * 128, q0, kx0, ky0, ntx, nt, C.ldsg); }
            } SEAM(pb + 3);
        }
        if (EN(4) && IN(pb + 4)) { phase_damerge(P, C, l, Ml); SEAM(pb + 4); }
        if (EN(5) && IN(pb + 5)) { for (int rep = 0; rep < NREP(5); ++rep) { if (rep) xcd_barrier(bar);
            pg8::PairSched S{(const char*)wsp<bf16_t>(C, WS_ODAN), (long)WS_OMLA - (long)WS_ODAN, (const char*)(wsp<bf16_t>(C, WS_WBRA) + (size_t)l * 1024 * 512), (long)WS_WBRB - (long)WS_WBRA, 512, nMl, 4, C.G, (int)blockIdx.x};
            EpiBranch E{C.ws};
            pg8::gemm_phase(C.lds, 512, S, E);
            } SEAM(pb + 5);
        }
        if (EN(6) && IN(pb + 6)) {
            pg8::PlainSched S{(const char*)wsp<bf16_t>(C, WS_U), (const char*)(wsp<bf16_t>(C, WS_WOUT) + (size_t)l * 1024 * 1024), 1024, nMl, 4, C.G, (int)blockIdx.x};
            EpiOut E{wsp<float>(C, WS_XS), inp(C, I_X), inp(C, I_CTX), MODl, l == 0 ? 1 : 0};
            pg8::gemm_phase(C.lds, 1024, S, E);
            SEAM(pb + 6);
        }
        if (EN(7) && IN(pb + 7)) { for (int rep = 0; rep < NREP(7); ++rep) { if (rep) xcd_barrier(bar); phase_mod2_router(P, C, l, Ml); } SEAM(pb + 7); }
        if (EN(8) && IN(pb + 8)) { for (int rep = 0; rep < NREP(8); ++rep) { if (rep) xcd_barrier(bar); phase_lists(P, C, Ml); } SEAM(pb + 8); }
        if (EN(9) && IN(pb + 9)) { for (int rep = 0; rep < NREP(9); ++rep) { if (rep) xcd_barrier(bar);
            LAS int* tile_e = (LAS int*)(C.lds + MISC_OFF + 512);
            const int ntiles = moe_tiles(C, tile_e);
            pg8::MoeSched S{(const char*)wsp<bf16_t>(C, WS_H), (const char*)(wsp<bf16_t>(C, WS_WGU) + (size_t)l * 32 * 1024 * 1024), 1024, (size_t)1024 * 1024 * 2, ntiles, C.G, C.vcu, tile_e, wsp<int>(C, WS_ROWLIST)};
            EpiUp E{wsp<bf16_t>(C, WS_ACT), inp(C, I_BGU) + (size_t)l * 32 * 1024};
            pg8::gemm_phase<EpiUp, pg8::MoeSched, true>(C.lds, 1024, S, E);
            } SEAM(pb + 9);
        }
        if (EN(10) && IN(pb + 10)) { for (int rep = 0; rep < NREP(10); ++rep) { if (rep) xcd_barrier(bar);
            LAS int* tile_e = (LAS int*)(C.lds + MISC_OFF + 512);
            const int ntiles = moe_tiles(C, tile_e);
            pg8::MoeSched S{(const char*)wsp<bf16_t>(C, WS_ACT), (const char*)(wsp<bf16_t>(C, WS_WDN) + (size_t)l * 32 * 1024 * 512), 512, (size_t)1024 * 512 * 2, ntiles, C.G, C.vcu, tile_e, nullptr};
            EpiDown E{wsp<bf16_t>(C, WS_Y), inp(C, I_BDN) + (size_t)l * 32 * 1024};
            pg8::gemm_phase(C.lds, 512, S, E);
            } SEAM(pb + 10);
        }
    }
    if (EN(12) && IN(N_PHASES - 1)) phase_final(P, C);
#undef IN
#undef SEAM
}

extern "C" void kernel_launch(void* const* d_in, const int* in_sizes, int n_in, void* d_out, int out_size, void* d_ws, size_t ws_size, hipStream_t stream) {
    static int grid = 0;
    if (grid == 0) {
        if (n_in != 28 || in_sizes[0] != MX * DM || out_size != MX * DM || ws_size < WS_END) { fprintf(stderr, "kernel_launch: shape/workspace mismatch (n_in %d, ws %zu < %zu)\n", n_in, ws_size, (size_t)WS_END); grid = -1; return; }
        int dev = 0, cus = 0, per_cu = 0;
        if (hipGetDevice(&dev) != hipSuccess || hipDeviceGetAttribute(&cus, hipDeviceAttributeMultiprocessorCount, dev) != hipSuccess) { grid = -1; return; }
        if (hipFuncSetAttribute((const void*)dit_fwd, hipFuncAttributeMaxDynamicSharedMemorySize, LDS_BYTES) != hipSuccess) { fprintf(stderr, "kernel_launch: hipFuncSetAttribute failed\n"); grid = -1; return; }
        if (hipOccupancyMaxActiveBlocksPerMultiprocessor(&per_cu, (const void*)dit_fwd, 512, LDS_BYTES) != hipSuccess || per_cu < 1) fprintf(stderr, "kernel_launch: occupancy query says %d\n", per_cu);
        (void)hipGetLastError();
        grid = cus > 1024 ? 1024 : cus;
    }
    if (grid < 0) return;
    if (hipMemsetAsync((char*)d_ws + WS_CTL, 0, CTL_ZERO_BYTES, stream) != hipSuccess) return;
    Params p{};
    for (int i = 0; i < 28; ++i) p.in[i] = (const float*)d_in[i];
    p.out = (float*)d_out; p.ws = (unsigned char*)d_ws;
#if MK_ONE_LAUNCH
    p.ph_lo = 0; p.ph_hi = N_PHASES;
    hipLaunchKernelGGL(dit_fwd, dim3(grid), dim3(512), LDS_BYTES, stream, p);
#else
    for (int k = 0; k < N_PHASES; ++k) { p.ph_lo = k; p.ph_hi = k + 1; hipLaunchKernelGGL(dit_fwd, dim3(grid), dim3(512), LDS_BYTES, stream, p); }
#endif
    const hipError_t le = hipPeekAtLastError();
    if (le != hipSuccess) fprintf(stderr, "kernel_launch: launch failed: %s\n", hipGetErrorName(le));
}
```

```cpp
#include <hip/hip_runtime.h>
#include <cstdio>
#include <cstdint>

#ifndef STAG_ON
#define STAG_ON 0
#endif
#ifndef STAG_T
#define STAG_T 37
#endif
#ifndef MK_ONE_LAUNCH
#define MK_ONE_LAUNCH 1
#endif

#define GAS __attribute__((address_space(1)))
#define LAS __attribute__((address_space(3)))
typedef unsigned short bf16_t;
typedef short bf16x8 __attribute__((ext_vector_type(8)));
typedef int i32x4_t __attribute__((ext_vector_type(4)));
typedef int i32x8_t __attribute__((ext_vector_type(8)));
typedef short s16x4 __attribute__((ext_vector_type(4)));
typedef float f32x4 __attribute__((ext_vector_type(4)));
typedef float f32x16 __attribute__((ext_vector_type(16)));
typedef unsigned u32x4 __attribute__((ext_vector_type(4)));
typedef unsigned u32x2 __attribute__((ext_vector_type(2)));

constexpr int DM = 1024, NB = 8, SEQ = 4096, DEPTH = 4, CTXL = 256;
constexpr int MX = NB * SEQ, MY = NB * CTXL, MT = MX + MY;
constexpr int NIN = 4352;
constexpr int NEXP = 32, DFF = 512;
constexpr int PMAX = 147456;
constexpr float EPS = 1e-6f;

constexpr size_t al256(size_t x) { return (x + 255) & ~(size_t)255; }
constexpr size_t WS_CTL = 0, CTL_ZERO_BYTES = 1u << 20;
constexpr size_t WS_MOD = CTL_ZERO_BYTES;
constexpr size_t WS_ROPE = WS_MOD + al256((size_t)DEPTH * 9 * 6144 * 4);
constexpr size_t WS_RWT = WS_ROPE + 8192;
constexpr size_t WS_WIN = WS_RWT + (size_t)DEPTH * 32 * 1024 * 6;
constexpr size_t WS_WQB = WS_WIN + (size_t)DEPTH * NIN * 1024 * 2;
constexpr size_t WS_WKVB = WS_WQB + (size_t)DEPTH * 768 * 384 * 2;
constexpr size_t WS_WBRA = WS_WKVB + (size_t)DEPTH * 1024 * 256 * 2;
constexpr size_t WS_WBRB = WS_WBRA + (size_t)DEPTH * 1024 * 512 * 2;
constexpr size_t WS_WOUT = WS_WBRB + (size_t)DEPTH * 1024 * 512 * 2;
constexpr size_t WS_WGU = WS_WOUT + (size_t)DEPTH * 1024 * 1024 * 2;
constexpr size_t WS_WDN = WS_WGU + (size_t)DEPTH * 32 * 1024 * 1024 * 2;
constexpr size_t WS_XS = WS_WDN + (size_t)DEPTH * 32 * 1024 * 512 * 2;
constexpr size_t WS_H = WS_XS + (size_t)MT * 1024 * 4;
constexpr size_t WS_QDA = WS_H + (size_t)MT * 1024 * 2;
constexpr size_t WS_KDA = WS_QDA + (size_t)MT * 512 * 2;
constexpr size_t WS_VDA = WS_KDA + (size_t)MT * 512 * 2;
constexpr size_t WS_GATES = WS_VDA + (size_t)MT * 512 * 2;
constexpr size_t WS_CQ = WS_GATES + (size_t)MT * 2048 * 2;
constexpr size_t WS_CKV = WS_CQ + (size_t)MT * 384 * 2;
constexpr size_t WS_KR = WS_CKV + (size_t)MT * 256 * 2;
constexpr size_t WS_ROWSQ = WS_KR + (size_t)MT * 64 * 2;
constexpr size_t WS_QMLA = WS_ROWSQ + (size_t)MT * 12 * 4;
constexpr size_t WS_KVMLA = WS_QMLA + (size_t)MT * 768 * 2;
constexpr size_t WS_ODA = WS_KVMLA + (size_t)MT * 1024 * 2;
constexpr size_t WS_OMLA = WS_ODA + (size_t)MT * 1024 * 2;
constexpr size_t WS_ODAN = WS_OMLA + (size_t)MT * 512 * 2;
constexpr size_t WS_U = WS_ODAN + (size_t)MT * 512 * 2;
constexpr size_t WS_TOPE = WS_U + (size_t)MT * 1024 * 2;
constexpr size_t WS_WTS = WS_TOPE + (size_t)MT * 16;
constexpr size_t WS_YDEST = WS_WTS + (size_t)MT * 16;
constexpr size_t WS_CNTWG = WS_YDEST + (size_t)MT * 16;
constexpr size_t WS_PSTART = WS_CNTWG + 1024 * 32 * 4;
constexpr size_t WS_ROWLIST = WS_PSTART + 256;
constexpr size_t WS_ACT = WS_ROWLIST + (size_t)PMAX * 4;
constexpr size_t WS_Y = WS_ACT + (size_t)PMAX * 512 * 2;
constexpr size_t WS_H8 = WS_Y + (size_t)PMAX * 1024 * 2;
constexpr size_t WS_WING8 = WS_H8 + (size_t)MT * 1024;
constexpr size_t WS_IDLIST = WS_WING8 + (size_t)DEPTH * 2560 * 1024;
constexpr size_t WS_WOUT8 = WS_IDLIST + (size_t)PMAX * 4;
constexpr size_t WS_WBR8 = WS_WOUT8 + (size_t)DEPTH * 1024 * 1024;
constexpr size_t WS_OB8 = WS_WBR8 + (size_t)DEPTH * 2 * 1024 * 512;
constexpr size_t WS_END = WS_OB8 + (size_t)2 * MX * 512;

constexpr int CW_BAR = 4096;

constexpr int RING_BYTES = 131072;
constexpr int MISC_OFF = RING_BYTES;
constexpr int ROPE_OFF = 135168;
constexpr int LDS_BYTES = 147456;

typedef float f32x2_t __attribute__((ext_vector_type(2)));
typedef __bf16 bf16x2_t __attribute__((ext_vector_type(2)));
__device__ __forceinline__ unsigned cvt_pk_bf16(float lo, float hi) { f32x2_t v = {lo, hi}; bf16x2_t b = __builtin_convertvector(v, bf16x2_t); return __builtin_bit_cast(unsigned, b); }
__device__ __forceinline__ float bf_lo(unsigned w) { return __uint_as_float(w << 16); }
__device__ __forceinline__ float bf_hi(unsigned w) { return __uint_as_float(w & 0xffff0000u); }
__device__ __forceinline__ float shx(float v, int o, int lane) { return __int_as_float(__builtin_amdgcn_ds_bpermute((lane ^ o) << 2, __float_as_int(v))); }
__device__ __forceinline__ int shxi(int v, int o, int lane) { return __builtin_amdgcn_ds_bpermute((lane ^ o) << 2, v); }
__device__ __forceinline__ float wave_sum(float v, int lane) {
#pragma unroll
    for (int o = 1; o < 64; o <<= 1) v += shx(v, o, lane);
    return v;
}
__device__ __forceinline__ float xchg32(float x, bool lo_half) {
    auto rr = __builtin_amdgcn_permlane32_swap(__float_as_uint(x), __float_as_uint(x), false, false);
    return __uint_as_float(lo_half ? rr[1] : rr[0]);
}
__device__ __forceinline__ float sigmoidf_(float x) { return __builtin_amdgcn_rcpf(1.0f + __builtin_amdgcn_exp2f(x * -1.4426950408889634f)); }
template <typename T> __device__ __forceinline__ T* as_global(T* p) { return (T*)(GAS T*)p; }
template <typename T> __device__ __forceinline__ T* gp(GAS unsigned char* ws, size_t off) { return (T*)(GAS T*)(ws + off); }
__device__ __forceinline__ int opaque_tid() { int t = threadIdx.x; asm volatile("" : "+v"(t)); return t; }
#define LDS_WAIT() asm volatile("s_waitcnt lgkmcnt(0)" ::: "memory")
#define VM_WAIT() asm volatile("s_waitcnt vmcnt(0)" ::: "memory")

#define XB_TMO      128
#define XB_XCNT(j)  (256  + 64 * (j))
#define XB_XSUB(j)  (1280 + 64 * (j))
#define XB_XGEN(j)  (2304 + 64 * (j))
#define XB_TOP      3328
#define XB_TOPGEN   3392
#define XCD_BAR_WORDS 3456
#define XB_SPIN_CAP (1u << 18)
__device__ __forceinline__ unsigned xb_ld(unsigned* p)              { return __hip_atomic_load(p, __ATOMIC_RELAXED, __HIP_MEMORY_SCOPE_AGENT); }
__device__ __forceinline__ unsigned xb_add(unsigned* p, unsigned v) { return __hip_atomic_fetch_add(p, v, __ATOMIC_RELAXED, __HIP_MEMORY_SCOPE_AGENT); }
__device__ __forceinline__ unsigned xb_xcc_id() { return (unsigned)__builtin_amdgcn_s_getreg((3 << 11) | 20) & 0xFu; }
#define XB_SPIN(cond, bar) do { unsigned _sp = 0; while (cond) { __builtin_amdgcn_s_sleep(1); \
    if ((++_sp & 255u) == 0u) { if (xb_ld(&(bar)[XB_TMO])) break; if (_sp > XB_SPIN_CAP) { atomicAdd(&(bar)[XB_TMO], 1u); break; } } } } while (0)
struct XcdBarrier { unsigned* bar; unsigned x; volatile LAS unsigned* st; };
__device__ __forceinline__ XcdBarrier xcd_barrier_post(unsigned* bar, volatile LAS unsigned* st) {
    XcdBarrier b; b.bar = bar; b.x = xb_xcc_id(); b.st = st;
    if (threadIdx.x == 0) (void)xb_add(&bar[XB_XCNT(b.x)], 1u);
    return b;
}
__device__ __forceinline__ void xcd_barrier_complete(unsigned* bar, unsigned x, unsigned& nloc, unsigned& nx) {
    const unsigned G = gridDim.x * gridDim.y * gridDim.z;
    unsigned sum, cnt, mine, sp = 0u;
    for (;;) {
        sum = 0u; cnt = 0u; mine = 0u;
#pragma unroll
        for (unsigned j = 0; j < 16; ++j) { const unsigned c = xb_ld(&bar[XB_XCNT(j)]); sum += c; cnt += (c > 0u) ? 1u : 0u; mine = (j == x) ? c : mine; }
        if (sum == G) break;
        __builtin_amdgcn_s_sleep(1);
        if ((++sp & 255u) == 0u) { if (xb_ld(&bar[XB_TMO])) break; if (sp > XB_SPIN_CAP) { atomicAdd(&bar[XB_TMO], 1u); break; } }
    }
    nloc = mine > 0u ? mine : 1u; nx = cnt > 0u ? cnt : 1u;
}
__device__ __forceinline__ void xcd_barrier(const XcdBarrier& b) {
    asm volatile("s_waitcnt vmcnt(0)" ::: "memory");
    __syncthreads();
    if (threadIdx.x == 0) {
        unsigned* bar = b.bar; asm volatile("" : "+s"(bar));
        __builtin_amdgcn_s_waitcnt(0);
        unsigned nloc = b.st[0], nx = b.st[1];
        if (nloc == 0u) { xcd_barrier_complete(bar, b.x, nloc, nx); b.st[0] = nloc; b.st[1] = nx; }
        const unsigned old = xb_add(&bar[XB_XSUB(b.x)], 1u);
        const unsigned gen = old / nloc;
        if (old + 1u == (gen + 1u) * nloc) {
            __builtin_amdgcn_fence(__ATOMIC_RELEASE, "agent");
            asm volatile("s_waitcnt vmcnt(0)" ::: "memory");
            const unsigned og = xb_add(&bar[XB_TOP], 1u);
            const unsigned tg = og / nx;
            if (og + 1u == (tg + 1u) * nx) xb_add(&bar[XB_TOPGEN], 1u);
            else XB_SPIN(xb_ld(&bar[XB_TOPGEN]) == tg, bar);
            __builtin_amdgcn_fence(__ATOMIC_ACQUIRE, "agent");
            xb_add(&bar[XB_XGEN(b.x)], 1u);
            asm volatile("s_waitcnt vmcnt(0)" ::: "memory");
        } else {
            XB_SPIN(xb_ld(&bar[XB_XGEN(b.x)]) == gen, bar);
            __builtin_amdgcn_fence(__ATOMIC_ACQUIRE, "agent");
            asm volatile("s_waitcnt vmcnt(0)" ::: "memory");
        }
    }
    __syncthreads();
}

namespace pg8 {
constexpr int BM = 256, BK = 64, HALF = 128, HTB = HALF * BK * 2, STAGE_BYTES = 8 * HTB, NXCD = 8, WGM = 8;
__host__ __device__ __forceinline__ int lds_byte(int r, int c) { const int st = (r >> 4) * 2 + (c >> 5), rr = r & 15, cc = c & 31, ob = rr * 64 + cc * 2; return st * 1024 + (ob ^ (((ob >> 9) & 1) << 5)); }
__host__ __device__ __forceinline__ void stage_rc(int b, int& R, int& C) { const int st = b / 1024, sb = b % 1024, swz = sb ^ (((sb >> 9) & 1) << 5); R = (st >> 1) * 16 + swz / 64; C = (st & 1) * 32 + (swz % 64) / 2; }
__host__ __device__ __forceinline__ int perm32(int rho) { const int n = rho >> 4, i = rho & 15; return 8 * (i >> 2) + 4 * n + (i & 3); }
struct Unit { int pm, pn, z; };

template <class Epi, class Sched, bool GATHER = false, bool FP8 = false>
__device__ __forceinline__ void gemm_phase(LAS unsigned char* lds, const int K, const Sched& S, const Epi& E, const int stag_ticks = 0) {
    const int tid = opaque_tid(), wid = __builtin_amdgcn_readfirstlane(tid >> 6), lane = tid & 63, wr = wid >> 2, wc = wid & 3, fr = lane & 15, fq = lane >> 4;
    const int nt = K / BK;
    unsigned voffA[2], voffB[2];
#pragma unroll
    for (int i = 0; i < 2; ++i) { int R, C; stage_rc(tid * 16 + i * 8192, R, C); const int Rb = (R & ~31) + perm32(R & 31);
        voffA[i] = (unsigned)(R * K + C) * 2u; voffB[i] = (unsigned)(Rb * K + C) * 2u; }
    unsigned gA[4] = {0u, 0u, 0u, 0u}, gN[4] = {0u, 0u, 0u, 0u};
#define PG8_GLOAD(dst, u) do { int R0_, C0_; stage_rc(tid * 16, R0_, C0_); const int* rl_ = S.rowlist + (size_t)(u).pm * 256 + R0_; \
        _Pragma("unroll") for (int h_ = 0; h_ < 2; ++h_) _Pragma("unroll") for (int i_ = 0; i_ < 2; ++i_) dst[h_ * 2 + i_] = (unsigned)rl_[h_ * 128 + i_ * 64] * (unsigned)(K * 2) + (unsigned)(C0_ * 2); } while (0)
    const size_t kstep = (size_t)(BK * 2);
    const size_t hstep = (size_t)HALF * K * 2;
    const unsigned ldsw = (unsigned)wid * 1024u;
    const int aoff = lds_byte(wr * 64 + fr, fq * 8), boff = lds_byte(wc * 32 + fr, fq * 8);
#define PG8_SA(b, h) (((b) * 2 + (h)) * HTB)
#define PG8_SB(b, h) ((4 + (b) * 2 + (h)) * HTB)
#define PG8_STAGE(bufoff, gbase, voff) do { _Pragma("unroll") for (int _i = 0; _i < 2; ++_i) \
        __builtin_amdgcn_global_load_lds((const unsigned*)((const char*)(gbase) + (voff)[_i]), (LAS unsigned*)(lds + (bufoff) + ldsw + _i * 8192), 16, 0, 0); } while (0)
#define PG8_STAGE_A(bufoff, ptr, h) do { if constexpr (GATHER) { PG8_STAGE(bufoff, ptr, gA + 2 * (h)); } else { PG8_STAGE(bufoff, (ptr) + (h) * hstep, voffA); } } while (0)
#define PG8_LDA(dst, b, h) do { _Pragma("unroll") for (int m = 0; m < 4; ++m) _Pragma("unroll") for (int k = 0; k < 2; ++k) dst[m][k] = *(const LAS bf16x8*)(lds + PG8_SA(b, h) + aoff + m * 2048 + k * 1024); } while (0)
#define PG8_LDB(dst, b, h) do { _Pragma("unroll") for (int n = 0; n < 2; ++n) _Pragma("unroll") for (int k = 0; k < 2; ++k) dst[n][k] = *(const LAS bf16x8*)(lds + PG8_SB(b, h) + boff + n * 2048 + k * 1024); } while (0)
#define PG8_F8(x0, x1) __builtin_shufflevector(__builtin_bit_cast(i32x4_t, x0), __builtin_bit_cast(i32x4_t, x1), 0, 1, 2, 3, 4, 5, 6, 7)
#define PG8_MMA(ai, bj, At, Bt) do { __builtin_amdgcn_s_setprio(1); \
        if constexpr (FP8) { __builtin_amdgcn_sched_barrier(0); _Pragma("unroll") for (int m = 0; m < 4; ++m) _Pragma("unroll") for (int n = 0; n < 2; ++n) { \
            acc[ai][bj][m][n] = __builtin_amdgcn_mfma_scale_f32_16x16x128_f8f6f4(PG8_F8(Bt[n][0], Bt[n][1]), PG8_F8(At[m][0], At[m][1]), acc[ai][bj][m][n], 0, 0, 0, 0x7f7f7f7f, 0, 0x7f7f7f7f); } __builtin_amdgcn_sched_barrier(0); } \
        else { _Pragma("unroll") for (int m = 0; m < 4; ++m) _Pragma("unroll") for (int n = 0; n < 2; ++n) _Pragma("unroll") for (int k = 0; k < 2; ++k) \
            acc[ai][bj][m][n] = __builtin_amdgcn_mfma_f32_16x16x32_bf16(Bt[n][k], At[m][k], acc[ai][bj][m][n], 0, 0, 0); } \
        __builtin_amdgcn_s_setprio(0); } while (0)
#define PG8_WAIT_V(n) asm volatile("s_waitcnt vmcnt(" #n ")" ::: "memory")
#define PG8_WAIT_L(n) asm volatile("s_waitcnt lgkmcnt(" #n ")" ::: "memory")
#define PG8_BAR __builtin_amdgcn_s_barrier()
#define PG8_SCHED __builtin_amdgcn_sched_barrier(0)
    Unit cur, nxt; int ui = 0;
    if (!S.next(0, cur)) return;
    if (stag_ticks > 0) {
        const unsigned long long t0_ = __builtin_amdgcn_s_memrealtime(); const unsigned long long dl_ = (unsigned long long)stag_ticks;
        while (__builtin_amdgcn_s_memrealtime() - t0_ < dl_) __builtin_amdgcn_s_sleep(16);
    }
    f32x4 acc[2][2][4][2];
#pragma unroll
    for (int a = 0; a < 2; ++a)
#pragma unroll
        for (int b = 0; b < 2; ++b)
#pragma unroll
            for (int m = 0; m < 4; ++m)
#pragma unroll
                for (int n = 0; n < 2; ++n) acc[a][b][m][n] = (f32x4){0.f, 0.f, 0.f, 0.f};
    bf16x8 At[4][2], B0[2][2], B1[2][2];
    const char* cA = S.a_tile(cur); const char* cB = S.b_tile(cur);
    if constexpr (GATHER) { PG8_GLOAD(gA, cur); }
    PG8_STAGE(PG8_SB(0, 0), cB, voffB); PG8_STAGE(PG8_SB(0, 1), cB + hstep, voffB); PG8_STAGE_A(PG8_SA(0, 0), cA, 0); PG8_STAGE_A(PG8_SA(0, 1), cA, 1);
    if (wr == 1) PG8_BAR;
    PG8_WAIT_V(2); PG8_BAR;
    PG8_STAGE(PG8_SB(1, 0), cB + kstep, voffB); PG8_STAGE_A(PG8_SA(1, 0), cA + kstep, 0); PG8_STAGE(PG8_SB(1, 1), cB + hstep + kstep, voffB);
    PG8_WAIT_V(6); PG8_BAR;
    for (;;) {
        const bool has_next = S.next(ui + 1, nxt);
        const char* nA = has_next ? S.a_tile(nxt) : cA; const char* nB = has_next ? S.b_tile(nxt) : cB;
        if constexpr (GATHER) { if (has_next) { PG8_GLOAD(gN, nxt); } }
        for (int t = 0; t < nt; t += 2) {
            const bool last = (t == nt - 2);
            const char* a1 = cA + (size_t)(t + 1) * kstep;
            const char* a2 = last ? nA : cA + (size_t)(t + 2) * kstep; const char* b2 = last ? nB : cB + (size_t)(t + 2) * kstep;
            const char* a3 = a2 + kstep; const char* b3 = b2 + kstep;
            PG8_LDB(B0, 0, 0); PG8_LDB(B1, 0, 1); PG8_SCHED; PG8_LDA(At, 0, 0); PG8_STAGE_A(PG8_SA(1, 1), a1, 1);
            if constexpr (GATHER) { if (last && has_next) { gA[0] = gN[0]; gA[1] = gN[1]; gA[2] = gN[2]; gA[3] = gN[3]; } }
            PG8_WAIT_V(8); PG8_WAIT_L(0); PG8_BAR; PG8_MMA(0, 0, At, B0); PG8_MMA(0, 1, At, B1); PG8_BAR; PG8_SCHED;
            PG8_LDA(At, 0, 1); PG8_STAGE(PG8_SB(0, 0), b2, voffB); PG8_STAGE(PG8_SB(0, 1), b2 + hstep, voffB); PG8_STAGE_A(PG8_SA(0, 0), a2, 0);
            PG8_WAIT_V(8); PG8_WAIT_L(0); PG8_BAR; PG8_MMA(1, 0, At, B0); PG8_MMA(1, 1, At, B1); PG8_BAR; PG8_SCHED;
            PG8_LDB(B0, 1, 0); PG8_LDB(B1, 1, 1); PG8_SCHED; PG8_LDA(At, 1, 0); PG8_STAGE_A(PG8_SA(0, 1), a2, 1);
            PG8_WAIT_V(8); PG8_WAIT_L(0); PG8_BAR; PG8_MMA(0, 0, At, B0); PG8_MMA(0, 1, At, B1); PG8_BAR; PG8_SCHED;
            PG8_LDA(At, 1, 1); PG8_STAGE(PG8_SB(1, 0), b3, voffB); PG8_STAGE(PG8_SB(1, 1), b3 + hstep, voffB); PG8_STAGE_A(PG8_SA(1, 0), a3, 0);
            PG8_WAIT_V(8); PG8_WAIT_L(0); PG8_BAR; PG8_MMA(1, 0, At, B0); PG8_MMA(1, 1, At, B1); PG8_BAR; PG8_SCHED;
        }
        if (wr == 0) PG8_BAR;
        E(acc, cur, wr, wc, fr, fq);
        if (!has_next) break;
        if (!S.keep_acc(cur)) {
#pragma unroll
        for (int a = 0; a < 2; ++a)
#pragma unroll
            for (int b = 0; b < 2; ++b)
#pragma unroll
                for (int m = 0; m < 4; ++m)
#pragma unroll
                    for (int n = 0; n < 2; ++n) acc[a][b][m][n] = (f32x4){0.f, 0.f, 0.f, 0.f};
        }
        cur = nxt; cA = nA; cB = nB; ++ui;
        if (wr == 1) PG8_BAR;
    }
    PG8_WAIT_V(0);
    PG8_BAR;
#undef PG8_SA
#undef PG8_SB
#undef PG8_STAGE
#undef PG8_STAGE_A
#undef PG8_GLOAD
#undef PG8_LDA
#undef PG8_LDB
#undef PG8_MMA
#undef PG8_F8
#undef PG8_WAIT_V
#undef PG8_WAIT_L
#undef PG8_BAR
#undef PG8_SCHED
}

__device__ __forceinline__ bool static_unit(const long L, int nM, int nN, Unit& u);
__device__ __forceinline__ bool static_next(int i, int G, int c, int nM, int nN, Unit& u) { return static_unit((long)i * G + c, nM, nN, u); }
__device__ __forceinline__ bool static_unit(const long L, int nM, int nN, Unit& u) {
    const int nwg = nM * nN; if (L >= nwg) return false;
    int wgid = (int)L; { const int q = nwg / NXCD, r = nwg % NXCD, xcd = wgid % NXCD, off = wgid / NXCD; wgid = (xcd < r ? xcd * (q + 1) : r * (q + 1) + (xcd - r) * q) + off; }
    const int nig = WGM * nN, gid = wgid / nig, fm = gid * WGM, gsz = (nM - fm) < WGM ? (nM - fm) : WGM;
    u.pm = fm + ((wgid % nig) % gsz); u.pn = (wgid % nig) / gsz; u.z = 0; return true;
}
struct PlainSched {
    const char* A; const char* Bt; int K, nM, nN, G, c; static constexpr const int* rowlist = nullptr;
    __device__ __forceinline__ bool next(int i, Unit& u) const { return static_next(i, G, c, nM, nN, u); }
    __device__ __forceinline__ bool keep_acc(const Unit&) const { return false; }
    __device__ __forceinline__ const char* a_tile(const Unit& u) const { return A + (size_t)u.pm * 256 * K * 2; }
    __device__ __forceinline__ const char* b_tile(const Unit& u) const { return Bt + (size_t)u.pn * 256 * K * 2; }
};
struct G1Sched {
    const char* A; const char* Bt; int K, nM, nN, G, c, i0, n; static constexpr const int* rowlist = nullptr;
    __device__ __forceinline__ bool next(int i, Unit& u) const { if (i >= n) return false; const bool ok = static_next(i + i0, G, c, nM, nN, u); u.pn = (u.pn * 9) % 17; return ok; }
    __device__ __forceinline__ bool keep_acc(const Unit&) const { return false; }
    __device__ __forceinline__ const char* a_tile(const Unit& u) const { return A + (size_t)u.pm * 256 * K * 2; }
    __device__ __forceinline__ const char* b_tile(const Unit& u) const { return Bt + (size_t)u.pn * 256 * K * 2; }
};
struct G1aSched {
    const char* A; const char* Bt; int K, nM, G, c; static constexpr const int* rowlist = nullptr;
    __device__ __forceinline__ bool next(int i, Unit& u) const { const bool ok = static_next(i, G, c, nM, 7, u); u.pn = u.pn < 4 ? u.pn : u.pn + 10; return ok; }
    __device__ __forceinline__ bool keep_acc(const Unit&) const { return false; }
    __device__ __forceinline__ const char* a_tile(const Unit& u) const { return A + (size_t)u.pm * 256 * K * 2; }
    __device__ __forceinline__ const char* b_tile(const Unit& u) const { return Bt + (size_t)u.pn * 256 * K * 2; }
};
struct G1bSched {
    const char* A; const char* Bt; int K, nM, G, c; const int* rowlist;
    __device__ __forceinline__ bool next(int i, Unit& u) const { const long L = c < 184 ? (i < 4 ? (long)i * 184 + c : (i == 4 && c < 120 ? (long)736 + c : (long)1 << 30)) : 856 + (long)i * 72 + (c - 184);
        const bool ok = static_unit(L, nM, 10, u) && (c < 184 || i < 7); u.z = u.pn; u.pn += 4; return ok; }
    __device__ __forceinline__ bool keep_acc(const Unit&) const { return false; }
    __device__ __forceinline__ const char* a_tile(const Unit& u) const { return A; }
    __device__ __forceinline__ const char* b_tile(const Unit& u) const { return Bt + (size_t)u.z * 256 * K * 2; }
};
struct PlainGSched {
    const char* A; const char* Bt; int K, nM, nN, G, c; const int* rowlist;
    __device__ __forceinline__ bool next(int i, Unit& u) const { return static_next(i, G, c, nM, nN, u); }
    __device__ __forceinline__ bool keep_acc(const Unit&) const { return false; }
    __device__ __forceinline__ const char* a_tile(const Unit& u) const { return A; }
    __device__ __forceinline__ const char* b_tile(const Unit& u) const { return Bt + (size_t)u.pn * 256 * K * 2; }
};
struct PairSched {
    const char* A0; long dA; const char* B0; long dB; int K, nM, nN, G, c; static constexpr const int* rowlist = nullptr;
    __device__ __forceinline__ bool next(int i, Unit& u) const { const bool ok = static_next(i >> 1, G, c, nM, nN, u); u.z = i & 1; return ok; }
    __device__ __forceinline__ bool keep_acc(const Unit& u) const { return u.z == 0; }
    __device__ __forceinline__ const char* a_tile(const Unit& u) const { return A0 + (long)u.z * dA + (size_t)u.pm * 256 * K * 2; }
    __device__ __forceinline__ const char* b_tile(const Unit& u) const { return B0 + (long)u.z * dB + (size_t)u.pn * 256 * K * 2; }
};
struct PairGSched {
    const char* A0; long dA; const char* B0; long dB; int K, nM, nN, G, c; const int* rowlist;
    __device__ __forceinline__ bool next(int i, Unit& u) const { const bool ok = static_next(i >> 1, G, c, nM, nN, u); u.z = i & 1; return ok; }
    __device__ __forceinline__ bool keep_acc(const Unit& u) const { return u.z == 0; }
    __device__ __forceinline__ const char* a_tile(const Unit& u) const { return A0 + (long)u.z * dA; }
    __device__ __forceinline__ const char* b_tile(const Unit& u) const { return B0 + (long)u.z * dB + (size_t)u.pn * 256 * K * 2; }
};
struct MoeSched {
    const char* A; const char* Bt; int K; size_t bstride; int ntiles, G, c; const LAS int* tile_e; const int* rowlist;
    __device__ __forceinline__ bool next(int i, Unit& u) const { const long L = (long)i * G + c; const int t = (int)(L >> 2); if (t >= ntiles) return false;
        u.pm = t; u.pn = (int)(L & 3); u.z = __builtin_amdgcn_readfirstlane(tile_e[t]); return true; }
    __device__ __forceinline__ bool keep_acc(const Unit&) const { return false; }
    __device__ __forceinline__ const char* a_tile(const Unit& u) const { return rowlist ? A : A + (size_t)u.pm * 256 * K * 2; }
    __device__ __forceinline__ const char* b_tile(const Unit& u) const { return Bt + (size_t)u.z * bstride + (size_t)u.pn * 256 * K * 2; }
};
}
using pg8::Unit;

#define EPI_ROWS(u, wr, fr) const int row0_ = (u).pm * 256 + (wr) * 64 + (fr);
#define EPI_V8(v, acc, ai, bj, m) float v[8] = {acc[ai][bj][m][0][0], acc[ai][bj][m][0][1], acc[ai][bj][m][0][2], acc[ai][bj][m][0][3], acc[ai][bj][m][1][0], acc[ai][bj][m][1][1], acc[ai][bj][m][1][2], acc[ai][bj][m][1][3]}
__device__ __forceinline__ void store8_bf16(bf16_t* p, const float (&v)[8]) {
    u32x4 w; w.x = cvt_pk_bf16(v[0], v[1]); w.y = cvt_pk_bf16(v[2], v[3]); w.z = cvt_pk_bf16(v[4], v[5]); w.w = cvt_pk_bf16(v[6], v[7]);
    *(u32x4*)p = w;
}
__device__ __forceinline__ void rope8(float (&v)[8], int pos, int g, int fq, const LAS float* T) {
    const int p = g ? (pos & 63) : (pos >> 6);
    const LAS f32x4* t = (const LAS f32x4*)(T + p * 32 + (fq & 1) * 16);
    const f32x4 t0 = t[0], t1 = t[1], t2 = t[2], t3 = t[3];
    const float cs[8] = {t0[0], t0[2], t1[0], t1[2], t2[0], t2[2], t3[0], t3[2]};
    const float sn[8] = {t0[1], t0[3], t1[1], t1[3], t2[1], t2[3], t3[1], t3[3]};
    const bool lo = fq < 2;
#pragma unroll
    for (int i = 0; i < 8; ++i) { const float pv = xchg32(v[i], lo); v[i] = lo ? (v[i] * cs[i] - pv * sn[i]) : (v[i] * cs[i] + pv * sn[i]); }
}

struct EpiG1 {
    GAS unsigned char* ws; const LAS float* rope;
    __device__ __forceinline__ void operator()(f32x4 (&acc)[2][2][4][2], const Unit& u, int wr, int wc, int fr, int fq) const {
        EPI_ROWS(u, wr, fr)
        bf16_t* const qda = gp<bf16_t>(ws, WS_QDA); bf16_t* const kda = gp<bf16_t>(ws, WS_KDA); bf16_t* const vda = gp<bf16_t>(ws, WS_VDA); unsigned char* const gates = gp<unsigned char>(ws, WS_GATES);
        bf16_t* const cq = gp<bf16_t>(ws, WS_CQ); bf16_t* const ckv = gp<bf16_t>(ws, WS_CKV); bf16_t* const kr = gp<bf16_t>(ws, WS_KR); float* const rowsq = gp<float>(ws, WS_ROWSQ);
        const int pn = u.pn; const bool xrows = u.pm < (MX / 256);
        if (pn < 4) {
            bf16_t* dst = pn < 2 ? qda : kda; const int cb = (pn & 1) * 256 + wc * 32 + 8 * fq;
#pragma unroll
            for (int ai = 0; ai < 2; ++ai)
#pragma unroll
                for (int m = 0; m < 4; ++m) { const int row = row0_ + ai * 128 + m * 16;
#pragma unroll
                    for (int bj = 0; bj < 2; ++bj) { EPI_V8(v, acc, ai, bj, m); if (xrows) rope8(v, row & 4095, wc & 1, fq, rope); store8_bf16(dst + (size_t)row * 512 + cb + bj * 128, v); } }
        } else if (pn < 6) {
            const int cb = (pn - 4) * 256 + wc * 32 + 8 * fq;
#pragma unroll
            for (int ai = 0; ai < 2; ++ai)
#pragma unroll
                for (int m = 0; m < 4; ++m) { const int row = row0_ + ai * 128 + m * 16;
#pragma unroll
                    for (int bj = 0; bj < 2; ++bj) { EPI_V8(v, acc, ai, bj, m); store8_bf16(vda + (size_t)row * 512 + cb + bj * 128, v); } }
        } else if (pn == 14) {
            const int cb = wc * 32 + 8 * fq;
#pragma unroll
            for (int ai = 0; ai < 2; ++ai)
#pragma unroll
                for (int m = 0; m < 4; ++m) { const int row = row0_ + ai * 128 + m * 16; float ss = 0.f;
#pragma unroll
                    for (int bj = 0; bj < 2; ++bj) { EPI_V8(v, acc, ai, bj, m);
#pragma unroll
                        for (int i = 0; i < 8; ++i) ss += v[i] * v[i];
                        store8_bf16(cq + (size_t)row * 384 + cb + bj * 128, v); }
                    ss += shx(ss, 16, fq * 16 + fr); ss += shx(ss, 32, fq * 16 + fr);
                    if (fq == 0) rowsq[(size_t)row * 12 + wc] = ss; }
        } else if (pn == 15) {
            const int cb = wc * 32 + 8 * fq;
#pragma unroll
            for (int ai = 0; ai < 2; ++ai)
#pragma unroll
                for (int m = 0; m < 4; ++m) { const int row = row0_ + ai * 128 + m * 16; float ss = 0.f;
                    { EPI_V8(v, acc, ai, 0, m);
#pragma unroll
                        for (int i = 0; i < 8; ++i) ss += v[i] * v[i];
                        store8_bf16(cq + (size_t)row * 384 + 256 + cb, v); }
                    ss += shx(ss, 16, fq * 16 + fr); ss += shx(ss, 32, fq * 16 + fr);
                    if (fq == 0) rowsq[(size_t)row * 12 + 4 + wc] = ss;
                    if (wc < 2) { EPI_V8(v, acc, ai, 1, m); if (xrows) rope8(v, row & 4095, wc, fq, rope); store8_bf16(kr + (size_t)row * 64 + cb, v); } }
        } else {
            const int cb = wc * 32 + 8 * fq;
#pragma unroll
            for (int ai = 0; ai < 2; ++ai)
#pragma unroll
                for (int m = 0; m < 4; ++m) { const int row = row0_ + ai * 128 + m * 16; float ss = 0.f;
#pragma unroll
                    for (int bj = 0; bj < 2; ++bj) { EPI_V8(v, acc, ai, bj, m);
#pragma unroll
                        for (int i = 0; i < 8; ++i) ss += v[i] * v[i];
                        store8_bf16(ckv + (size_t)row * 256 + cb + bj * 128, v); }
                    ss += shx(ss, 16, fq * 16 + fr); ss += shx(ss, 32, fq * 16 + fr);
                    if (fq == 0) rowsq[(size_t)row * 12 + 8 + wc] = ss; }
        }
    }
};
struct EpiGate {
    GAS unsigned char* ws;
    __device__ __forceinline__ void operator()(f32x4 (&acc)[2][2][4][2], const Unit& u, int wr, int wc, int fr_, int fq_) const {
        const int lz = opaque_tid() & 63, fr = lz & 15, fq = lz >> 4;
        EPI_ROWS(u, wr, fr)
        unsigned char* const gates = gp<unsigned char>(ws, WS_GATES); const int pn = u.pn;
        if (pn < 6) {
            bf16_t* const vda = gp<bf16_t>(ws, WS_VDA); const int cb = (pn - 4) * 256 + wc * 32 + 8 * fq;
#pragma unroll
            for (int ai = 0; ai < 2; ++ai)
#pragma unroll
                for (int m = 0; m < 4; ++m) { const int row = row0_ + ai * 128 + m * 16;
#pragma unroll
                    for (int bj = 0; bj < 2; ++bj) { EPI_V8(v, acc, ai, bj, m);
#pragma unroll
                        for (int i = 0; i < 8; ++i) v[i] *= (1.0f / 64.0f);
                        store8_bf16(vda + (size_t)row * 512 + cb + bj * 128, v); } }
        } else {
            const int cb = (pn - 6) * 256 + wc * 32 + 8 * fq;
            const float glo = pn >= 10 ? 1.0f : 0.0f;
#pragma unroll
            for (int ai = 0; ai < 2; ++ai)
#pragma unroll
                for (int m = 0; m < 4; ++m) { const int row = row0_ + ai * 128 + m * 16;
#pragma unroll
                    for (int bj = 0; bj < 2; ++bj) { EPI_V8(v, acc, ai, bj, m);
#pragma unroll
                        for (int i = 0; i < 8; ++i) v[i] = fmaxf(sigmoidf_(v[i] * (1.0f / 64.0f)) * 255.0f, glo);
                        u32x2 w = (u32x2){0u, 0u};
#pragma unroll
                        for (int i = 0; i < 4; ++i) { w.x = __builtin_amdgcn_cvt_pk_u8_f32(v[i], i, w.x); w.y = __builtin_amdgcn_cvt_pk_u8_f32(v[4 + i], i, w.y); }
                        *(u32x2*)(gates + (size_t)row * 2048 + cb + bj * 128) = w; } }
        }
    }
};
struct EpiNull {
    __device__ __forceinline__ void operator()(f32x4 (&acc)[2][2][4][2], const Unit& u, int wr, int wc, int fr, int fq) const {
#pragma unroll
        for (int ai = 0; ai < 2; ++ai)
#pragma unroll
            for (int bj = 0; bj < 2; ++bj)
#pragma unroll
                for (int m = 0; m < 4; ++m)
#pragma unroll
                    for (int n = 0; n < 2; ++n) asm volatile("" :: "v"(acc[ai][bj][m][n]));
    }
};
struct EpiQMla {
    GAS unsigned char* ws; const LAS float* rope;
    __device__ __forceinline__ void operator()(f32x4 (&acc)[2][2][4][2], const Unit& u, int wr, int wc, int fr_, int fq) const {
        const int fr = opaque_tid() & 15;
        EPI_ROWS(u, wr, fr)
        bf16_t* const qmla = gp<bf16_t>(ws, WS_QMLA); const float* const rowsq = gp<const float>(ws, WS_ROWSQ);
        const bool xrows = u.pm < (MX / 256);
#pragma unroll
        for (int ai = 0; ai < 2; ++ai)
#pragma unroll
            for (int m = 0; m < 4; ++m) { const int row = row0_ + ai * 128 + m * 16;
                const f32x4 q0_ = *(const f32x4*)(rowsq + (size_t)row * 12), q1_ = *(const f32x4*)(rowsq + (size_t)row * 12 + 4);
                const float sc = rsqrtf((((q0_[0] + q0_[1]) + (q0_[2] + q0_[3])) + ((q1_[0] + q1_[1]) + (q1_[2] + q1_[3]))) * (1.0f / 384.0f) + EPS);
#pragma unroll
                for (int bj = 0; bj < 2; ++bj) { const int g32 = u.pn * 8 + bj * 4 + wc, j = g32 % 6;
                    EPI_V8(v, acc, ai, bj, m);
#pragma unroll
                    for (int i = 0; i < 8; ++i) v[i] *= sc;
                    if (xrows && j >= 4) rope8(v, row & 4095, j - 4, fq, rope);
                    store8_bf16(qmla + (size_t)row * 768 + g32 * 32 + 8 * fq, v); } }
    }
};
struct EpiKvMla {
    GAS unsigned char* ws;
    __device__ __forceinline__ void operator()(f32x4 (&acc)[2][2][4][2], const Unit& u, int wr, int wc, int fr_, int fq) const {
        const int fr = opaque_tid() & 15;
        EPI_ROWS(u, wr, fr)
        bf16_t* const kvmla = gp<bf16_t>(ws, WS_KVMLA); const float* const rowsq = gp<const float>(ws, WS_ROWSQ);
        const int cb = u.pn * 256 + wc * 32 + 8 * fq;
#pragma unroll
        for (int ai = 0; ai < 2; ++ai)
#pragma unroll
            for (int m = 0; m < 4; ++m) { const int row = row0_ + ai * 128 + m * 16;
                const f32x4 q2_ = *(const f32x4*)(rowsq + (size_t)row * 12 + 8);
                const float sc = rsqrtf(((q2_[0] + q2_[1]) + (q2_[2] + q2_[3])) * (1.0f / 256.0f) + EPS);
#pragma unroll
                for (int bj = 0; bj < 2; ++bj) { EPI_V8(v, acc, ai, bj, m);
#pragma unroll
                    for (int i = 0; i < 8; ++i) v[i] *= sc;
                    store8_bf16(kvmla + (size_t)row * 1024 + cb + bj * 128, v); } }
    }
};
struct EpiBranch {
    GAS unsigned char* ws;
    __device__ __forceinline__ void operator()(f32x4 (&acc)[2][2][4][2], const Unit& u, int wr, int wc, int fr, int fq) const {
        EPI_ROWS(u, wr, fr)
        unsigned char* const U8 = gp<unsigned char>(ws, WS_U); const unsigned char* const gates = gp<const unsigned char>(ws, WS_GATES);
        const int cb = u.pn * 256 + wc * 32 + 8 * fq;
#define UNPK8(g) {(float)(g.x & 255u), (float)((g.x >> 8) & 255u), (float)((g.x >> 16) & 255u), (float)(g.x >> 24), (float)(g.y & 255u), (float)((g.y >> 8) & 255u), (float)((g.y >> 16) & 255u), (float)(g.y >> 24)}
        if (u.z == 0) {
#pragma unroll
            for (int ai = 0; ai < 2; ++ai) { u32x2 ga_[4][2], gb_[4][2];
#pragma unroll
                for (int m = 0; m < 4; ++m)
#pragma unroll
                    for (int bj = 0; bj < 2; ++bj) { const unsigned char* gp_ = gates + (size_t)(row0_ + ai * 128 + m * 16) * 2048 + cb + bj * 128; ga_[m][bj] = *(const u32x2*)gp_; gb_[m][bj] = *(const u32x2*)(gp_ + 1024); }
                __builtin_amdgcn_sched_barrier(0);
#pragma unroll
                for (int m = 0; m < 4; ++m)
#pragma unroll
                    for (int bj = 0; bj < 2; ++bj) { const float a_[8] = UNPK8(ga_[m][bj]); const float b_[8] = UNPK8(gb_[m][bj]);
#pragma unroll
                        for (int i = 0; i < 4; ++i) { acc[ai][bj][m][0][i] *= a_[i] * __builtin_amdgcn_rcpf(b_[i]); acc[ai][bj][m][1][i] *= a_[4 + i] * __builtin_amdgcn_rcpf(b_[4 + i]); } }
            }
        } else {
#pragma unroll
            for (int ai = 0; ai < 2; ++ai) { u32x2 gb_[4][2];
#pragma unroll
                for (int m = 0; m < 4; ++m)
#pragma unroll
                    for (int bj = 0; bj < 2; ++bj) gb_[m][bj] = *(const u32x2*)(gates + (size_t)(row0_ + ai * 128 + m * 16) * 2048 + 1024 + cb + bj * 128);
                __builtin_amdgcn_sched_barrier(0);
#pragma unroll
                for (int m = 0; m < 4; ++m)
#pragma unroll
                    for (int bj = 0; bj < 2; ++bj) { const float b_[8] = UNPK8(gb_[m][bj]); EPI_V8(v, acc, ai, bj, m);
#pragma unroll
                        for (int i = 0; i < 8; ++i) v[i] = fminf(fmaxf(v[i] * b_[i] * (8.0f / 255.0f / 512.0f), -448.0f), 448.0f);
                        int w0 = __builtin_amdgcn_cvt_pk_fp8_f32(v[0], v[1], 0, false); w0 = __builtin_amdgcn_cvt_pk_fp8_f32(v[2], v[3], w0, true);
                        int w1 = __builtin_amdgcn_cvt_pk_fp8_f32(v[4], v[5], 0, false); w1 = __builtin_amdgcn_cvt_pk_fp8_f32(v[6], v[7], w1, true);
                        *(u32x2*)(U8 + (size_t)(row0_ + ai * 128 + m * 16) * 1024 + cb + bj * 128) = (u32x2){(unsigned)w0, (unsigned)w1}; }
            }
        }
#undef UNPK8
    }
};
struct EpiOut {
    bf16_t* XS; const float* xin; const float* ctx; const float* mod_l; int first;
    __device__ __forceinline__ void operator()(f32x4 (&acc)[2][2][4][2], const Unit& u, int wr, int wc, int fr, int fq) const {
        EPI_ROWS(u, wr, fr)
        const int cb = u.pn * 256 + wc * 32 + 8 * fq;
        const bool xrows = u.pm < (MX / 256);
        const int bidx = xrows ? (u.pm >> 4) : 8;
        const float* g1 = mod_l + (size_t)bidx * 6144 + 2048;
        if (first) {
            const float* base = xrows ? xin : ctx - (size_t)MX * 1024;
#pragma unroll
            for (int bj = 0; bj < 2; ++bj) { const int col = cb + bj * 128;
                const f32x4 ga = *(const f32x4*)(g1 + col) * (1.0f / 512.0f), gb = *(const f32x4*)(g1 + col + 4) * (1.0f / 512.0f);
#pragma unroll
                for (int ai = 0; ai < 2; ++ai) { f32x4 b0_[4], b1_[4];
#pragma unroll
                    for (int m = 0; m < 4; ++m) { const size_t off = (size_t)(row0_ + ai * 128 + m * 16) * 1024 + col; b0_[m] = *(const f32x4*)(base + off); b1_[m] = *(const f32x4*)(base + off + 4); }
                    __builtin_amdgcn_sched_barrier(0);
#pragma unroll
                    for (int m = 0; m < 4; ++m) { const size_t off = (size_t)(row0_ + ai * 128 + m * 16) * 1024 + col;
                        const f32x4 r0 = b0_[m] + ga * acc[ai][bj][m][0], r1 = b1_[m] + gb * acc[ai][bj][m][1];
                        u32x4 w; w.x = cvt_pk_bf16(r0.x, r0.y); w.y = cvt_pk_bf16(r0.z, r0.w); w.z = cvt_pk_bf16(r1.x, r1.y); w.w = cvt_pk_bf16(r1.z, r1.w); *(u32x4*)(XS + off) = w; } } }
        } else {
#pragma unroll
            for (int bj = 0; bj < 2; ++bj) { const int col = cb + bj * 128;
                const f32x4 ga = *(const f32x4*)(g1 + col) * (1.0f / 512.0f), gb = *(const f32x4*)(g1 + col + 4) * (1.0f / 512.0f);
#pragma unroll
                for (int ai = 0; ai < 2; ++ai) { u32x4 bb[4];
#pragma unroll
                    for (int m = 0; m < 4; ++m) { const size_t off = (size_t)(row0_ + ai * 128 + m * 16) * 1024 + col; bb[m] = *(const u32x4*)(XS + off); }
                    __builtin_amdgcn_sched_barrier(0);
#pragma unroll
                    for (int m = 0; m < 4; ++m) { const size_t off = (size_t)(row0_ + ai * 128 + m * 16) * 1024 + col;
                        const f32x4 b0 = (f32x4){bf_lo(bb[m].x), bf_hi(bb[m].x), bf_lo(bb[m].y), bf_hi(bb[m].y)}, b1 = (f32x4){bf_lo(bb[m].z), bf_hi(bb[m].z), bf_lo(bb[m].w), bf_hi(bb[m].w)};
                        const f32x4 r0 = b0 + ga * acc[ai][bj][m][0], r1 = b1 + gb * acc[ai][bj][m][1];
                        u32x4 w; w.x = cvt_pk_bf16(r0.x, r0.y); w.y = cvt_pk_bf16(r0.z, r0.w); w.z = cvt_pk_bf16(r1.x, r1.y); w.w = cvt_pk_bf16(r1.z, r1.w); *(u32x4*)(XS + off) = w; } } }
        }
    }
};
struct EpiUp {
    unsigned char* act; const float* bgu;
    __device__ __forceinline__ void operator()(f32x4 (&acc)[2][2][4][2], const Unit& u, int wr, int wc, int fr, int fq) const {
        EPI_ROWS(u, wr, fr)
        const int j0 = u.pn * 128 + wc * 32 + 8 * fq;
        const float* bg = bgu + (size_t)u.z * 1024 + j0;
        const f32x4 g0 = *(const f32x4*)bg, g1 = *(const f32x4*)(bg + 4), l0 = *(const f32x4*)(bg + 512), l1 = *(const f32x4*)(bg + 516);
        const float bgv[8] = {g0[0], g0[1], g0[2], g0[3], g1[0], g1[1], g1[2], g1[3]}, blv[8] = {l0[0], l0[1], l0[2], l0[3], l1[0], l1[1], l1[2], l1[3]};
#pragma unroll
        for (int ai = 0; ai < 2; ++ai)
#pragma unroll
            for (int m = 0; m < 4; ++m) { const int row = row0_ + ai * 128 + m * 16;
                EPI_V8(gt, acc, ai, 0, m); EPI_V8(ln, acc, ai, 1, m); float o[8];
#pragma unroll
                for (int i = 0; i < 8; ++i) { const float g = fminf(gt[i] * (1.0f / 64.0f) + bgv[i], 7.0f); const float li = fminf(fmaxf(ln[i] * (1.0f / 64.0f) + blv[i], -7.0f), 7.0f);
                    o[i] = fminf(fmaxf((li + 1.0f) * g * sigmoidf_(1.702f * g) * 8.0f, -448.0f), 448.0f); }
                int w0 = __builtin_amdgcn_cvt_pk_fp8_f32(o[0], o[1], 0, false); w0 = __builtin_amdgcn_cvt_pk_fp8_f32(o[2], o[3], w0, true);
                int w1 = __builtin_amdgcn_cvt_pk_fp8_f32(o[4], o[5], 0, false); w1 = __builtin_amdgcn_cvt_pk_fp8_f32(o[6], o[7], w1, true);
                *(u32x2*)(act + (size_t)row * 512 + j0) = (u32x2){(unsigned)w0, (unsigned)w1}; }
    }
};
struct EpiDown {
    unsigned char* Y; const float* bdn;
    __device__ __forceinline__ void operator()(f32x4 (&acc)[2][2][4][2], const Unit& u, int wr, int wc, int fr, int fq) const {
        EPI_ROWS(u, wr, fr)
        const int cb = u.pn * 256 + wc * 32 + 8 * fq;
#pragma unroll
        for (int bj = 0; bj < 2; ++bj) { const int col = cb + bj * 128; const float* bp = bdn + (size_t)u.z * 1024 + col;
            const f32x4 b0 = *(const f32x4*)bp, b1 = *(const f32x4*)(bp + 4);
#pragma unroll
            for (int ai = 0; ai < 2; ++ai)
#pragma unroll
                for (int m = 0; m < 4; ++m) { const int row = row0_ + ai * 128 + m * 16;
                    f32x4 a0 = acc[ai][bj][m][0] * (1.0f / 64.0f) + b0 * 8.0f, a1 = acc[ai][bj][m][1] * (1.0f / 64.0f) + b1 * 8.0f;
#pragma unroll
                    for (int i = 0; i < 4; ++i) { a0[i] = fminf(fmaxf(a0[i], -448.0f), 448.0f); a1[i] = fminf(fmaxf(a1[i], -448.0f), 448.0f); }
                    int w0 = __builtin_amdgcn_cvt_pk_fp8_f32(a0[0], a0[1], 0, false); w0 = __builtin_amdgcn_cvt_pk_fp8_f32(a0[2], a0[3], w0, true);
                    int w1 = __builtin_amdgcn_cvt_pk_fp8_f32(a1[0], a1[1], 0, false); w1 = __builtin_amdgcn_cvt_pk_fp8_f32(a1[2], a1[3], w1, true);
                    *(u32x2*)(Y + (size_t)row * 1024 + col) = (u32x2){(unsigned)w0, (unsigned)w1}; } }
    }
};

namespace att {
constexpr int NW = 8, QBLK = 32, KVBLK = 64;
constexpr int SHM_V = 16384, SHM_KR = 8192, SHM_KN = 16384;
constexpr int OFF_V = 0, OFF_KR = 3 * SHM_V, OFF_KN = OFF_KR + 3 * SHM_KR, OFF_WS = OFF_KN + 3 * SHM_KN;
static_assert(OFF_WS + 2048 <= 131072, "attention LDS map");
constexpr float THR = 8.f;
#define KSLAB(row, c) ((((c) >> 4) * 2048) + (row) * 32 + ((((((c) >> 3) & 1) ^ (((row) >> 3) & 1))) << 4))
#define SBAR() __builtin_amdgcn_sched_barrier(0)
__device__ __forceinline__ int crow(int r, int hi) { return (r & 3) + 8 * (r >> 2) + 4 * hi; }
template <int DN> struct SC { static constexpr float SCALE = DN ? 0.07216878364870322f : 0.125f; };
__device__ __forceinline__ void psm1(const f32x16& p0, float& pmax) {
    pmax = p0[0];
#pragma unroll
    for (int r = 1; r < 16; ++r) pmax = fmaxf(pmax, p0[r]);
}
template <int DN>
__device__ __forceinline__ void psm2(const f32x16& p1, float& pmax, float& m_reg, float& mn, float& alpha) {
    constexpr float SCALE = SC<DN>::SCALE, C = SCALE * 1.4426950408889634f;
#pragma unroll
    for (int r = 0; r < 16; ++r) pmax = fmaxf(pmax, p1[r]);
    { auto rr = __builtin_amdgcn_permlane32_swap(__float_as_uint(pmax), __float_as_uint(pmax), false, false);
      pmax = fmaxf(__uint_as_float(rr[0]), __uint_as_float(rr[1])); }
    if (__builtin_expect(__all(pmax - m_reg <= THR / SCALE), 1)) { mn = m_reg; alpha = 1.f; }
    else { mn = fmaxf(m_reg, pmax); alpha = __builtin_amdgcn_exp2f((m_reg - mn) * C); m_reg = mn; }
}
template <int DN>
__device__ __forceinline__ void psm3(f32x16& p0, f32x16& p1, float mn) {
    constexpr float SCALE = SC<DN>::SCALE, C = SCALE * 1.4426950408889634f;
    const float mnC = -mn * C;
#pragma unroll
    for (int r = 0; r < 16; ++r) p0[r] = fmaf(p0[r], C, mnC);
#pragma unroll
    for (int r = 0; r < 16; ++r) p1[r] = fmaf(p1[r], C, mnC);
}
__device__ __forceinline__ void psm4(f32x16& p0) {
#pragma unroll
    for (int r = 0; r < 16; ++r) p0[r] = __builtin_amdgcn_exp2f(p0[r]);
}
template <int DN>
__device__ __forceinline__ void partialSM(f32x16& p0, f32x16& p1, float& m_reg, float& mn, float& alpha) {
    float pmax; psm1(p0, pmax); psm2<DN>(p1, pmax, m_reg, mn, alpha); psm3<DN>(p0, p1, mn); psm4(p0);
}
__device__ __forceinline__ void finishSM(f32x16& p0, f32x16& p1, float alpha, float& l_reg, bf16x8& pa0, bf16x8& pa1, bf16x8& pa2, bf16x8& pa3) {
#pragma unroll
    for (int r = 0; r < 16; ++r) p1[r] = __builtin_amdgcn_exp2f(p1[r]);
    float ps = 0;
#pragma unroll
    for (int r = 0; r < 16; ++r) ps += p0[r];
#pragma unroll
    for (int r = 0; r < 16; ++r) ps += p1[r];
    { auto rr = __builtin_amdgcn_permlane32_swap(__float_as_uint(ps), __float_as_uint(ps), false, false);
      ps = __uint_as_float(rr[0]) + __uint_as_float(rr[1]); }
    l_reg = l_reg * alpha + ps;
#define PK4(P, BASE, OUT) do { unsigned a0 = cvt_pk_bf16(P[BASE + 0], P[BASE + 1]), a1 = cvt_pk_bf16(P[BASE + 2], P[BASE + 3]);   \
    unsigned b0 = cvt_pk_bf16(P[BASE + 4], P[BASE + 5]), b1 = cvt_pk_bf16(P[BASE + 6], P[BASE + 7]);                              \
    auto r0 = __builtin_amdgcn_permlane32_swap(a0, b0, false, false); auto r1 = __builtin_amdgcn_permlane32_swap(a1, b1, false, false); \
    u32x4 w = {r0[0], r1[0], r0[1], r1[1]}; OUT = *reinterpret_cast<bf16x8*>(&w); } while (0)
    PK4(p0, 0, pa0); PK4(p0, 8, pa1); PK4(p1, 0, pa2); PK4(p1, 8, pa3);
#undef PK4
}
template <int DN>
__device__ __forceinline__ void qkt(f32x16& p0, f32x16& p1, const LAS char* Kn, const LAS char* Kr, const bf16x8* qn, const bf16x8* qr, int kb) {
    p0 = f32x16{}; p1 = f32x16{};
    if constexpr (DN > 0) {
#pragma unroll
        for (int d0 = 0; d0 < DN / 16; ++d0) {
            const bf16x8 b0 = *(const LAS bf16x8*)(Kn + kb + d0 * 2048);
            const bf16x8 b1 = *(const LAS bf16x8*)(Kn + kb + d0 * 2048 + 1024);
            p0 = __builtin_amdgcn_mfma_f32_32x32x16_bf16(b0, qn[d0], p0, 0, 0, 0);
            p1 = __builtin_amdgcn_mfma_f32_32x32x16_bf16(b1, qn[d0], p1, 0, 0, 0); }
    }
#pragma unroll
    for (int d0 = 0; d0 < 4; ++d0) {
        const bf16x8 b0 = *(const LAS bf16x8*)(Kr + kb + d0 * 2048);
        const bf16x8 b1 = *(const LAS bf16x8*)(Kr + kb + d0 * 2048 + 1024);
        p0 = __builtin_amdgcn_mfma_f32_32x32x16_bf16(b0, qr[d0], p0, 0, 0, 0);
        p1 = __builtin_amdgcn_mfma_f32_32x32x16_bf16(b1, qr[d0], p1, 0, 0, 0); }
}
__device__ __forceinline__ int v_st(int k, int c) { const int kk = (k & ~0xC) | ((k & 4) << 1) | ((k & 8) >> 1); return ((kk >> 3) * 4 + (c >> 5)) * 512 + ((kk & 7) * 32 + (c & 31)) * 2; }
__device__ __forceinline__ int v_rd_base(int lane) { return ((lane & 3) << 3) | (((lane >> 2) & 3) << 6) | (((lane >> 4) & 1) << 5) | (((lane >> 5) & 1) << 8); }
constexpr int v_rd_off(int d0, int ks, int half) { return d0 * 512 + ks * 4096 + half * 2048; }
template <int OFF> __device__ __forceinline__ s16x4 tr_read(int vb) {
    s16x4 r; asm volatile("ds_read_b64_tr_b16 %0, %1 offset:%2" : "=&v"(r) : "v"(vb), "i"(OFF) : "memory"); return r;
}
template <int D0> __device__ __forceinline__ void pv_one(f32x16& od, int vb, bf16x8 pa0, bf16x8 pa1, bf16x8 pa2, bf16x8 pa3) {
    const s16x4 l0 = tr_read<v_rd_off(D0, 0, 0)>(vb), h0 = tr_read<v_rd_off(D0, 0, 1)>(vb), l1 = tr_read<v_rd_off(D0, 1, 0)>(vb), h1 = tr_read<v_rd_off(D0, 1, 1)>(vb);
    const s16x4 l2 = tr_read<v_rd_off(D0, 2, 0)>(vb), h2 = tr_read<v_rd_off(D0, 2, 1)>(vb), l3 = tr_read<v_rd_off(D0, 3, 0)>(vb), h3 = tr_read<v_rd_off(D0, 3, 1)>(vb);
    asm volatile("s_waitcnt lgkmcnt(0)" ::: "memory"); SBAR();
#define PK(L, H) (bf16x8){L[0], L[1], L[2], L[3], H[0], H[1], H[2], H[3]}
    od = __builtin_amdgcn_mfma_f32_32x32x16_bf16(pa0, PK(l0, h0), od, 0, 0, 0);
    od = __builtin_amdgcn_mfma_f32_32x32x16_bf16(pa1, PK(l1, h1), od, 0, 0, 0);
    od = __builtin_amdgcn_mfma_f32_32x32x16_bf16(pa2, PK(l2, h2), od, 0, 0, 0);
    od = __builtin_amdgcn_mfma_f32_32x32x16_bf16(pa3, PK(l3, h3), od, 0, 0, 0);
#undef PK
}
template <int DN>
__device__ __forceinline__ void pv_sm(f32x16* o, int vb, bf16x8 pa0, bf16x8 pa1, bf16x8 pa2, bf16x8 pa3, f32x16& p0, f32x16& p1, float& m_reg, float& mn, float& alpha) {
    float pmax;
    pv_one<0>(o[0], vb, pa0, pa1, pa2, pa3); psm1(p0, pmax);
    pv_one<1>(o[1], vb, pa0, pa1, pa2, pa3); psm2<DN>(p1, pmax, m_reg, mn, alpha);
    pv_one<2>(o[2], vb, pa0, pa1, pa2, pa3); psm3<DN>(p0, p1, mn);
    pv_one<3>(o[3], vb, pa0, pa1, pa2, pa3); psm4(p0);
}
__device__ __forceinline__ void pv_d0(f32x16* o, int vb, bf16x8 pa0, bf16x8 pa1, bf16x8 pa2, bf16x8 pa3) {
    pv_one<0>(o[0], vb, pa0, pa1, pa2, pa3); pv_one<1>(o[1], vb, pa0, pa1, pa2, pa3); pv_one<2>(o[2], vb, pa0, pa1, pa2, pa3); pv_one<3>(o[3], vb, pa0, pa1, pa2, pa3);
}
template <int DN, int LDQ, int LDKN, int LDKR, int LDV, int LDO, int SDEPTH>
__device__ __forceinline__ void attn_unit(const bf16_t* __restrict__ Qn, const bf16_t* __restrict__ Qr, const bf16_t* __restrict__ Kng, const bf16_t* __restrict__ Krg,
                                          const bf16_t* __restrict__ Vg, bf16_t* __restrict__ Ob, const int q0, const int kx0, const int ky0, const int ntx, const int NT, char* lds, unsigned char* __restrict__ O8 = nullptr) {
    const int tid = opaque_tid(), wid = tid >> 6, lane = tid & 63, r32 = lane & 31, hi = lane >> 5;
    char* V_lds = lds + OFF_V; char* KR_lds = lds + OFF_KR; char* KN_lds = lds + OFF_KN;
    float* ws = (float*)(lds + OFF_WS) + wid * 64; float* li_l = ws; float* al_l = ws + 32;
    float m_reg = -1e30f, l_reg = 0; f32x16 o[4] = {}; bf16x8 qn[DN ? DN / 16 : 1], qr[4];
    { const size_t qrow = (size_t)(q0 + wid * QBLK + r32);
      if constexpr (DN > 0) {
#pragma unroll
          for (int d0 = 0; d0 < DN / 16; ++d0) qn[d0] = *reinterpret_cast<const bf16x8*>(Qn + qrow * LDQ + hi * 8 + d0 * 16);
      }
#pragma unroll
      for (int d0 = 0; d0 < 4; ++d0) qr[d0] = *reinterpret_cast<const bf16x8*>(Qr + qrow * LDQ + hi * 8 + d0 * 16); }
    const int sr = tid >> 4, sc = (tid & 15) * 8, vst0 = v_st(sr, sc), vst1 = v_st(32 + sr, sc);
    const int rr_ = tid >> 3, rc_ = (tid & 7) * 8;
    const int vb0 = (int)(uintptr_t)V_lds + v_rd_base(lane);
    const int kb_ = KSLAB(r32, hi * 8);
#define KROW(j) __builtin_amdgcn_readfirstlane((j) < ntx ? kx0 + (j) * KVBLK : ky0 + ((j) - ntx) * KVBLK)
    const int wv_ = __builtin_amdgcn_readfirstlane(tid >> 6);
    unsigned ogV[2], ogN[2], ogR;
#pragma unroll
    for (int i = 0; i < 2; ++i) { const int b = tid * 16 + i * 8192;
        { const int sub = b >> 9, within = b & 511, kk = (sub >> 2) * 8 + (within >> 6), k = (kk & ~0xC) | ((kk & 4) << 1) | ((kk & 8) >> 1), c = (sub & 3) * 32 + ((within & 63) >> 1); ogV[i] = (unsigned)(k * LDV + c) * 2u; }
        { const int d0 = b >> 11, rem = b & 2047, row = rem >> 5, half = ((rem >> 4) & 1) ^ ((row >> 3) & 1); ogN[i] = (unsigned)(row * LDKN + d0 * 16 + half * 8) * 2u; } }
    { const int b = tid * 16, d0 = b >> 11, rem = b & 2047, row = rem >> 5, half = ((rem >> 4) & 1) ^ ((row >> 3) & 1); ogR = (unsigned)(row * LDKR + d0 * 16 + half * 8) * 2u; }
    LAS char* const V3 = (LAS char*)V_lds; LAS char* const KR3 = (LAS char*)KR_lds; LAS char* const KN3 = (LAS char*)KN_lds;
#define DMA16(gp, lp) __builtin_amdgcn_global_load_lds((const unsigned*)(gp), (LAS unsigned*)(lp), 16, 0, 0)
#define SDMA(j, b) do { const size_t k0_ = (size_t)KROW(j); const char* vb_ = (const char*)(Vg + k0_ * LDV); const char* rb_ = (const char*)(Krg + k0_ * LDKR); \
    DMA16(vb_ + ogV[0], V3 + (b) * SHM_V + wv_ * 1024); DMA16(vb_ + ogV[1], V3 + (b) * SHM_V + wv_ * 1024 + 8192); \
    if constexpr (DN > 0) { const char* nb_ = (const char*)(Kng + k0_ * LDKN); DMA16(nb_ + ogN[0], KN3 + (b) * SHM_KN + wv_ * 1024); DMA16(nb_ + ogN[1], KN3 + (b) * SHM_KN + wv_ * 1024 + 8192); } \
    DMA16(rb_ + ogR, KR3 + (b) * SHM_KR + wv_ * 1024); } while (0)
#define DMAWAIT() asm volatile("s_waitcnt vmcnt(0)" ::: "memory")
#define RESC(a) do { if (__any((a) < 1.f)) { if (hi == 0) al_l[r32] = (a); asm volatile("s_waitcnt lgkmcnt(0)" ::: "memory"); \
    _Pragma("unroll") for (int d = 0; d < 4; ++d) _Pragma("unroll") for (int r = 0; r < 16; ++r) o[d][r] *= al_l[crow(r, hi)]; } } while (0)
    f32x16 pA0, pA1, pB0, pB1; float mnA, mnB, alA, alB; bf16x8 pa0, pa1, pa2, pa3;
    SDMA(0, 0); SDMA(1, 1); if (2 < NT) SDMA(2, 2); DMAWAIT(); __syncthreads();
    qkt<DN>(pA0, pA1, (const LAS char*)KN3, (const LAS char*)KR3, qn, qr, kb_); partialSM<DN>(pA0, pA1, m_reg, mnA, alA);
    int bK = 1, bV = 0;
#define TRIP(C0, C1, MNC, ALC, P0, P1, ALP, j) do { \
        SBAR(); qkt<DN>(C0, C1, (const LAS char*)(KN3 + bK * SHM_KN), (const LAS char*)(KR3 + bK * SHM_KR), qn, qr, kb_); \
        finishSM(P0, P1, ALP, l_reg, pa0, pa1, pa2, pa3); SBAR(); \
        pv_sm<DN>(o, vb0 + bV * SHM_V, pa0, pa1, pa2, pa3, C0, C1, m_reg, MNC, ALC); \
        RESC(ALC); \
        DMAWAIT(); __syncthreads(); \
        if ((j) + 2 < NT) SDMA((j) + 2, bV); \
        bV = bK; bK = (bK == 2) ? 0 : bK + 1; } while (0)
    for (int j = 1; j + 1 < NT; j += 2) {
        TRIP(pB0, pB1, mnB, alB, pA0, pA1, alA, j);
        TRIP(pA0, pA1, mnA, alA, pB0, pB1, alB, j + 1);
    }
    SBAR(); qkt<DN>(pB0, pB1, (const LAS char*)(KN3 + bK * SHM_KN), (const LAS char*)(KR3 + bK * SHM_KR), qn, qr, kb_);
    finishSM(pA0, pA1, alA, l_reg, pa0, pa1, pa2, pa3); SBAR();
    pv_sm<DN>(o, vb0 + bV * SHM_V, pa0, pa1, pa2, pa3, pB0, pB1, m_reg, mnB, alB);
    RESC(alB);
    finishSM(pB0, pB1, alB, l_reg, pa0, pa1, pa2, pa3); SBAR();
    pv_d0(o, vb0 + bK * SHM_V, pa0, pa1, pa2, pa3);
#undef TRIP
    if (hi == 0) li_l[r32] = l_reg; asm volatile("s_waitcnt lgkmcnt(0)" ::: "memory");
    const int tz = opaque_tid(), wid2 = tz >> 6, r32b = tz & 31, hib = (tz >> 5) & 1;
    const float* li2 = (const float*)(lds + OFF_WS) + wid2 * 64;
    float rli[16];
#pragma unroll
    for (int r = 0; r < 16; ++r) rli[r] = __builtin_amdgcn_rcpf(li2[crow(r, hib)]);
    if (O8) {
        unsigned char* Ow8 = O8 + (size_t)(q0 + wid2 * QBLK) * 512;
#pragma unroll
        for (int r = 0; r < 16; ++r) { const int orow = crow(r, hib);
#pragma unroll
            for (int d0 = 0; d0 < 4; ++d0) { const float v_ = fminf(fmaxf(o[d0][r] * rli[r] * 8.0f, -448.0f), 448.0f);
                const int w = __builtin_amdgcn_cvt_pk_fp8_f32(v_, 0.f, 0, false); Ow8[(size_t)orow * 512 + d0 * 32 + r32b] = (unsigned char)(w & 0xff); } }
    } else {
    bf16_t* Ow = Ob + (size_t)(q0 + wid2 * QBLK) * LDO;
#pragma unroll
    for (int r = 0; r < 16; ++r) { const int orow = crow(r, hib);
#pragma unroll
        for (int d0 = 0; d0 < 4; ++d0) { const unsigned w = cvt_pk_bf16(o[d0][r] * rli[r], 0.f); Ow[(size_t)orow * LDO + d0 * 32 + r32b] = (bf16_t)(w & 0xffffu); } }
    }
    __syncthreads();
#undef KROW
#undef SDMA
#undef DMA16
#undef DMAWAIT
#undef RESC
}
}

struct Params { const float* in[28]; float* out; unsigned char* ws; int ph_lo, ph_hi; };
struct Ctx { LAS unsigned char* lds; char* ldsg; int tid, lane, wave, vcu, G; GAS unsigned char* ws; };
enum { I_X = 0, I_C, I_CTX, I_CCTX, I_ADAW, I_ADAB, I_N1G, I_N2G, I_WIN, I_LQ1, I_LK1, I_LQ2, I_LK2, I_SUBLN, I_QAG, I_KVAG, I_WQB, I_WKVB, I_WBRA, I_WBRB, I_WOUT, I_RW, I_RB, I_WGU, I_BGU, I_WDN, I_BDN, I_FG };
template <typename T> __device__ __forceinline__ T* wsp(const Ctx& C, size_t off) { return (T*)(GAS T*)(C.ws + off); }
constexpr int PTRTAB_OFF = MISC_OFF + 3072;
__device__ __forceinline__ const float* inp(const Ctx& C, int i) {
    const unsigned long long v = ((volatile LAS unsigned long long*)(C.lds + PTRTAB_OFF))[i];
    const unsigned lo = __builtin_amdgcn_readfirstlane((unsigned)v), hi = __builtin_amdgcn_readfirstlane((unsigned)(v >> 32));
    return (const float*)(GAS const float*)(((unsigned long long)hi << 32) | lo);
}

__device__ __forceinline__ void p0_transpose_item(const float* W, int K, int N, bf16_t* WT, int k0, int n0d, int n0s, const float* gain, LAS float* scr, int lane) {
    float w_[32];
#pragma unroll
    for (int i = 0; i < 32; ++i) { const int kk = 2 * i + (lane >> 5); w_[i] = (n0s >= 0) ? __builtin_nontemporal_load(W + (size_t)(k0 + kk) * N + n0s + (lane & 31)) : 0.f; }
    if (gain) {
#pragma unroll
        for (int i = 0; i < 32; ++i) w_[i] *= gain[k0 + 2 * i + (lane >> 5)]; }
#pragma unroll
    for (int i = 0; i < 32; ++i) scr[(2 * i + (lane >> 5)) * 33 + (lane & 31)] = w_[i];
    LDS_WAIT(); asm volatile("" ::: "memory");
    const int c = lane & 7;
#pragma unroll
    for (int j = 0; j < 4; ++j) { const int n = (lane >> 3) + 8 * j; const LAS float* s = scr + (8 * c) * 33 + n;
        u32x4 o; o.x = cvt_pk_bf16(s[0 * 33], s[1 * 33]); o.y = cvt_pk_bf16(s[2 * 33], s[3 * 33]); o.z = cvt_pk_bf16(s[4 * 33], s[5 * 33]); o.w = cvt_pk_bf16(s[6 * 33], s[7 * 33]);
        __builtin_nontemporal_store(o, (u32x4*)(WT + (size_t)(n0d + n) * K + k0 + 8 * c)); }
    LDS_WAIT(); asm volatile("" ::: "memory");
}
__device__ __forceinline__ void p0_transpose_item_f8(const float* W, int K, int N, unsigned char* WT, int k0, int n0d, int n0s, LAS float* scr, int lane) {
    float w_[32];
#pragma unroll
    for (int i = 0; i < 32; ++i) { const int kk = 2 * i + (lane >> 5); w_[i] = __builtin_nontemporal_load(W + (size_t)(k0 + kk) * N + n0s + (lane & 31)); }
#pragma unroll
    for (int i = 0; i < 32; ++i) scr[(2 * i + (lane >> 5)) * 33 + (lane & 31)] = w_[i] * 64.0f;
    LDS_WAIT(); asm volatile("" ::: "memory");
    const int c = lane & 7;
#pragma unroll
    for (int j = 0; j < 4; ++j) { const int n = (lane >> 3) + 8 * j; const LAS float* s = scr + (8 * c) * 33 + n;
        int w0 = __builtin_amdgcn_cvt_pk_fp8_f32(s[0 * 33], s[1 * 33], 0, false); w0 = __builtin_amdgcn_cvt_pk_fp8_f32(s[2 * 33], s[3 * 33], w0, true);
        int w1 = __builtin_amdgcn_cvt_pk_fp8_f32(s[4 * 33], s[5 * 33], 0, false); w1 = __builtin_amdgcn_cvt_pk_fp8_f32(s[6 * 33], s[7 * 33], w1, true);
        __builtin_nontemporal_store((u32x2){(unsigned)w0, (unsigned)w1}, (u32x2*)(WT + (size_t)(n0d + n) * K + k0 + 8 * c)); }
    LDS_WAIT(); asm volatile("" ::: "memory");
}
__device__ __forceinline__ int win_src_col(int n) {
    if (n < 1536) return n; if (n < 3584) return 2240 + (n - 1536); if (n < 3968) return 1536 + (n - 3584);
    if (n < 4032) return 2176 + (n - 3968); if (n < 4096) return -1; return 1920 + (n - 4096);
}
constexpr int I_IN_ = 16 * (NIN / 32), I_QB_ = 6 * 24, I_KVB_ = 4 * 32, I_BR_ = 8 * 32, I_OUT_ = 16 * 32, I_GU_ = 32 * 16 * 32, I_DN_ = 32 * 8 * 32;
constexpr int PER_L = I_IN_ + I_QB_ + I_KVB_ + 2 * I_BR_ + I_OUT_ + I_GU_ + I_DN_;
constexpr int PER_L_DENSE = I_IN_ + I_QB_ + I_KVB_ + 2 * I_BR_ + I_OUT_;
__device__ __forceinline__ void p0_item(const Ctx& C, const int l, int r, LAS float* scr) {
    if (r < I_IN_) { const int nb = r % (NIN / 32), kb = r / (NIN / 32);
        if (nb >= 32 && nb < 112) p0_transpose_item_f8(inp(C, I_WIN) + (size_t)l * 1024 * 4288, 1024, 4288, wsp<unsigned char>(C, WS_WING8) + (size_t)l * 2560 * 1024, kb * 64, nb * 32 - 1024, win_src_col(nb * 32), scr, C.lane);
        else p0_transpose_item(inp(C, I_WIN) + (size_t)l * 1024 * 4288, 1024, 4288, wsp<bf16_t>(C, WS_WIN) + (size_t)l * NIN * 1024, kb * 64, nb * 32, win_src_col(nb * 32), nullptr, scr, C.lane);
        return; } r -= I_IN_;
    if (r < I_QB_) { const int nb = r % 24, kb = r / 24;
        p0_transpose_item(inp(C, I_WQB) + (size_t)l * 384 * 768, 384, 768, wsp<bf16_t>(C, WS_WQB) + (size_t)l * 768 * 384, kb * 64, nb * 32, nb * 32, inp(C, I_QAG) + l * 384, scr, C.lane); return; } r -= I_QB_;
    if (r < I_KVB_) { const int nb = r % 32, kb = r / 32;
        p0_transpose_item(inp(C, I_WKVB) + (size_t)l * 256 * 1024, 256, 1024, wsp<bf16_t>(C, WS_WKVB) + (size_t)l * 1024 * 256, kb * 64, nb * 32, nb * 32, inp(C, I_KVAG) + l * 256, scr, C.lane); return; } r -= I_KVB_;
    if (r < I_BR_) { const int nb = r % 32, kb = r / 32;
        p0_transpose_item(inp(C, I_WBRA) + (size_t)l * 512 * 1024, 512, 1024, wsp<bf16_t>(C, WS_WBRA) + (size_t)l * 1024 * 512, kb * 64, nb * 32, nb * 32, nullptr, scr, C.lane);
        p0_transpose_item_f8(inp(C, I_WBRA) + (size_t)l * 512 * 1024, 512, 1024, wsp<unsigned char>(C, WS_WBR8) + (size_t)(l * 2) * 1024 * 512, kb * 64, nb * 32, nb * 32, scr, C.lane); return; } r -= I_BR_;
    if (r < I_BR_) { const int nb = r % 32, kb = r / 32;
        p0_transpose_item(inp(C, I_WBRB) + (size_t)l * 512 * 1024, 512, 1024, wsp<bf16_t>(C, WS_WBRB) + (size_t)l * 1024 * 512, kb * 64, nb * 32, nb * 32, nullptr, scr, C.lane);
        p0_transpose_item_f8(inp(C, I_WBRB) + (size_t)l * 512 * 1024, 512, 1024, wsp<unsigned char>(C, WS_WBR8) + (size_t)(l * 2 + 1) * 1024 * 512, kb * 64, nb * 32, nb * 32, scr, C.lane); return; } r -= I_BR_;
    if (r < I_OUT_) { const int nb = r % 32, kb = r / 32;
        p0_transpose_item(inp(C, I_WOUT) + (size_t)l * 1024 * 1024, 1024, 1024, wsp<bf16_t>(C, WS_WOUT) + (size_t)l * 1024 * 1024, kb * 64, nb * 32, nb * 32, nullptr, scr, C.lane);
        p0_transpose_item_f8(inp(C, I_WOUT) + (size_t)l * 1024 * 1024, 1024, 1024, wsp<unsigned char>(C, WS_WOUT8) + (size_t)l * 1024 * 1024, kb * 64, nb * 32, nb * 32, scr, C.lane); return; } r -= I_OUT_;
    if (r < I_GU_) { const int e = r / 512, q = r % 512, nb = q % 32, kb = q / 32; const int n0 = nb * 32;
        const int src = 512 * ((n0 >> 7) & 1) + 128 * (n0 >> 8) + (n0 & 127);
        p0_transpose_item_f8(inp(C, I_WGU) + ((size_t)l * 32 + e) * 1024 * 1024, 1024, 1024, wsp<unsigned char>(C, WS_WGU) + ((size_t)l * 32 + e) * 1024 * 1024, kb * 64, n0, src, scr, C.lane); return; } r -= I_GU_;
    { const int e = r / 256, q = r % 256, nb = q % 32, kb = q / 32;
        p0_transpose_item_f8(inp(C, I_WDN) + ((size_t)l * 32 + e) * 512 * 1024, 512, 1024, wsp<unsigned char>(C, WS_WDN) + ((size_t)l * 32 + e) * 1024 * 512, kb * 64, nb * 32, nb * 32, scr, C.lane); }
}
__device__ __forceinline__ void convert_layer_share(const Ctx& C0, const int l, const int r_lo, const int r_hi, const int n_next) {
    Ctx C = C0; { const int t_ = opaque_tid(); C.tid = t_; C.lane = t_ & 63; C.wave = __builtin_amdgcn_readfirstlane(t_ >> 6); asm volatile("" : "+s"(C.ws)); asm volatile("" : "+s"(C.vcu)); asm volatile("" : "+s"(C.G)); }
    LAS float* scr = (LAS float*)(C.lds + C.wave * 8448);
    const int gw = C.vcu * 8 + C.wave, NGW = C.G * 8;
    const int n0 = r_hi - r_lo;
    for (int j = gw; j < n0 + n_next; j += NGW) { const bool nx = j >= n0; p0_item(C, nx ? l + 1 : l, nx ? j - n0 : r_lo + j, scr); }
    __syncthreads();
}
__device__ __forceinline__ void phase_prologue(const Params& P, const Ctx& C0) {
    Ctx C = C0; { const int t_ = opaque_tid(); C.tid = t_; C.lane = t_ & 63; C.wave = __builtin_amdgcn_readfirstlane(t_ >> 6); asm volatile("" : "+s"(C.ws)); asm volatile("" : "+s"(C.vcu)); asm volatile("" : "+s"(C.G)); }
    convert_layer_share(C, 0, 0, PER_L_DENSE, 0);
    { int* idl = wsp<int>(C, WS_IDLIST); for (int i = C.vcu * 512 + C.tid; i < PMAX; i += C.G * 512) idl[i] = i; }
    { float* rwt = wsp<float>(C, WS_RWT); const float* rw = inp(C, I_RW);
      for (int i = C.vcu * 512 + C.tid; i < DEPTH * 32 * 1024; i += C.G * 512) { const int l = i >> 15, e = (i >> 10) & 31, d = i & 1023; rwt[i] = rw[((size_t)l * 1024 + d) * 32 + e]; }
      { bf16_t* rwb = wsp<bf16_t>(C, WS_RWT) + (size_t)DEPTH * 32 * 1024 * 2;
        for (int i = C.vcu * 512 + C.tid; i < DEPTH * 32 * 1024; i += C.G * 512) { const int l = i >> 15, e = (i >> 10) & 31, d = i & 1023; rwb[i] = (bf16_t)(cvt_pk_bf16(rw[((size_t)l * 1024 + d) * 32 + e], 0.f) & 0xffffu); } }
 }
    __syncthreads();
    { LAS float* s = (LAS float*)(C.lds + 69632); LAS float* red = (LAS float*)(C.lds + 106496);
      const float* const cc = inp(C, I_C); const float* const cx = inp(C, I_CCTX);
      for (int i = C.tid; i < 9 * 1024; i += 512) { const float v = i < 8192 ? cc[i] : cx[i - 8192]; s[i] = v / (1.0f + __expf(-v)); }
      __syncthreads();
      const int cl = C.tid & 31, kg = C.tid >> 5; float* MOD = wsp<float>(C, WS_MOD); const float* const adaw = inp(C, I_ADAW); const float* const adab = inp(C, I_ADAB);
      for (int blk = C.vcu; blk < DEPTH * 192; blk += C.G) { const int l = blk / 192, col = (blk % 192) * 32 + cl;
          const float* w = adaw + (size_t)l * 1024 * 6144 + col; float a[9];
#pragma unroll
          for (int r = 0; r < 9; ++r) a[r] = 0.f;
          float wv_[64];
#pragma unroll
          for (int kk = 0; kk < 64; ++kk) wv_[kk] = w[(size_t)(kg * 64 + kk) * 6144];
#pragma unroll
          for (int kk = 0; kk < 64; ++kk) { const int k = kg * 64 + kk; const float wv = wv_[kk];
#pragma unroll
              for (int r = 0; r < 9; ++r) a[r] += s[r * 1024 + k] * wv; }
#pragma unroll
          for (int r = 0; r < 9; ++r) red[(kg * 32 + cl) * 9 + r] = a[r];
          __syncthreads();
          if (C.tid < 288) { const int c2 = C.tid & 31, r = C.tid >> 5; float t = 0.f;
              for (int g = 0; g < 16; ++g) t += red[(g * 32 + c2) * 9 + r];
              const int col2 = (blk % 192) * 32 + c2; MOD[((size_t)l * 9 + r) * 6144 + col2] = t + adab[(size_t)l * 6144 + col2]; }
          __syncthreads(); } }
}

struct RowPipe { unsigned y[16]; f32x4 v[4]; u32x2 xb[4]; f32x4 wt; };
template <bool FINAL, bool FIRST>
__device__ __forceinline__ void phase_rows(const Params& P, const Ctx& C0, const int l) {
    Ctx C = C0; { const int t_ = opaque_tid(); C.tid = t_; C.lane = t_ & 63; C.wave = __builtin_amdgcn_readfirstlane(t_ >> 6); asm volatile("" : "+s"(C.ws)); asm volatile("" : "+s"(C.vcu)); asm volatile("" : "+s"(C.G)); }
    const int gw = C.vcu * 8 + C.wave, NGW = C.G * 8, MR = FINAL ? MX : MT;
    const float* MOD = wsp<float>(C, WS_MOD); bf16_t* XS = wsp<bf16_t>(C, WS_XS); bf16_t* H = wsp<bf16_t>(C, WS_H);
    const u32x4* YD = wsp<u32x4>(C, WS_YDEST); const f32x4* WT = wsp<f32x4>(C, WS_WTS); const unsigned char* Y = wsp<unsigned char>(C, WS_Y);
    const float* ng = FINAL ? inp(C, I_FG) : inp(C, I_N1G) + l * 1024; const float* const xin = inp(C, I_X); const float* const cin = inp(C, I_CTX); float* const outp = (float*)inp(C, 28);
    constexpr bool comb = !FIRST;
    f32x4 gv[4];
#pragma unroll
    for (int j = 0; j < 4; ++j) gv[j] = ((const f32x4*)ng)[C.lane + 64 * j];
    RowPipe cur, nxt; u32x4 ydn = (u32x4){0u, 0u, 0u, 0u}; f32x4 wtn = (f32x4){0.f, 0.f, 0.f, 0.f};
#define ROW_LOAD(R, m, yd) do { if constexpr (FIRST) { const float* s_ = (m) < MX ? xin + (size_t)(m) * 1024 : cin + (size_t)((m) - MX) * 1024; _Pragma("unroll") for (int j = 0; j < 4; ++j) R.v[j] = ((const f32x4*)s_)[C.lane + 64 * j]; } \
        else { const u32x2* s_ = (const u32x2*)(XS + (size_t)(m) * 1024); _Pragma("unroll") for (int j = 0; j < 4; ++j) R.xb[j] = s_[C.lane + 64 * j]; } \
        if (comb) { const unsigned d_[4] = {yd.x, yd.y, yd.z, yd.w}; _Pragma("unroll") for (int k = 0; k < 4; ++k) { const unsigned* yr = (const unsigned*)(Y + (size_t)d_[k] * 1024); \
            _Pragma("unroll") for (int j = 0; j < 4; ++j) R.y[k * 4 + j] = yr[C.lane + 64 * j]; } } } while (0)
    int m = gw;
    if (m < MR) { if (comb) { ydn = YD[m]; wtn = WT[m]; } cur.wt = wtn; ROW_LOAD(cur, m, ydn); if (comb && m + NGW < MR) { ydn = YD[m + NGW]; wtn = WT[m + NGW]; } }
    for (; m < MR; m += NGW) {
        const int mn = m + NGW;
        if (mn < MR) { nxt.wt = wtn; ROW_LOAD(nxt, mn, ydn); if (comb && mn + NGW < MR) { ydn = YD[mn + NGW]; wtn = WT[mn + NGW]; } }
        const int bidx = m < MX ? (m >> 12) : 8;
        f32x4 v[4];
#pragma unroll
        for (int j = 0; j < 4; ++j) { if constexpr (FIRST) v[j] = cur.v[j]; else v[j] = (f32x4){bf_lo(cur.xb[j].x), bf_hi(cur.xb[j].x), bf_lo(cur.xb[j].y), bf_hi(cur.xb[j].y)}; }
        if (comb) {
            const float w_[4] = {cur.wt.x * 0.125f, cur.wt.y * 0.125f, cur.wt.z * 0.125f, cur.wt.w * 0.125f};
            const float* g2 = MOD + ((size_t)(FINAL ? DEPTH - 1 : l - 1) * 9 + bidx) * 6144 + 5 * 1024;
#pragma unroll
            for (int j = 0; j < 4; ++j) { f32x4 f = (f32x4){0.f, 0.f, 0.f, 0.f};
#pragma unroll
                for (int k = 0; k < 4; ++k) { const int y = (int)cur.y[k * 4 + j]; const f32x2_t ylo = __builtin_amdgcn_cvt_pk_f32_fp8(y, false), yhi = __builtin_amdgcn_cvt_pk_f32_fp8(y, true); f += w_[k] * (f32x4){ylo.x, ylo.y, yhi.x, yhi.y}; }
                v[j] += ((const f32x4*)g2)[C.lane + 64 * j] * f;
                if (!FINAL) { u32x2 w; w.x = cvt_pk_bf16(v[j].x, v[j].y); w.y = cvt_pk_bf16(v[j].z, v[j].w); __builtin_nontemporal_store(w, (u32x2*)(XS + (size_t)m * 1024) + C.lane + 64 * j); } }
        }
        float ss = 0.f;
#pragma unroll
        for (int j = 0; j < 4; ++j) ss += (v[j].x * v[j].x + v[j].y * v[j].y) + (v[j].z * v[j].z + v[j].w * v[j].w);
        const float rstd = rsqrtf(wave_sum(ss, C.lane) * (1.0f / 1024.0f) + EPS);
        if (FINAL) {
#pragma unroll
            for (int j = 0; j < 4; ++j) __builtin_nontemporal_store(v[j] * rstd * gv[j], (f32x4*)(outp + (size_t)m * 1024) + C.lane + 64 * j);
        } else {
            const float* sh = MOD + ((size_t)l * 9 + bidx) * 6144; const float* sc = sh + 1024;
            u32x2* o8 = (u32x2*)(H + (size_t)m * 1024); unsigned* q8 = (unsigned*)(wsp<unsigned char>(C, WS_H8) + (size_t)m * 1024);
#pragma unroll
            for (int j = 0; j < 4; ++j) { const f32x4 s1 = ((const f32x4*)sc)[C.lane + 64 * j], s0 = ((const f32x4*)sh)[C.lane + 64 * j];
                const f32x4 h = v[j] * rstd * gv[j] * (1.0f + s1) + s0; u32x2 w; w.x = cvt_pk_bf16(h.x, h.y); w.y = cvt_pk_bf16(h.z, h.w); __builtin_nontemporal_store(w, o8 + C.lane + 64 * j);
                const f32x4 hc = (f32x4){fminf(fmaxf(h.x, -448.0f), 448.0f), fminf(fmaxf(h.y, -448.0f), 448.0f), fminf(fmaxf(h.z, -448.0f), 448.0f), fminf(fmaxf(h.w, -448.0f), 448.0f)};
                int f = __builtin_amdgcn_cvt_pk_fp8_f32(hc.x, hc.y, 0, false); f = __builtin_amdgcn_cvt_pk_fp8_f32(hc.z, hc.w, f, true); __builtin_nontemporal_store((unsigned)f, q8 + C.lane + 64 * j); }
        }
        if (mn < MR) { cur = nxt; }
    }
#undef ROW_LOAD
}
__device__ __forceinline__ void phase_mod1(const Params& P, const Ctx& C0, const int l) { if (l == 0) phase_rows<false, true>(P, C0, l); else phase_rows<false, false>(P, C0, l); }
__device__ __forceinline__ void phase_final(const Params& P, const Ctx& C0) { phase_rows<true, false>(P, C0, DEPTH - 1); }
__device__ __forceinline__ void phase_damerge(const Params& P, const Ctx& C0, const int l, const int Ml) {
    Ctx C = C0; { const int t_ = opaque_tid(); C.tid = t_; C.lane = t_ & 63; C.wave = __builtin_amdgcn_readfirstlane(t_ >> 6); asm volatile("" : "+s"(C.ws)); asm volatile("" : "+s"(C.vcu)); asm volatile("" : "+s"(C.G)); }
    const int gw = C.vcu * 8 + C.wave, NGW = C.G * 8;
    const float lam_init = 0.8f - 0.6f * expf(-0.3f * (float)l);
    const float d1 = wave_sum(inp(C, I_LQ1)[l * 64 + C.lane] * inp(C, I_LK1)[l * 64 + C.lane], C.lane), d2 = wave_sum(inp(C, I_LQ2)[l * 64 + C.lane] * inp(C, I_LK2)[l * 64 + C.lane], C.lane);
    const float lam = expf(d1) - expf(d2) + lam_init;
    const int h = C.lane >> 4, c = C.lane & 15;
    float gq[8];
    { const float* sg = inp(C, I_SUBLN) + l * 128 + c * 8;
#pragma unroll
      for (int i = 0; i < 8; ++i) gq[i] = sg[i] * (1.0f - lam_init); }
    const bf16_t* ODA = wsp<bf16_t>(C, WS_ODA); bf16_t* ODAN = wsp<bf16_t>(C, WS_ODAN); unsigned char* OB8 = wsp<unsigned char>(C, WS_OB8);
    for (int m0 = gw; m0 < Ml; m0 += 4 * NGW) {
        u32x4 a[4], b[4];
#pragma unroll
        for (int r = 0; r < 4; ++r) { const int m = m0 + r * NGW; if (m < Ml) { a[r] = *(const u32x4*)(ODA + (size_t)m * 1024 + h * 256 + c * 8); b[r] = *(const u32x4*)(ODA + (size_t)m * 1024 + h * 256 + 128 + c * 8); } }
#pragma unroll
        for (int r = 0; r < 4; ++r) { const int m = m0 + r * NGW; if (m < Ml) {
            const unsigned aw[4] = {a[r].x, a[r].y, a[r].z, a[r].w}, bw[4] = {b[r].x, b[r].y, b[r].z, b[r].w}; float o[8]; float ss = 0.f;
#pragma unroll
            for (int i = 0; i < 4; ++i) { o[2 * i] = bf_lo(aw[i]) - lam * bf_lo(bw[i]); o[2 * i + 1] = bf_hi(aw[i]) - lam * bf_hi(bw[i]); ss += o[2 * i] * o[2 * i] + o[2 * i + 1] * o[2 * i + 1]; }
            ss += shx(ss, 1, C.lane); ss += shx(ss, 2, C.lane); ss += shx(ss, 4, C.lane); ss += shx(ss, 8, C.lane);
            const float rr = rsqrtf(ss * (1.0f / 128.0f) + EPS);
            if (m >= MX) {
            u32x4 w; w.x = cvt_pk_bf16(o[0] * rr * gq[0], o[1] * rr * gq[1]); w.y = cvt_pk_bf16(o[2] * rr * gq[2], o[3] * rr * gq[3]);
            w.z = cvt_pk_bf16(o[4] * rr * gq[4], o[5] * rr * gq[5]); w.w = cvt_pk_bf16(o[6] * rr * gq[6], o[7] * rr * gq[7]);
            __builtin_nontemporal_store(w, (u32x4*)(ODAN + (size_t)m * 512 + h * 128 + c * 8));
            } else {
            float q_[8];
#pragma unroll
            for (int i = 0; i < 8; ++i) q_[i] = fminf(fmaxf(o[i] * rr * gq[i] * 8.0f, -448.0f), 448.0f);
            int w0 = __builtin_amdgcn_cvt_pk_fp8_f32(q_[0], q_[1], 0, false); w0 = __builtin_amdgcn_cvt_pk_fp8_f32(q_[2], q_[3], w0, true);
            int w1 = __builtin_amdgcn_cvt_pk_fp8_f32(q_[4], q_[5], 0, false); w1 = __builtin_amdgcn_cvt_pk_fp8_f32(q_[6], q_[7], w1, true);
            __builtin_nontemporal_store((u32x2){(unsigned)w0, (unsigned)w1}, (u32x2*)(OB8 + (size_t)m * 512 + C.lane * 8));
            }
            } }
    }
}
__device__ __forceinline__ void phase_mod2_router(const Params& P, const Ctx& C0, const int l, const int Ml) {
    Ctx C = C0; { const int t_ = opaque_tid(); C.tid = t_; C.lane = t_ & 63; C.wave = __builtin_amdgcn_readfirstlane(t_ >> 6); asm volatile("" : "+s"(C.ws)); asm volatile("" : "+s"(C.vcu)); asm volatile("" : "+s"(C.G)); }
    LAS int* hist = (LAS int*)(C.lds + MISC_OFF + 256);
    if (C.tid < 32) hist[C.tid] = 0;
    const float* MOD = wsp<float>(C, WS_MOD); const bf16_t* XS = wsp<bf16_t>(C, WS_XS);
    int* TOPE = wsp<int>(C, WS_TOPE); float* WT = wsp<float>(C, WS_WTS); unsigned char* H8 = wsp<unsigned char>(C, WS_H8);
    const float* ng = inp(C, I_N2G) + l * 1024;
    const int wg = blockIdx.x, RPW = (Ml + C.G - 1) / C.G, m_lo = wg * RPW, m_hi = (m_lo + RPW < Ml) ? m_lo + RPW : Ml;
    { constexpr int RP = 2064;
      LAS unsigned char* rows = C.lds + 40960;
      LAS float* part = (LAS float*)C.lds;
      LAS float* lgt = (LAS float*)(C.lds + 32768);
      const int r32 = C.lane & 31, hi = C.lane >> 5, kq = C.wave * 128;
      const bf16_t* RWB = wsp<bf16_t>(C, WS_RWT) + (size_t)DEPTH * 32 * 1024 * 2 + (size_t)l * 32768;
      const float rbias = inp(C, I_RB)[l * 32 + r32];
      f32x4 gv[4];
#pragma unroll
      for (int j = 0; j < 4; ++j) gv[j] = ((const f32x4*)ng)[C.lane + 64 * j];
      bf16x8 bfr[8];
#pragma unroll
      for (int ks = 0; ks < 8; ++ks) bfr[ks] = *(const bf16x8*)(RWB + (size_t)r32 * 1024 + kq + ks * 16 + hi * 8);
      u32x2 xr[4][4];
#define XLOAD(mb_) do { _Pragma("unroll") for (int i = 0; i < 4; ++i) { const int m_ = (mb_) + C.wave * 4 + i; \
          _Pragma("unroll") for (int j = 0; j < 4; ++j) xr[i][j] = m_ < m_hi ? ((const u32x2*)(XS + (size_t)m_ * 1024))[C.lane + 64 * j] : (u32x2){0u, 0u}; } } while (0)
      if (m_lo < m_hi) XLOAD(m_lo);
      for (int mb = m_lo; mb < m_hi; mb += 32) {
          const int nrow = (m_hi - mb) < 32 ? (m_hi - mb) : 32;
#pragma unroll
          for (int i = 0; i < 4; ++i) { const int m = mb + C.wave * 4 + i;
              if (m < m_hi) {
                  const int bidx = m < MX ? (m >> 12) : 8;
                  f32x4 v[4]; float ss = 0.f;
#pragma unroll
                  for (int j = 0; j < 4; ++j) { v[j] = (f32x4){bf_lo(xr[i][j].x), bf_hi(xr[i][j].x), bf_lo(xr[i][j].y), bf_hi(xr[i][j].y)}; ss += (v[j].x * v[j].x + v[j].y * v[j].y) + (v[j].z * v[j].z + v[j].w * v[j].w); }
                  const float rstd = rsqrtf(wave_sum(ss, C.lane) * (1.0f / 1024.0f) + EPS);
                  const float* sh = MOD + ((size_t)l * 9 + bidx) * 6144 + 3 * 1024; const float* sc = sh + 1024;
                  LAS u32x2* o8 = (LAS u32x2*)(rows + (C.wave * 4 + i) * RP); unsigned* q8 = (unsigned*)(H8 + (size_t)m * 1024);
#pragma unroll
                  for (int j = 0; j < 4; ++j) { const f32x4 s1 = ((const f32x4*)sc)[C.lane + 64 * j], s0 = ((const f32x4*)sh)[C.lane + 64 * j];
                      const f32x4 h = v[j] * rstd * gv[j] * (1.0f + s1) + s0; u32x2 w; w.x = cvt_pk_bf16(h.x, h.y); w.y = cvt_pk_bf16(h.z, h.w); o8[C.lane + 64 * j] = w;
                      const f32x4 hc = (f32x4){fminf(fmaxf(h.x, -448.0f), 448.0f), fminf(fmaxf(h.y, -448.0f), 448.0f), fminf(fmaxf(h.z, -448.0f), 448.0f), fminf(fmaxf(h.w, -448.0f), 448.0f)};
                      int f = __builtin_amdgcn_cvt_pk_fp8_f32(hc.x, hc.y, 0, false); f = __builtin_amdgcn_cvt_pk_fp8_f32(hc.z, hc.w, f, true); __builtin_nontemporal_store((unsigned)f, q8 + C.lane + 64 * j); }
              } }
          if (mb + 32 < m_hi) XLOAD(mb + 32);
          __syncthreads();
          bf16x8 afr[8];
#pragma unroll
          for (int ks = 0; ks < 8; ++ks) afr[ks] = *(const LAS bf16x8*)(rows + r32 * RP + (kq + ks * 16 + hi * 8) * 2);
          f32x16 acc = {};
#pragma unroll
          for (int ks = 0; ks < 8; ++ks) acc = __builtin_amdgcn_mfma_f32_32x32x16_bf16(afr[ks], bfr[ks], acc, 0, 0, 0);
#pragma unroll
          for (int r = 0; r < 16; ++r) part[(C.wave * 32 + att::crow(r, hi)) * 32 + r32] = acc[r];
          __syncthreads();
          { const int i0 = C.tid, i1 = C.tid + 512; float s0 = 0.f, s1 = 0.f;
#pragma unroll
            for (int w = 0; w < 8; ++w) { s0 += part[w * 1024 + i0]; s1 += part[w * 1024 + i1]; }
            lgt[(i0 >> 5) * 33 + (i0 & 31)] = s0; lgt[(i1 >> 5) * 33 + (i1 & 31)] = s1; }
          __syncthreads();
#pragma unroll
          for (int pr = 0; pr < 2; ++pr) { const int tok = C.wave * 4 + pr * 2 + hi; const bool live = tok < nrow;
              const float lg = lgt[(tok < 32 ? tok : 31) * 33 + r32] + rbias;
              int rank = 0;
#pragma unroll 4
              for (int j = 0; j < 32; ++j) { const float o0 = __int_as_float(__builtin_amdgcn_readlane(__float_as_int(lg), j)), o1 = __int_as_float(__builtin_amdgcn_readlane(__float_as_int(lg), 32 + j));
                  const float oj = hi ? o1 : o0; rank += (oj > lg || (oj == lg && j < r32)) ? 1 : 0; }
              float tv[4]; int ti[4];
#pragma unroll
              for (int k = 0; k < 4; ++k) { const unsigned long long mk = __ballot(rank == k); const unsigned lo = (unsigned)mk, hh = (unsigned)(mk >> 32);
                  const int s0 = __builtin_ctz(lo | 0x80000000u) & 31, s1 = __builtin_ctz(hh | 0x80000000u) & 31;
                  const float v0 = __int_as_float(__builtin_amdgcn_readlane(__float_as_int(lg), s0)), v1 = __int_as_float(__builtin_amdgcn_readlane(__float_as_int(lg), 32 + s1));
                  tv[k] = hi ? v1 : v0; ti[k] = hi ? s1 : s0; }
              const float e1 = __expf(tv[1] - tv[0]), e2 = __expf(tv[2] - tv[0]), e3 = __expf(tv[3] - tv[0]); const float inv = 1.0f / (1.0f + e1 + e2 + e3);
              if (live && r32 < 4) { const int e = r32 == 0 ? ti[0] : r32 == 1 ? ti[1] : r32 == 2 ? ti[2] : ti[3];
                  const float w = (r32 == 0 ? 1.0f : r32 == 1 ? e1 : r32 == 2 ? e2 : e3) * inv;
                  const int rk = atomicAdd((int*)(hist + e), 1);
                  const int m = mb + tok; TOPE[m * 4 + r32] = e | (rk << 8); WT[m * 4 + r32] = w; } }
      } }
#undef XLOAD
    __syncthreads();
    if (C.tid < 32) wsp<int>(C, WS_CNTWG)[wg * 32 + C.tid] = hist[C.tid];
    __syncthreads();
}
__device__ __forceinline__ void phase_lists(const Params& P, const Ctx& C0, const int Ml) {
    Ctx C = C0; { const int t_ = opaque_tid(); C.tid = t_; C.lane = t_ & 63; C.wave = __builtin_amdgcn_readfirstlane(t_ >> 6); asm volatile("" : "+s"(C.ws)); asm volatile("" : "+s"(C.vcu)); asm volatile("" : "+s"(C.G)); }
    LAS int* part = (LAS int*)(C.lds);
    LAS int* tot = (LAS int*)(C.lds + 4096);
    LAS int* base = (LAS int*)(C.lds + 4096 + 128);
    LAS int* pst = (LAS int*)(C.lds + 4096 + 256);
    const int* CNT = wsp<int>(C, WS_CNTWG); const int wg = blockIdx.x;
    { const int e = C.tid & 31, seg = C.tid >> 5; int s = 0, sb = 0;
      for (int w = seg; w < C.G; w += 16) { const int c = CNT[w * 32 + e]; s += c; if (w < wg) sb += c; }
      part[seg * 32 + e] = s; part[512 + seg * 32 + e] = sb; }
    __syncthreads();
    if (C.tid < 32) { int s = 0, sb = 0; for (int g = 0; g < 16; ++g) { s += part[g * 32 + C.tid]; sb += part[512 + g * 32 + C.tid]; } tot[C.tid] = s; base[C.tid] = sb; }
    __syncthreads();
    if (C.tid == 0) { int p = 0; for (int e = 0; e < 32; ++e) { pst[e] = p; p += (tot[e] + 255) & ~255; } pst[32] = p;
        if (wg == 0) { int* PS = wsp<int>(C, WS_PSTART); for (int e = 0; e <= 32; ++e) PS[e] = pst[e]; } }
    __syncthreads();
    const int* TOPE = wsp<int>(C, WS_TOPE); int* YD = wsp<int>(C, WS_YDEST); int* RL = wsp<int>(C, WS_ROWLIST);
    const int RPW = (Ml + C.G - 1) / C.G, m_lo = wg * RPW, m_hi = (m_lo + RPW < Ml) ? m_lo + RPW : Ml;
    for (int i = m_lo * 4 + C.tid; i < m_hi * 4; i += 512) { const int t = TOPE[i], e = t & 255, rank = t >> 8; const int dst = pst[e] + base[e] + rank;
        YD[i] = dst; RL[dst] = i >> 2; }
    for (int e = 0; e < 32; ++e) { const int lo = pst[e] + tot[e], hi = pst[e + 1];
        for (int r = lo + wg * 512 + C.tid; r < hi; r += C.G * 512) RL[r] = 0; }
    __syncthreads();
}
struct SkOut { const bf16_t* A; const bf16_t* B; static constexpr int NC = 8, LD = 1024;
    __device__ __forceinline__ const bf16_t* a(int c) const { return A + c * 128; } __device__ __forceinline__ const bf16_t* b(int c) const { return B + c * 128; }
    static __device__ __forceinline__ constexpr int ai(int) { return 0; } };
struct SkBranch { const bf16_t* A0; const bf16_t* B0; const bf16_t* A1; const bf16_t* B1; static constexpr int NC = 8, LD = 512;
    __device__ __forceinline__ const bf16_t* a(int c) const { return c < 4 ? A0 + c * 128 : A1 + (c - 4) * 128; } __device__ __forceinline__ const bf16_t* b(int c) const { return c < 4 ? B0 + c * 128 : B1 + (c - 4) * 128; }
    static __device__ __forceinline__ constexpr int ai(int c) { return c < 4 ? 0 : 1; } };
template <class Src>
__device__ __forceinline__ void skinny_mm(const Src& S, f32x16 (&acc)[2], LAS unsigned char* lds, const int tid) {
    constexpr int NC = Src::NC, LD = Src::LD, ST = 136;
    LAS bf16_t* As = (LAS bf16_t*)lds;
    LAS bf16_t* Bs = As + 2 * 128 * ST;
    const int lane = tid & 63, wv = tid >> 6, r32 = lane & 31, hi = lane >> 5, wr = wv >> 1, wc = wv & 1;
    const int prow = tid >> 4, pk = (tid & 15) * 8;
    u32x4 ra[2][4], rb[2][2];
#define SK_LOAD(c, s) do { const bf16_t* a_ = S.a(c) + (size_t)prow * LD + pk; const bf16_t* b_ = S.b(c) + (size_t)prow * LD + pk; \
        _Pragma("unroll") for (int i = 0; i < 4; ++i) ra[s][i] = *(const u32x4*)(a_ + (size_t)i * 32 * LD); \
        _Pragma("unroll") for (int i = 0; i < 2; ++i) rb[s][i] = *(const u32x4*)(b_ + (size_t)i * 32 * LD); } while (0)
#define SK_WRITE(s, buf) do { _Pragma("unroll") for (int i = 0; i < 4; ++i) *(LAS u32x4*)(As + ((buf) * 128 + prow + 32 * i) * ST + pk) = ra[s][i]; \
        _Pragma("unroll") for (int i = 0; i < 2; ++i) *(LAS u32x4*)(Bs + ((buf) * 64 + prow + 32 * i) * ST + pk) = rb[s][i]; } while (0)
    SK_LOAD(0, 0); SK_LOAD(1, 1);
#pragma unroll
    for (int c = 0; c < NC; ++c) {
        SK_WRITE(c & 1, c & 1);
        if (c + 2 < NC) SK_LOAD(c + 2, c & 1);
        __syncthreads();
        const LAS bf16_t* ar = As + ((c & 1) * 128 + wr * 32 + r32) * ST + hi * 8; const LAS bf16_t* br = Bs + ((c & 1) * 64 + wc * 32 + r32) * ST + hi * 8;
#pragma unroll
        for (int ks = 0; ks < 8; ++ks) acc[Src::ai(c)] = __builtin_amdgcn_mfma_f32_32x32x16_bf16(*(const LAS bf16x8*)(ar + ks * 16), *(const LAS bf16x8*)(br + ks * 16), acc[Src::ai(c)], 0, 0, 0);
    }
    __syncthreads();
#undef SK_LOAD
#undef SK_WRITE
}
__device__ __forceinline__ void phase_skinny_branch(const Ctx& C0, const int l) {
    Ctx C = C0; { const int t_ = opaque_tid(); C.tid = t_; C.lane = t_ & 63; C.wave = __builtin_amdgcn_readfirstlane(t_ >> 6); asm volatile("" : "+s"(C.ws)); asm volatile("" : "+s"(C.vcu)); asm volatile("" : "+s"(C.G)); }
    const int r32 = C.lane & 31, hi = C.lane >> 5;
    for (int item = C.vcu; item < 256; item += C.G) {
        const int rb0 = MX + (item >> 4) * 128, cb0 = (item & 15) * 64;
        f32x16 acc[2] = {};
        SkBranch S{wsp<bf16_t>(C, WS_ODAN) + (size_t)rb0 * 512, wsp<bf16_t>(C, WS_WBRA) + (size_t)l * 1024 * 512 + (size_t)cb0 * 512,
                   wsp<bf16_t>(C, WS_OMLA) + (size_t)rb0 * 512, wsp<bf16_t>(C, WS_WBRB) + (size_t)l * 1024 * 512 + (size_t)cb0 * 512};
        skinny_mm(S, acc, C.lds, C.tid);
        const unsigned char* gates = wsp<unsigned char>(C, WS_GATES); bf16_t* U = wsp<bf16_t>(C, WS_U);
        const int r0 = rb0 + (C.wave >> 1) * 32, col = cb0 + (C.wave & 1) * 32 + r32;
#pragma unroll
        for (int r = 0; r < 16; ++r) { const size_t row = (size_t)(r0 + att::crow(r, hi));
            const float ga = (float)gates[row * 2048 + col], gb = (float)gates[row * 2048 + 1024 + col];
            const unsigned w = cvt_pk_bf16((ga * acc[0][r] + gb * acc[1][r]) * (1.0f / 255.0f), 0.f); U[row * 1024 + col] = (bf16_t)(w & 0xffffu); }
    }
}
__device__ __forceinline__ void phase_skinny_out(const Ctx& C0, const int l) {
    Ctx C = C0; { const int t_ = opaque_tid(); C.tid = t_; C.lane = t_ & 63; C.wave = __builtin_amdgcn_readfirstlane(t_ >> 6); asm volatile("" : "+s"(C.ws)); asm volatile("" : "+s"(C.vcu)); asm volatile("" : "+s"(C.G)); }
    const int r32 = C.lane & 31, hi = C.lane >> 5;
    for (int item = C.vcu; item < 256; item += C.G) {
        const int rb0 = MX + (item >> 4) * 128, cb0 = (item & 15) * 64;
        f32x16 acc[2] = {};
        SkOut S{wsp<bf16_t>(C, WS_U) + (size_t)rb0 * 1024, wsp<bf16_t>(C, WS_WOUT) + (size_t)l * 1024 * 1024 + (size_t)cb0 * 1024};
        skinny_mm(S, acc, C.lds, C.tid);
        bf16_t* XS = wsp<bf16_t>(C, WS_XS); const float* cin = inp(C, I_CTX);
        const int r0 = rb0 + (C.wave >> 1) * 32, col = cb0 + (C.wave & 1) * 32 + r32;
        const float g1 = (wsp<float>(C, WS_MOD) + ((size_t)l * 9 + 8) * 6144 + 2048)[col];
#pragma unroll
        for (int r = 0; r < 16; ++r) { const size_t row = (size_t)(r0 + att::crow(r, hi));
            const float base = l == 0 ? cin[(row - MX) * 1024 + col] : bf_lo((unsigned)XS[row * 1024 + col]);
            const unsigned w = cvt_pk_bf16(base + g1 * acc[0][r], 0.f); XS[row * 1024 + col] = (bf16_t)(w & 0xffffu); }
    }
}
__device__ __forceinline__ int moe_tiles(const Ctx& C0, LAS int* tile_e) {
    Ctx C = C0; { const int t_ = opaque_tid(); C.tid = t_; C.lane = t_ & 63; C.wave = __builtin_amdgcn_readfirstlane(t_ >> 6); asm volatile("" : "+s"(C.ws)); asm volatile("" : "+s"(C.vcu)); asm volatile("" : "+s"(C.G)); }
    const int* PS = wsp<int>(C, WS_PSTART);
    LAS int* pst = tile_e + 600;
    if (C.tid <= 32) pst[C.tid] = PS[C.tid] >> 8;
    __syncthreads();
    const int ntiles = pst[32];
    for (int t = C.tid; t < ntiles; t += 512) { int e = 0;
#pragma unroll
        for (int j = 1; j < 32; ++j) e = (pst[j] <= t) ? j : e;
        tile_e[t] = e; }
    __syncthreads();
    return __builtin_amdgcn_readfirstlane(ntiles);
}

__device__ unsigned g_barw[XCD_BAR_WORDS + 64];
constexpr int PH_PER_LAYER = 11, N_PHASES = 1 + DEPTH * PH_PER_LAYER + 1;
__global__ void __launch_bounds__(512, 2) dit_fwd(Params P) {
    extern __shared__ __attribute__((aligned(16))) unsigned char lds_raw[];
    Ctx C; C.lds = (LAS unsigned char*)lds_raw; C.ldsg = (char*)lds_raw; C.tid = threadIdx.x; C.lane = C.tid & 63; C.wave = __builtin_amdgcn_readfirstlane(C.tid >> 6);
    C.G = gridDim.x; { const int bx = blockIdx.x; C.vcu = (C.G % 8 == 0) ? (bx % 8) * (C.G / 8) + bx / 8 : bx; }
    C.ws = (GAS unsigned char*)P.ws;
    volatile LAS unsigned* MISC = (volatile LAS unsigned*)(C.lds + MISC_OFF);
    if (C.tid < 64) MISC[C.tid] = 0u;
    if (C.tid == 64) { LAS unsigned long long* tab = (LAS unsigned long long*)(C.lds + PTRTAB_OFF);
#pragma unroll
        for (int i = 0; i < 28; ++i) tab[i] = (unsigned long long)P.in[i];
        tab[28] = (unsigned long long)P.out; }
    { LAS float* T = (LAS float*)(C.lds + ROPE_OFF);
      for (int i = C.tid; i < 1024; i += 512) { const int p = i >> 4, f = i & 15; const float fr = powf(10000.0f, -(float)(2 * f) / 32.0f); const float a = (float)p * fr; T[2 * i] = cosf(a); T[2 * i + 1] = sinf(a); } }
    __syncthreads();
    unsigned* barw = g_barw;
    XcdBarrier bar; bar.bar = barw; bar.x = 0; bar.st = nullptr;
    const int lo = P.ph_lo, hi = P.ph_hi;
    const bool multi = (hi - lo) > 1;
    if (multi) bar = xcd_barrier_post(barw, MISC + 8);
#ifndef PH_MASK
#define PH_MASK 0xffff
#endif
#define IN(k) (lo <= (k) && (k) < hi)
#define EN(p) ((PH_MASK >> (p)) & 1)
#ifndef DUP_MASK
#define DUP_MASK 0
#endif
#define NREP(p) (((DUP_MASK >> (p)) & 1) ? 2 : 1)
#define PHASE_CTX(Q) Ctx Q = C; asm volatile("" : "+s"(Q.ws)); asm volatile("" : "+s"(Q.vcu)); asm volatile("" : "+s"(Q.G))
#ifndef TIME_MASK
#define TIME_MASK 0
#endif
#ifndef TIME_AMP
#define TIME_AMP 4
#endif
#define TM_BEGIN(p) unsigned long long tm0_ = 0; if ((TIME_MASK >> (p)) & 1) { __syncthreads(); tm0_ = __builtin_amdgcn_s_memrealtime(); }
#define TM_END(p) if ((TIME_MASK >> (p)) & 1) { __syncthreads(); const unsigned long long d_ = (__builtin_amdgcn_s_memrealtime() - tm0_) * TIME_AMP; const unsigned long long t1_ = __builtin_amdgcn_s_memrealtime(); while (__builtin_amdgcn_s_memrealtime() - t1_ < d_) __builtin_amdgcn_s_sleep(32); }
#define SEAM(k) do { if (IN((k) + 1)) xcd_barrier(bar); } while (0)
    if (EN(11) && IN(0)) { for (int rep = 0; rep < NREP(11); ++rep) { if (rep) xcd_barrier(bar); phase_prologue(P, C); } SEAM(0); }
    for (int l = 0; l < DEPTH; ++l) {
        const int pb = 1 + l * PH_PER_LAYER;
        const bool lastl = (l == DEPTH - 1);
        const int Ml = lastl ? MX : MT;
        const int nMl = Ml / 256;
        if (EN(0) && IN(pb + 0)) { TM_BEGIN(0) phase_mod1(P, C, l); TM_END(0) SEAM(pb + 0); }
        if (EN(1) && IN(pb + 1)) { TM_BEGIN(1)
            { PHASE_CTX(Q);
              pg8::G1aSched S{(const char*)wsp<bf16_t>(Q, WS_H), (const char*)(wsp<bf16_t>(Q, WS_WIN) + (size_t)l * NIN * 1024), 1024, MT / 256, 256, (int)blockIdx.x};
              EpiG1 E{Q.ws, (const LAS float*)(Q.lds + ROPE_OFF)};
              pg8::gemm_phase(Q.lds, 1024, S, E); }
            { PHASE_CTX(Q);
              pg8::G1bSched S{(const char*)wsp<unsigned char>(Q, WS_H8), (const char*)(wsp<unsigned char>(Q, WS_WING8) + (size_t)l * 2560 * 1024), 512, MT / 256, 256, (int)blockIdx.x, wsp<int>(Q, WS_IDLIST)};
              EpiGate E{Q.ws};
              pg8::gemm_phase<EpiGate, pg8::G1bSched, true, true>(Q.lds, 512, S, E); }
            TM_END(1) SEAM(pb + 1);
        }
        if (EN(2) && IN(pb + 2)) { TM_BEGIN(2) PHASE_CTX(Q); const int bx = (int)blockIdx.x;
            { pg8::PlainSched S{(const char*)wsp<bf16_t>(Q, WS_CQ), (const char*)(wsp<bf16_t>(Q, WS_WQB) + (size_t)l * 768 * 384), 384, MT / 256, 3, 256, bx};
              EpiQMla E{Q.ws, (const LAS float*)(Q.lds + ROPE_OFF)};
              pg8::gemm_phase(Q.lds, 384, S, E); }
            { pg8::PlainSched S{(const char*)wsp<bf16_t>(Q, WS_CKV), (const char*)(wsp<bf16_t>(Q, WS_WKVB) + (size_t)l * 1024 * 256), 256, MT / 256, 4, 256, (bx + 104) & 255};
              EpiKvMla E{Q.ws};
              pg8::gemm_phase(Q.lds, 256, S, E); }
            TM_END(2) SEAM(pb + 2);
        }
        if (EN(3) && IN(pb + 3)) { TM_BEGIN(3) for (int rep = 0; rep < NREP(3); ++rep) { if (rep) xcd_barrier(bar); PHASE_CTX(Q);
            const bf16_t* QDA = wsp<bf16_t>(Q, WS_QDA); const bf16_t* KDA = wsp<bf16_t>(Q, WS_KDA); const bf16_t* VDA = wsp<bf16_t>(Q, WS_VDA); bf16_t* ODA = wsp<bf16_t>(Q, WS_ODA);
            const bf16_t* QM = wsp<bf16_t>(Q, WS_QMLA); const bf16_t* KVM = wsp<bf16_t>(Q, WS_KVMLA); const bf16_t* KR = wsp<bf16_t>(Q, WS_KR); bf16_t* OM = wsp<bf16_t>(Q, WS_OMLA);
#ifndef ATT_ONLY
#define ATT_ONLY 3
#endif
            const int nu_m = (ATT_ONLY & 1) ? NB * 4 * 16 + (lastl ? 0 : NB * 4) : 0;
            for (int u = Q.vcu; u < nu_m; u += Q.G) {
                int h, q0, kx0, ky0, ntx, nt;
                if (u < NB * 4 * 16) { const int qb = u & 15, b = u >> 6; h = (u >> 4) & 3; q0 = b * SEQ + qb * 256; kx0 = b * SEQ; ky0 = MX + b * CTXL; ntx = SEQ / 64; nt = SEQ / 64 + CTXL / 64; }
                else { const int v = u - NB * 4 * 16, b = v >> 2; h = v & 3; q0 = MX + b * CTXL; kx0 = 0; ky0 = q0; ntx = 0; nt = CTXL / 64; }
                att::attn_unit<128, 768, 1024, 64, 1024, 512, 1>(QM + h * 192, QM + h * 192 + 128, KVM + h * 256, KR, KVM + h * 256 + 128, OM + h * 128, q0, kx0, ky0, ntx, nt, Q.ldsg,
                                                                 u < NB * 4 * 16 ? wsp<unsigned char>(Q, WS_OB8) + (size_t)MX * 512 + h * 128 : nullptr); }
            const int nu_d = (ATT_ONLY & 2) ? NB * 8 * 16 + (lastl ? 0 : NB * 8) : 0;
            for (int u = Q.vcu; u < nu_d; u += (Q.G == 256 && u < NB * 8 * 16 && u + Q.G >= NB * 8 * 16) ? ((Q.vcu >= 64 && Q.vcu < 128) ? Q.G - 64 : 4 * Q.G) : Q.G) {
                int hm, q0, kx0, ky0, ntx, nt;
                if (u < NB * 8 * 16) { const int qb = u & 15, b = u >> 7; hm = (u >> 4) & 7; q0 = b * SEQ + qb * 256; kx0 = b * SEQ; ky0 = MX + b * CTXL; ntx = SEQ / 64; nt = SEQ / 64 + CTXL / 64; }
                else { const int v = u - NB * 8 * 16, b = v >> 3; hm = v & 7; q0 = MX + b * CTXL; kx0 = 0; ky0 = q0; ntx = 0; nt = CTXL / 64; }
                att::attn_unit<0, 512, 512, 512, 512, 1024, 2>(QDA, QDA + hm * 64, KDA, KDA + hm * 64, VDA + (hm >> 1) * 128, ODA + hm * 128, q0, kx0, ky0, ntx, nt, Q.ldsg);
                if ((u >> 8) == (Q.vcu & 3)) convert_layer_share(Q, l, PER_L_DENSE, PER_L, lastl ? 0 : PER_L_DENSE); }
            } TM_END(3) SEAM(pb + 3);
        }
        if (EN(4) && IN(pb + 4)) { TM_BEGIN(4) phase_damerge(P, C, l, Ml); TM_END(4) SEAM(pb + 4); }
        if (EN(5) && IN(pb + 5)) { TM_BEGIN(5) for (int rep = 0; rep < NREP(5); ++rep) { if (rep) xcd_barrier(bar); PHASE_CTX(Q);
            pg8::PairGSched S{(const char*)wsp<unsigned char>(Q, WS_OB8), (long)MX * 512, (const char*)(wsp<unsigned char>(Q, WS_WBR8) + (size_t)(l * 2) * 1024 * 512), (long)1024 * 512, 256, MX / 256, 4, Q.G, (int)blockIdx.x, wsp<int>(Q, WS_IDLIST)};
            EpiBranch E{Q.ws};
            int kq_ = 256; asm volatile("" : "+s"(kq_));
            pg8::gemm_phase<EpiBranch, pg8::PairGSched, true, true>(Q.lds, kq_, S, E);
            if (!lastl) phase_skinny_branch(Q, l);
            } TM_END(5) SEAM(pb + 5);
        }
        if (EN(6) && IN(pb + 6)) { TM_BEGIN(6) PHASE_CTX(Q);
            pg8::PlainGSched S{(const char*)wsp<unsigned char>(Q, WS_U), (const char*)(wsp<unsigned char>(Q, WS_WOUT8) + (size_t)l * 1024 * 1024), 512, MX / 256, 4, Q.G, (int)blockIdx.x, wsp<int>(Q, WS_IDLIST)};
            EpiOut E{wsp<bf16_t>(Q, WS_XS), inp(Q, I_X), inp(Q, I_CTX), wsp<float>(Q, WS_MOD) + (size_t)l * 9 * 6144, l == 0 ? 1 : 0};
            pg8::gemm_phase<EpiOut, pg8::PlainGSched, true, true>(Q.lds, 512, S, E);
            if (!lastl) phase_skinny_out(Q, l);
            TM_END(6) SEAM(pb + 6);
        }
        if (EN(7) && IN(pb + 7)) { TM_BEGIN(7) for (int rep = 0; rep < NREP(7); ++rep) { if (rep) xcd_barrier(bar); phase_mod2_router(P, C, l, Ml); } TM_END(7) SEAM(pb + 7); }
        if (EN(8) && IN(pb + 8)) { TM_BEGIN(8) for (int rep = 0; rep < NREP(8); ++rep) { if (rep) xcd_barrier(bar); phase_lists(P, C, Ml); } TM_END(8) SEAM(pb + 8); }
        if (EN(9) && IN(pb + 9)) { TM_BEGIN(9) for (int rep = 0; rep < NREP(9); ++rep) { if (rep) xcd_barrier(bar); PHASE_CTX(Q);
            LAS int* tile_e = (LAS int*)(Q.lds + MISC_OFF + 512);
            const int ntiles = moe_tiles(Q, tile_e);
            pg8::MoeSched S{(const char*)wsp<unsigned char>(Q, WS_H8), (const char*)(wsp<unsigned char>(Q, WS_WGU) + (size_t)l * 32 * 1024 * 1024), 512, (size_t)1024 * 1024, ntiles, Q.G, Q.vcu, tile_e, wsp<int>(Q, WS_ROWLIST)};
            EpiUp E{wsp<unsigned char>(Q, WS_ACT), inp(Q, I_BGU) + (size_t)l * 32 * 1024};
            pg8::gemm_phase<EpiUp, pg8::MoeSched, true, true>(Q.lds, 512, S, E);
            } TM_END(9) SEAM(pb + 9);
        }
        if (EN(10) && IN(pb + 10)) { TM_BEGIN(10) for (int rep = 0; rep < NREP(10); ++rep) { if (rep) xcd_barrier(bar); PHASE_CTX(Q);
            LAS int* tile_e = (LAS int*)(Q.lds + MISC_OFF + 512);
            const int ntiles = moe_tiles(Q, tile_e);
            pg8::MoeSched S{(const char*)wsp<unsigned char>(Q, WS_ACT), (const char*)(wsp<unsigned char>(Q, WS_WDN) + (size_t)l * 32 * 1024 * 512), 256, (size_t)1024 * 512, ntiles, Q.G, Q.vcu, tile_e, wsp<int>(Q, WS_IDLIST)};
            EpiDown E{wsp<unsigned char>(Q, WS_Y), inp(Q, I_BDN) + (size_t)l * 32 * 1024};
            int kq_ = 256; asm volatile("" : "+s"(kq_));
            pg8::gemm_phase<EpiDown, pg8::MoeSched, true, true>(Q.lds, kq_, S, E);
            } TM_END(10) SEAM(pb + 10);
        }
    }
    if (EN(12) && IN(N_PHASES - 1)) phase_final(P, C);
    if (multi) {
        __syncthreads();
        if (threadIdx.x == 0) { const unsigned old = xb_add(&g_barw[XCD_BAR_WORDS], 1u); MISC[10] = (old + 1u == gridDim.x) ? 1u : 0u; }
        __syncthreads();
        if (MISC[10]) { for (int i = threadIdx.x; i < XCD_BAR_WORDS + 64; i += 512) g_barw[i] = 0u; }
    }
#undef IN
#undef SEAM
}

extern "C" void kernel_launch(void* const* d_in, const int* in_sizes, int n_in, void* d_out, int out_size, void* d_ws, size_t ws_size, hipStream_t stream) {
    static int grid = 0;
    if (grid == 0) {
        if (n_in != 28 || in_sizes[0] != MX * DM || out_size != MX * DM || ws_size < WS_END) { fprintf(stderr, "kernel_launch: shape/workspace mismatch (n_in %d, ws %zu < %zu)\n", n_in, ws_size, (size_t)WS_END); grid = -1; return; }
        int dev = 0, cus = 0, per_cu = 0;
        if (hipGetDevice(&dev) != hipSuccess || hipDeviceGetAttribute(&cus, hipDeviceAttributeMultiprocessorCount, dev) != hipSuccess) { grid = -1; return; }
        if (hipFuncSetAttribute((const void*)dit_fwd, hipFuncAttributeMaxDynamicSharedMemorySize, LDS_BYTES) != hipSuccess) { fprintf(stderr, "kernel_launch: hipFuncSetAttribute failed\n"); grid = -1; return; }
        if (hipOccupancyMaxActiveBlocksPerMultiprocessor(&per_cu, (const void*)dit_fwd, 512, LDS_BYTES) != hipSuccess || per_cu < 1) fprintf(stderr, "kernel_launch: occupancy query says %d\n", per_cu);
        (void)hipGetLastError();
        grid = cus > 1024 ? 1024 : cus;
    }
    if (grid < 0) return;
    Params p{};
    for (int i = 0; i < 28; ++i) p.in[i] = (const float*)d_in[i];
    p.out = (float*)d_out; p.ws = (unsigned char*)d_ws;
#if MK_ONE_LAUNCH
    p.ph_lo = 0; p.ph_hi = N_PHASES;
    hipLaunchKernelGGL(dit_fwd, dim3(grid), dim3(512), LDS_BYTES, stream, p);
#else
    for (int k = 0; k < N_PHASES; ++k) { p.ph_lo = k; p.ph_hi = k + 1; hipLaunchKernelGGL(dit_fwd, dim3(grid), dim3(512), LDS_BYTES, stream, p); }
#endif
    const hipError_t le = hipPeekAtLastError();
    if (le != hipSuccess) fprintf(stderr, "kernel_launch: launch failed: %s\n", hipGetErrorName(le));
}
```

```cpp
#include <hip/hip_runtime.h>
#include <cstdio>
#include <cstdint>

#ifndef STAG_ON
#define STAG_ON 0
#endif
#ifndef STAG_T
#define STAG_T 37
#endif
#ifndef MK_ONE_LAUNCH
#define MK_ONE_LAUNCH 1
#endif

#define GAS __attribute__((address_space(1)))
#define LAS __attribute__((address_space(3)))
typedef unsigned short bf16_t;
typedef short bf16x8 __attribute__((ext_vector_type(8)));
typedef int i32x4_t __attribute__((ext_vector_type(4)));
typedef int i32x8_t __attribute__((ext_vector_type(8)));
typedef short s16x4 __attribute__((ext_vector_type(4)));
typedef float f32x4 __attribute__((ext_vector_type(4)));
typedef float f32x16 __attribute__((ext_vector_type(16)));
typedef unsigned u32x4 __attribute__((ext_vector_type(4)));
typedef unsigned u32x2 __attribute__((ext_vector_type(2)));

constexpr int DM = 1024, NB = 8, SEQ = 4096, DEPTH = 4, CTXL = 256;
constexpr int MX = NB * SEQ, MY = NB * CTXL, MT = MX + MY;
constexpr int NIN = 4352;
constexpr int NEXP = 32, DFF = 512;
constexpr int PMAX = 147456;
constexpr float EPS = 1e-6f;

constexpr size_t al256(size_t x) { return (x + 255) & ~(size_t)255; }
constexpr size_t WS_CTL = 0, CTL_ZERO_BYTES = 1u << 20;
constexpr size_t WS_MOD = CTL_ZERO_BYTES;
constexpr size_t WS_ROPE = WS_MOD + al256((size_t)DEPTH * 9 * 6144 * 4);
constexpr size_t WS_RWT = WS_ROPE + 8192;
constexpr size_t WS_WIN = WS_RWT + (size_t)DEPTH * 32 * 1024 * 6;
constexpr size_t WS_WQB = WS_WIN + (size_t)DEPTH * NIN * 1024 * 2;
constexpr size_t WS_WKVB = WS_WQB + (size_t)DEPTH * 768 * 384 * 2;
constexpr size_t WS_WBRA = WS_WKVB + (size_t)DEPTH * 1024 * 256 * 2;
constexpr size_t WS_WBRB = WS_WBRA + (size_t)DEPTH * 1024 * 512 * 2;
constexpr size_t WS_WOUT = WS_WBRB + (size_t)DEPTH * 1024 * 512 * 2;
constexpr size_t WS_WGU = WS_WOUT + (size_t)DEPTH * 1024 * 1024 * 2;
constexpr size_t WS_WDN = WS_WGU + (size_t)DEPTH * 32 * 1024 * 1024 * 2;
constexpr size_t WS_XS = WS_WDN + (size_t)DEPTH * 32 * 1024 * 512 * 2;
constexpr size_t WS_H = WS_XS + (size_t)MT * 1024 * 4;
constexpr size_t WS_QDA = WS_H + (size_t)MT * 1024 * 2;
constexpr size_t WS_KDA = WS_QDA + (size_t)MT * 512 * 2;
constexpr size_t WS_VDA = WS_KDA + (size_t)MT * 512 * 2;
constexpr size_t WS_GATES = WS_VDA + (size_t)MT * 512 * 2;
constexpr size_t WS_CQ = WS_GATES + (size_t)MT * 2048 * 2;
constexpr size_t WS_CKV = WS_CQ + (size_t)MT * 384 * 2;
constexpr size_t WS_KR = WS_CKV + (size_t)MT * 256 * 2;
constexpr size_t WS_ROWSQ = WS_KR + (size_t)MT * 64 * 2;
constexpr size_t WS_QMLA = WS_ROWSQ + (size_t)MT * 12 * 4;
constexpr size_t WS_KVMLA = WS_QMLA + (size_t)MT * 768 * 2;
constexpr size_t WS_ODA = WS_KVMLA + (size_t)MT * 1024 * 2;
constexpr size_t WS_OMLA = WS_ODA + (size_t)MT * 1024 * 2;
constexpr size_t WS_ODAN = WS_OMLA + (size_t)MT * 512 * 2;
constexpr size_t WS_U = WS_ODAN + (size_t)MT * 512 * 2;
constexpr size_t WS_TOPE = WS_U + (size_t)MT * 1024 * 2;
constexpr size_t WS_WTS = WS_TOPE + (size_t)MT * 16;
constexpr size_t WS_YDEST = WS_WTS + (size_t)MT * 16;
constexpr size_t WS_CNTWG = WS_YDEST + (size_t)MT * 16;
constexpr size_t WS_PSTART = WS_CNTWG + 1024 * 32 * 4;
constexpr size_t WS_ROWLIST = WS_PSTART + 256;
constexpr size_t WS_ACT = WS_ROWLIST + (size_t)PMAX * 4;
constexpr size_t WS_Y = WS_ACT + (size_t)PMAX * 512 * 2;
constexpr size_t WS_H8 = WS_Y + (size_t)PMAX * 1024 * 2;
constexpr size_t WS_WING8 = WS_H8 + (size_t)MT * 1024;
constexpr size_t WS_IDLIST = WS_WING8 + (size_t)DEPTH * 2560 * 1024;
constexpr size_t WS_WOUT8 = WS_IDLIST + (size_t)PMAX * 4;
constexpr size_t WS_WBR8 = WS_WOUT8 + (size_t)DEPTH * 1024 * 1024;
constexpr size_t WS_OB8 = WS_WBR8 + (size_t)DEPTH * 2 * 1024 * 512;
constexpr size_t WS_END = WS_OB8 + (size_t)2 * MX * 512;

constexpr int CW_BAR = 4096;

constexpr int RING_BYTES = 131072;
constexpr int MISC_OFF = RING_BYTES;
constexpr int ROPE_OFF = 135168;
constexpr int LDS_BYTES = 147456;

typedef float f32x2_t __attribute__((ext_vector_type(2)));
typedef __bf16 bf16x2_t __attribute__((ext_vector_type(2)));
__device__ __forceinline__ unsigned cvt_pk_bf16(float lo, float hi) { f32x2_t v = {lo, hi}; bf16x2_t b = __builtin_convertvector(v, bf16x2_t); return __builtin_bit_cast(unsigned, b); }
__device__ __forceinline__ float bf_lo(unsigned w) { return __uint_as_float(w << 16); }
__device__ __forceinline__ float bf_hi(unsigned w) { return __uint_as_float(w & 0xffff0000u); }
__device__ __forceinline__ float shx(float v, int o, int lane) { return __int_as_float(__builtin_amdgcn_ds_bpermute((lane ^ o) << 2, __float_as_int(v))); }
__device__ __forceinline__ int shxi(int v, int o, int lane) { return __builtin_amdgcn_ds_bpermute((lane ^ o) << 2, v); }
__device__ __forceinline__ float wave_sum(float v, int lane) {
#pragma unroll
    for (int o = 1; o < 64; o <<= 1) v += shx(v, o, lane);
    return v;
}
__device__ __forceinline__ float xchg32(float x, bool lo_half) {
    auto rr = __builtin_amdgcn_permlane32_swap(__float_as_uint(x), __float_as_uint(x), false, false);
    return __uint_as_float(lo_half ? rr[1] : rr[0]);
}
__device__ __forceinline__ float sigmoidf_(float x) { return __builtin_amdgcn_rcpf(1.0f + __builtin_amdgcn_exp2f(x * -1.4426950408889634f)); }
template <typename T> __device__ __forceinline__ T* as_global(T* p) { return (T*)(GAS T*)p; }
template <typename T> __device__ __forceinline__ T* gp(GAS unsigned char* ws, size_t off) { return (T*)(GAS T*)(ws + off); }
__device__ __forceinline__ int opaque_tid() { int t = threadIdx.x; asm volatile("" : "+v"(t)); return t; }
#define LDS_WAIT() asm volatile("s_waitcnt lgkmcnt(0)" ::: "memory")
#define VM_WAIT() asm volatile("s_waitcnt vmcnt(0)" ::: "memory")

#define XB_TMO      128
#define XB_XCNT(j)  (256  + 64 * (j))
#define XB_XSUB(j)  (1280 + 64 * (j))
#define XB_XGEN(j)  (2304 + 64 * (j))
#define XB_TOP      3328
#define XB_TOPGEN   3392
#define XCD_BAR_WORDS 3456
#define XB_SPIN_CAP (1u << 18)
__device__ __forceinline__ unsigned xb_ld(unsigned* p)              { return __hip_atomic_load(p, __ATOMIC_RELAXED, __HIP_MEMORY_SCOPE_AGENT); }
__device__ __forceinline__ unsigned xb_add(unsigned* p, unsigned v) { return __hip_atomic_fetch_add(p, v, __ATOMIC_RELAXED, __HIP_MEMORY_SCOPE_AGENT); }
__device__ __forceinline__ unsigned xb_xcc_id() { return (unsigned)__builtin_amdgcn_s_getreg((3 << 11) | 20) & 0xFu; }
#define XB_SPIN(cond, bar) do { unsigned _sp = 0; while (cond) { __builtin_amdgcn_s_sleep(1); \
    if ((++_sp & 255u) == 0u) { if (xb_ld(&(bar)[XB_TMO])) break; if (_sp > XB_SPIN_CAP) { atomicAdd(&(bar)[XB_TMO], 1u); break; } } } } while (0)
struct XcdBarrier { unsigned* bar; unsigned x; volatile LAS unsigned* st; };
__device__ __forceinline__ XcdBarrier xcd_barrier_post(unsigned* bar, volatile LAS unsigned* st) {
    XcdBarrier b; b.bar = bar; b.x = xb_xcc_id(); b.st = st;
    if (threadIdx.x == 0) (void)xb_add(&bar[XB_XCNT(b.x)], 1u);
    return b;
}
__device__ __forceinline__ void xcd_barrier_complete(unsigned* bar, unsigned x, unsigned& nloc, unsigned& nx) {
    const unsigned G = gridDim.x * gridDim.y * gridDim.z;
    unsigned sum, cnt, mine, sp = 0u;
    for (;;) {
        sum = 0u; cnt = 0u; mine = 0u;
#pragma unroll
        for (unsigned j = 0; j < 16; ++j) { const unsigned c = xb_ld(&bar[XB_XCNT(j)]); sum += c; cnt += (c > 0u) ? 1u : 0u; mine = (j == x) ? c : mine; }
        if (sum == G) break;
        __builtin_amdgcn_s_sleep(1);
        if ((++sp & 255u) == 0u) { if (xb_ld(&bar[XB_TMO])) break; if (sp > XB_SPIN_CAP) { atomicAdd(&bar[XB_TMO], 1u); break; } }
    }
    nloc = mine > 0u ? mine : 1u; nx = cnt > 0u ? cnt : 1u;
}
__device__ __forceinline__ void xcd_barrier(const XcdBarrier& b) {
    asm volatile("s_waitcnt vmcnt(0)" ::: "memory");
    __syncthreads();
    if (threadIdx.x == 0) {
        unsigned* bar = b.bar; asm volatile("" : "+s"(bar));
        __builtin_amdgcn_s_waitcnt(0);
        unsigned nloc = b.st[0], nx = b.st[1];
        if (nloc == 0u) { xcd_barrier_complete(bar, b.x, nloc, nx); b.st[0] = nloc; b.st[1] = nx; }
        const unsigned old = xb_add(&bar[XB_XSUB(b.x)], 1u);
        const unsigned gen = old / nloc;
        if (old + 1u == (gen + 1u) * nloc) {
            __builtin_amdgcn_fence(__ATOMIC_RELEASE, "agent");
            asm volatile("s_waitcnt vmcnt(0)" ::: "memory");
            const unsigned og = xb_add(&bar[XB_TOP], 1u);
            const unsigned tg = og / nx;
            if (og + 1u == (tg + 1u) * nx) xb_add(&bar[XB_TOPGEN], 1u);
            else XB_SPIN(xb_ld(&bar[XB_TOPGEN]) == tg, bar);
            __builtin_amdgcn_fence(__ATOMIC_ACQUIRE, "agent");
            xb_add(&bar[XB_XGEN(b.x)], 1u);
            asm volatile("s_waitcnt vmcnt(0)" ::: "memory");
        } else {
            XB_SPIN(xb_ld(&bar[XB_XGEN(b.x)]) == gen, bar);
            __builtin_amdgcn_fence(__ATOMIC_ACQUIRE, "agent");
            asm volatile("s_waitcnt vmcnt(0)" ::: "memory");
        }
    }
    __syncthreads();
}

namespace pg8 {
constexpr int BM = 256, BK = 64, HALF = 128, HTB = HALF * BK * 2, STAGE_BYTES = 8 * HTB, NXCD = 8, WGM = 8;
__host__ __device__ __forceinline__ int lds_byte(int r, int c) { const int st = (r >> 4) * 2 + (c >> 5), rr = r & 15, cc = c & 31, ob = rr * 64 + cc * 2; return st * 1024 + (ob ^ (((ob >> 9) & 1) << 5)); }
__host__ __device__ __forceinline__ void stage_rc(int b, int& R, int& C) { const int st = b / 1024, sb = b % 1024, swz = sb ^ (((sb >> 9) & 1) << 5); R = (st >> 1) * 16 + swz / 64; C = (st & 1) * 32 + (swz % 64) / 2; }
__host__ __device__ __forceinline__ int perm32(int rho) { const int n = rho >> 4, i = rho & 15; return 8 * (i >> 2) + 4 * n + (i & 3); }
struct Unit { int pm, pn, z; };

template <class Epi, class Sched, bool GATHER = false, bool FP8 = false>
__device__ __forceinline__ void gemm_phase(LAS unsigned char* lds, const int K, const Sched& S, const Epi& E, const int stag_ticks = 0) {
    const int tid = opaque_tid(), wid = __builtin_amdgcn_readfirstlane(tid >> 6), lane = tid & 63, wr = wid >> 2, wc = wid & 3, fr = lane & 15, fq = lane >> 4;
    const int nt = K / BK;
    unsigned voffA[2], voffB[2];
#pragma unroll
    for (int i = 0; i < 2; ++i) { int R, C; stage_rc(tid * 16 + i * 8192, R, C); const int Rb = (R & ~31) + perm32(R & 31);
        voffA[i] = (unsigned)(R * K + C) * 2u; voffB[i] = (unsigned)(Rb * K + C) * 2u; }
    unsigned gA[4] = {0u, 0u, 0u, 0u}, gN[4] = {0u, 0u, 0u, 0u};
#define PG8_GLOAD(dst, u) do { int R0_, C0_; stage_rc(tid * 16, R0_, C0_); const int* rl_ = S.rowlist + (size_t)(u).pm * 256 + R0_; \
        _Pragma("unroll") for (int h_ = 0; h_ < 2; ++h_) _Pragma("unroll") for (int i_ = 0; i_ < 2; ++i_) dst[h_ * 2 + i_] = (unsigned)rl_[h_ * 128 + i_ * 64] * (unsigned)(K * 2) + (unsigned)(C0_ * 2); } while (0)
    const size_t kstep = (size_t)(BK * 2);
    const size_t hstep = (size_t)HALF * K * 2;
    const unsigned ldsw = (unsigned)wid * 1024u;
    const int aoff = lds_byte(wr * 64 + fr, fq * 8), boff = lds_byte(wc * 32 + fr, fq * 8);
#define PG8_SA(b, h) (((b) * 2 + (h)) * HTB)
#define PG8_SB(b, h) ((4 + (b) * 2 + (h)) * HTB)
#define PG8_STAGE(bufoff, gbase, voff) do { _Pragma("unroll") for (int _i = 0; _i < 2; ++_i) \
        __builtin_amdgcn_global_load_lds((const unsigned*)((const char*)(gbase) + (voff)[_i]), (LAS unsigned*)(lds + (bufoff) + ldsw + _i * 8192), 16, 0, 0); } while (0)
#define PG8_STAGE_A(bufoff, ptr, h) do { if constexpr (GATHER) { PG8_STAGE(bufoff, ptr, gA + 2 * (h)); } else { PG8_STAGE(bufoff, (ptr) + (h) * hstep, voffA); } } while (0)
#define PG8_LDA(dst, b, h) do { _Pragma("unroll") for (int m = 0; m < 4; ++m) _Pragma("unroll") for (int k = 0; k < 2; ++k) dst[m][k] = *(const LAS bf16x8*)(lds + PG8_SA(b, h) + aoff + m * 2048 + k * 1024); } while (0)
#define PG8_LDB(dst, b, h) do { _Pragma("unroll") for (int n = 0; n < 2; ++n) _Pragma("unroll") for (int k = 0; k < 2; ++k) dst[n][k] = *(const LAS bf16x8*)(lds + PG8_SB(b, h) + boff + n * 2048 + k * 1024); } while (0)
#define PG8_F8(x0, x1) __builtin_shufflevector(__builtin_bit_cast(i32x4_t, x0), __builtin_bit_cast(i32x4_t, x1), 0, 1, 2, 3, 4, 5, 6, 7)
#define PG8_MMA(ai, bj, At, Bt) do { __builtin_amdgcn_s_setprio(1); \
        if constexpr (FP8) { __builtin_amdgcn_sched_barrier(0); _Pragma("unroll") for (int m = 0; m < 4; ++m) _Pragma("unroll") for (int n = 0; n < 2; ++n) { \
            acc[ai][bj][m][n] = __builtin_amdgcn_mfma_scale_f32_16x16x128_f8f6f4(PG8_F8(Bt[n][0], Bt[n][1]), PG8_F8(At[m][0], At[m][1]), acc[ai][bj][m][n], 0, 0, 0, 0x7f7f7f7f, 0, 0x7f7f7f7f); } __builtin_amdgcn_sched_barrier(0); } \
        else { _Pragma("unroll") for (int m = 0; m < 4; ++m) _Pragma("unroll") for (int n = 0; n < 2; ++n) _Pragma("unroll") for (int k = 0; k < 2; ++k) \
            acc[ai][bj][m][n] = __builtin_amdgcn_mfma_f32_16x16x32_bf16(Bt[n][k], At[m][k], acc[ai][bj][m][n], 0, 0, 0); } \
        __builtin_amdgcn_s_setprio(0); } while (0)
#define PG8_WAIT_V(n) asm volatile("s_waitcnt vmcnt(" #n ")" ::: "memory")
#define PG8_WAIT_L(n) asm volatile("s_waitcnt lgkmcnt(" #n ")" ::: "memory")
#define PG8_BAR __builtin_amdgcn_s_barrier()
#define PG8_SCHED __builtin_amdgcn_sched_barrier(0)
    Unit cur, nxt; int ui = 0;
    if (!S.next(0, cur)) return;
    if (stag_ticks > 0) {
        const unsigned long long t0_ = __builtin_amdgcn_s_memrealtime(); const unsigned long long dl_ = (unsigned long long)stag_ticks;
        while (__builtin_amdgcn_s_memrealtime() - t0_ < dl_) __builtin_amdgcn_s_sleep(16);
    }
    f32x4 acc[2][2][4][2];
#pragma unroll
    for (int a = 0; a < 2; ++a)
#pragma unroll
        for (int b = 0; b < 2; ++b)
#pragma unroll
            for (int m = 0; m < 4; ++m)
#pragma unroll
                for (int n = 0; n < 2; ++n) acc[a][b][m][n] = (f32x4){0.f, 0.f, 0.f, 0.f};
    bf16x8 At[4][2], B0[2][2], B1[2][2];
    const char* cA = S.a_tile(cur); const char* cB = S.b_tile(cur);
    if constexpr (GATHER) { PG8_GLOAD(gA, cur); }
    PG8_STAGE(PG8_SB(0, 0), cB, voffB); PG8_STAGE(PG8_SB(0, 1), cB + hstep, voffB); PG8_STAGE_A(PG8_SA(0, 0), cA, 0); PG8_STAGE_A(PG8_SA(0, 1), cA, 1);
    if (wr == 1) PG8_BAR;
    PG8_WAIT_V(2); PG8_BAR;
    PG8_STAGE(PG8_SB(1, 0), cB + kstep, voffB); PG8_STAGE_A(PG8_SA(1, 0), cA + kstep, 0); PG8_STAGE(PG8_SB(1, 1), cB + hstep + kstep, voffB);
    PG8_WAIT_V(6); PG8_BAR;
    for (;;) {
        const bool has_next = S.next(ui + 1, nxt);
        const char* nA = has_next ? S.a_tile(nxt) : cA; const char* nB = has_next ? S.b_tile(nxt) : cB;
        if constexpr (GATHER) { if (has_next) { PG8_GLOAD(gN, nxt); } }
        for (int t = 0; t < nt; t += 2) {
            const bool last = (t == nt - 2);
            const char* a1 = cA + (size_t)(t + 1) * kstep;
            const char* a2 = last ? nA : cA + (size_t)(t + 2) * kstep; const char* b2 = last ? nB : cB + (size_t)(t + 2) * kstep;
            const char* a3 = a2 + kstep; const char* b3 = b2 + kstep;
            PG8_LDB(B0, 0, 0); PG8_LDB(B1, 0, 1); PG8_SCHED; PG8_LDA(At, 0, 0); PG8_STAGE_A(PG8_SA(1, 1), a1, 1);
            if constexpr (GATHER) { if (last && has_next) { gA[0] = gN[0]; gA[1] = gN[1]; gA[2] = gN[2]; gA[3] = gN[3]; } }
            PG8_WAIT_V(8); PG8_WAIT_L(0); PG8_BAR; PG8_MMA(0, 0, At, B0); PG8_MMA(0, 1, At, B1); PG8_BAR; PG8_SCHED;
            PG8_LDA(At, 0, 1); PG8_STAGE(PG8_SB(0, 0), b2, voffB); PG8_STAGE(PG8_SB(0, 1), b2 + hstep, voffB); PG8_STAGE_A(PG8_SA(0, 0), a2, 0);
            PG8_WAIT_V(8); PG8_WAIT_L(0); PG8_BAR; PG8_MMA(1, 0, At, B0); PG8_MMA(1, 1, At, B1); PG8_BAR; PG8_SCHED;
            PG8_LDB(B0, 1, 0); PG8_LDB(B1, 1, 1); PG8_SCHED; PG8_LDA(At, 1, 0); PG8_STAGE_A(PG8_SA(0, 1), a2, 1);
            PG8_WAIT_V(8); PG8_WAIT_L(0); PG8_BAR; PG8_MMA(0, 0, At, B0); PG8_MMA(0, 1, At, B1); PG8_BAR; PG8_SCHED;
            PG8_LDA(At, 1, 1); PG8_STAGE(PG8_SB(1, 0), b3, voffB); PG8_STAGE(PG8_SB(1, 1), b3 + hstep, voffB); PG8_STAGE_A(PG8_SA(1, 0), a3, 0);
            PG8_WAIT_V(8); PG8_WAIT_L(0); PG8_BAR; PG8_MMA(1, 0, At, B0); PG8_MMA(1, 1, At, B1); PG8_BAR; PG8_SCHED;
        }
        if (wr == 0) PG8_BAR;
        E(acc, cur, wr, wc, fr, fq);
        if (!has_next) break;
        if (!S.keep_acc(cur)) {
#pragma unroll
        for (int a = 0; a < 2; ++a)
#pragma unroll
            for (int b = 0; b < 2; ++b)
#pragma unroll
                for (int m = 0; m < 4; ++m)
#pragma unroll
                    for (int n = 0; n < 2; ++n) acc[a][b][m][n] = (f32x4){0.f, 0.f, 0.f, 0.f};
        }
        cur = nxt; cA = nA; cB = nB; ++ui;
        if (wr == 1) PG8_BAR;
    }
    PG8_WAIT_V(0);
    PG8_BAR;
#undef PG8_SA
#undef PG8_SB
#undef PG8_STAGE
#undef PG8_STAGE_A
#undef PG8_GLOAD
#undef PG8_LDA
#undef PG8_LDB
#undef PG8_MMA
#undef PG8_F8
#undef PG8_WAIT_V
#undef PG8_WAIT_L
#undef PG8_BAR
#undef PG8_SCHED
}

__device__ __forceinline__ bool static_unit(const long L, int nM, int nN, Unit& u);
__device__ __forceinline__ bool static_next(int i, int G, int c, int nM, int nN, Unit& u) { return static_unit((long)i * G + c, nM, nN, u); }
__device__ __forceinline__ bool static_unit(const long L, int nM, int nN, Unit& u) {
    const int nwg = nM * nN; if (L >= nwg) return false;
    int wgid = (int)L; { const int q = nwg / NXCD, r = nwg % NXCD, xcd = wgid % NXCD, off = wgid / NXCD; wgid = (xcd < r ? xcd * (q + 1) : r * (q + 1) + (xcd - r) * q) + off; }
    const int nig = WGM * nN, gid = wgid / nig, fm = gid * WGM, gsz = (nM - fm) < WGM ? (nM - fm) : WGM;
    u.pm = fm + ((wgid % nig) % gsz); u.pn = (wgid % nig) / gsz; u.z = 0; return true;
}
struct PlainSched {
    const char* A; const char* Bt; int K, nM, nN, G, c; static constexpr const int* rowlist = nullptr;
    __device__ __forceinline__ bool next(int i, Unit& u) const { return static_next(i, G, c, nM, nN, u); }
    __device__ __forceinline__ bool keep_acc(const Unit&) const { return false; }
    __device__ __forceinline__ const char* a_tile(const Unit& u) const { return A + (size_t)u.pm * 256 * K * 2; }
    __device__ __forceinline__ const char* b_tile(const Unit& u) const { return Bt + (size_t)u.pn * 256 * K * 2; }
};
struct G1Sched {
    const char* A; const char* Bt; int K, nM, nN, G, c, i0, n; static constexpr const int* rowlist = nullptr;
    __device__ __forceinline__ bool next(int i, Unit& u) const { if (i >= n) return false; const bool ok = static_next(i + i0, G, c, nM, nN, u); u.pn = (u.pn * 9) % 17; return ok; }
    __device__ __forceinline__ bool keep_acc(const Unit&) const { return false; }
    __device__ __forceinline__ const char* a_tile(const Unit& u) const { return A + (size_t)u.pm * 256 * K * 2; }
    __device__ __forceinline__ const char* b_tile(const Unit& u) const { return Bt + (size_t)u.pn * 256 * K * 2; }
};
struct G1aSched {
    const char* A; const char* Bt; int K, nM, G, c; static constexpr const int* rowlist = nullptr;
    __device__ __forceinline__ bool next(int i, Unit& u) const { const bool ok = static_next(i, G, c, nM, 7, u); u.pn = u.pn < 4 ? u.pn : u.pn + 10; return ok; }
    __device__ __forceinline__ bool keep_acc(const Unit&) const { return false; }
    __device__ __forceinline__ const char* a_tile(const Unit& u) const { return A + (size_t)u.pm * 256 * K * 2; }
    __device__ __forceinline__ const char* b_tile(const Unit& u) const { return Bt + (size_t)u.pn * 256 * K * 2; }
};
struct G1bSched {
    const char* A; const char* Bt; int K, nM, G, c; const int* rowlist;
    __device__ __forceinline__ bool next(int i, Unit& u) const { const long L = c < 184 ? (i < 4 ? (long)i * 184 + c : (i == 4 && c < 120 ? (long)736 + c : (long)1 << 30)) : 856 + (long)i * 72 + (c - 184);
        const bool ok = static_unit(L, nM, 10, u) && (c < 184 || i < 7); u.z = u.pn; u.pn += 4; return ok; }
    __device__ __forceinline__ bool keep_acc(const Unit&) const { return false; }
    __device__ __forceinline__ const char* a_tile(const Unit& u) const { return A; }
    __device__ __forceinline__ const char* b_tile(const Unit& u) const { return Bt + (size_t)u.z * 256 * K * 2; }
};
struct PlainGSched {
    const char* A; const char* Bt; int K, nM, nN, G, c; const int* rowlist;
    __device__ __forceinline__ bool next(int i, Unit& u) const { return static_next(i, G, c, nM, nN, u); }
    __device__ __forceinline__ bool keep_acc(const Unit&) const { return false; }
    __device__ __forceinline__ const char* a_tile(const Unit& u) const { return A; }
    __device__ __forceinline__ const char* b_tile(const Unit& u) const { return Bt + (size_t)u.pn * 256 * K * 2; }
};
struct PairSched {
    const char* A0; long dA; const char* B0; long dB; int K, nM, nN, G, c; static constexpr const int* rowlist = nullptr;
    __device__ __forceinline__ bool next(int i, Unit& u) const { const bool ok = static_next(i >> 1, G, c, nM, nN, u); u.z = i & 1; return ok; }
    __device__ __forceinline__ bool keep_acc(const Unit& u) const { return u.z == 0; }
    __device__ __forceinline__ const char* a_tile(const Unit& u) const { return A0 + (long)u.z * dA + (size_t)u.pm * 256 * K * 2; }
    __device__ __forceinline__ const char* b_tile(const Unit& u) const { return B0 + (long)u.z * dB + (size_t)u.pn * 256 * K * 2; }
};
struct PairGSched {
    const char* A0; long dA; const char* B0; long dB; int K, nM, nN, G, c; const int* rowlist;
    __device__ __forceinline__ bool next(int i, Unit& u) const { const bool ok = static_next(i >> 1, G, c, nM, nN, u); u.z = i & 1; return ok; }
    __device__ __forceinline__ bool keep_acc(const Unit& u) const { return u.z == 0; }
    __device__ __forceinline__ const char* a_tile(const Unit& u) const { return A0 + (long)u.z * dA; }
    __device__ __forceinline__ const char* b_tile(const Unit& u) const { return B0 + (long)u.z * dB + (size_t)u.pn * 256 * K * 2; }
};
struct MoeSched {
    const char* A; const char* Bt; int K; size_t bstride; int ntiles, G, c; const LAS int* tile_e; const int* rowlist;
    __device__ __forceinline__ bool next(int i, Unit& u) const { const long L = (long)i * G + c; const int t = (int)(L >> 2); if (t >= ntiles) return false;
        u.pm = t; u.pn = (int)(L & 3); u.z = __builtin_amdgcn_readfirstlane(tile_e[t]); return true; }
    __device__ __forceinline__ bool keep_acc(const Unit&) const { return false; }
    __device__ __forceinline__ const char* a_tile(const Unit& u) const { return rowlist ? A : A + (size_t)u.pm * 256 * K * 2; }
    __device__ __forceinline__ const char* b_tile(const Unit& u) const { return Bt + (size_t)u.z * bstride + (size_t)u.pn * 256 * K * 2; }
};
}
using pg8::Unit;

#define EPI_ROWS(u, wr, fr) const int row0_ = (u).pm * 256 + (wr) * 64 + (fr);
#define EPI_V8(v, acc, ai, bj, m) float v[8] = {acc[ai][bj][m][0][0], acc[ai][bj][m][0][1], acc[ai][bj][m][0][2], acc[ai][bj][m][0][3], acc[ai][bj][m][1][0], acc[ai][bj][m][1][1], acc[ai][bj][m][1][2], acc[ai][bj][m][1][3]}
__device__ __forceinline__ void store8_bf16(bf16_t* p, const float (&v)[8]) {
    u32x4 w; w.x = cvt_pk_bf16(v[0], v[1]); w.y = cvt_pk_bf16(v[2], v[3]); w.z = cvt_pk_bf16(v[4], v[5]); w.w = cvt_pk_bf16(v[6], v[7]);
    *(u32x4*)p = w;
}
__device__ __forceinline__ void rope8(float (&v)[8], int pos, int g, int fq, const LAS float* T) {
    const int p = g ? (pos & 63) : (pos >> 6);
    const LAS f32x4* t = (const LAS f32x4*)(T + p * 32 + (fq & 1) * 16);
    const f32x4 t0 = t[0], t1 = t[1], t2 = t[2], t3 = t[3];
    const float cs[8] = {t0[0], t0[2], t1[0], t1[2], t2[0], t2[2], t3[0], t3[2]};
    const float sn[8] = {t0[1], t0[3], t1[1], t1[3], t2[1], t2[3], t3[1], t3[3]};
    const bool lo = fq < 2;
#pragma unroll
    for (int i = 0; i < 8; ++i) { const float pv = xchg32(v[i], lo); v[i] = lo ? (v[i] * cs[i] - pv * sn[i]) : (v[i] * cs[i] + pv * sn[i]); }
}

struct EpiG1 {
    GAS unsigned char* ws; const LAS float* rope;
    __device__ __forceinline__ void operator()(f32x4 (&acc)[2][2][4][2], const Unit& u, int wr, int wc, int fr, int fq) const {
        EPI_ROWS(u, wr, fr)
        bf16_t* const qda = gp<bf16_t>(ws, WS_QDA); bf16_t* const kda = gp<bf16_t>(ws, WS_KDA); bf16_t* const vda = gp<bf16_t>(ws, WS_VDA); unsigned char* const gates = gp<unsigned char>(ws, WS_GATES);
        bf16_t* const cq = gp<bf16_t>(ws, WS_CQ); bf16_t* const ckv = gp<bf16_t>(ws, WS_CKV); bf16_t* const kr = gp<bf16_t>(ws, WS_KR); float* const rowsq = gp<float>(ws, WS_ROWSQ);
        const int pn = u.pn; const bool xrows = u.pm < (MX / 256);
        if (pn < 4) {
            bf16_t* dst = pn < 2 ? qda : kda; const int cb = (pn & 1) * 256 + wc * 32 + 8 * fq;
#pragma unroll
            for (int ai = 0; ai < 2; ++ai)
#pragma unroll
                for (int m = 0; m < 4; ++m) { const int row = row0_ + ai * 128 + m * 16;
#pragma unroll
                    for (int bj = 0; bj < 2; ++bj) { EPI_V8(v, acc, ai, bj, m); if (xrows) rope8(v, row & 4095, wc & 1, fq, rope); store8_bf16(dst + (size_t)row * 512 + cb + bj * 128, v); } }
        } else if (pn < 6) {
            const int cb = (pn - 4) * 256 + wc * 32 + 8 * fq;
#pragma unroll
            for (int ai = 0; ai < 2; ++ai)
#pragma unroll
                for (int m = 0; m < 4; ++m) { const int row = row0_ + ai * 128 + m * 16;
#pragma unroll
                    for (int bj = 0; bj < 2; ++bj) { EPI_V8(v, acc, ai, bj, m); store8_bf16(vda + (size_t)row * 512 + cb + bj * 128, v); } }
        } else if (pn == 14) {
            const int cb = wc * 32 + 8 * fq;
#pragma unroll
            for (int ai = 0; ai < 2; ++ai)
#pragma unroll
                for (int m = 0; m < 4; ++m) { const int row = row0_ + ai * 128 + m * 16; float ss = 0.f;
#pragma unroll
                    for (int bj = 0; bj < 2; ++bj) { EPI_V8(v, acc, ai, bj, m);
#pragma unroll
                        for (int i = 0; i < 8; ++i) ss += v[i] * v[i];
                        store8_bf16(cq + (size_t)row * 384 + cb + bj * 128, v); }
                    ss += shx(ss, 16, fq * 16 + fr); ss += shx(ss, 32, fq * 16 + fr);
                    if (fq == 0) rowsq[(size_t)row * 12 + wc] = ss; }
        } else if (pn == 15) {
            const int cb = wc * 32 + 8 * fq;
#pragma unroll
            for (int ai = 0; ai < 2; ++ai)
#pragma unroll
                for (int m = 0; m < 4; ++m) { const int row = row0_ + ai * 128 + m * 16; float ss = 0.f;
                    { EPI_V8(v, acc, ai, 0, m);
#pragma unroll
                        for (int i = 0; i < 8; ++i) ss += v[i] * v[i];
                        store8_bf16(cq + (size_t)row * 384 + 256 + cb, v); }
                    ss += shx(ss, 16, fq * 16 + fr); ss += shx(ss, 32, fq * 16 + fr);
                    if (fq == 0) rowsq[(size_t)row * 12 + 4 + wc] = ss;
                    if (wc < 2) { EPI_V8(v, acc, ai, 1, m); if (xrows) rope8(v, row & 4095, wc, fq, rope); store8_bf16(kr + (size_t)row * 64 + cb, v); } }
        } else {
            const int cb = wc * 32 + 8 * fq;
#pragma unroll
            for (int ai = 0; ai < 2; ++ai)
#pragma unroll
                for (int m = 0; m < 4; ++m) { const int row = row0_ + ai * 128 + m * 16; float ss = 0.f;
#pragma unroll
                    for (int bj = 0; bj < 2; ++bj) { EPI_V8(v, acc, ai, bj, m);
#pragma unroll
                        for (int i = 0; i < 8; ++i) ss += v[i] * v[i];
                        store8_bf16(ckv + (size_t)row * 256 + cb + bj * 128, v); }
                    ss += shx(ss, 16, fq * 16 + fr); ss += shx(ss, 32, fq * 16 + fr);
                    if (fq == 0) rowsq[(size_t)row * 12 + 8 + wc] = ss; }
        }
    }
};
struct EpiGate {
    GAS unsigned char* ws;
    __device__ __forceinline__ void operator()(f32x4 (&acc)[2][2][4][2], const Unit& u, int wr, int wc, int fr_, int fq_) const {
        const int lz = opaque_tid() & 63, fr = lz & 15, fq = lz >> 4;
        EPI_ROWS(u, wr, fr)
        unsigned char* const gates = gp<unsigned char>(ws, WS_GATES); const int pn = u.pn;
        if (pn < 6) {
            bf16_t* const vda = gp<bf16_t>(ws, WS_VDA); const int cb = (pn - 4) * 256 + wc * 32 + 8 * fq;
#pragma unroll
            for (int ai = 0; ai < 2; ++ai)
#pragma unroll
                for (int m = 0; m < 4; ++m) { const int row = row0_ + ai * 128 + m * 16;
#pragma unroll
                    for (int bj = 0; bj < 2; ++bj) { EPI_V8(v, acc, ai, bj, m);
#pragma unroll
                        for (int i = 0; i < 8; ++i) v[i] *= (1.0f / 64.0f);
                        store8_bf16(vda + (size_t)row * 512 + cb + bj * 128, v); } }
        } else {
            const int cb = (pn - 6) * 256 + wc * 32 + 8 * fq;
            const float glo = pn >= 10 ? 1.0f : 0.0f;
#pragma unroll
            for (int ai = 0; ai < 2; ++ai)
#pragma unroll
                for (int m = 0; m < 4; ++m) { const int row = row0_ + ai * 128 + m * 16;
#pragma unroll
                    for (int bj = 0; bj < 2; ++bj) { EPI_V8(v, acc, ai, bj, m);
#pragma unroll
                        for (int i = 0; i < 8; ++i) v[i] = fmaxf(sigmoidf_(v[i] * (1.0f / 64.0f)) * 255.0f, glo);
                        u32x2 w = (u32x2){0u, 0u};
#pragma unroll
                        for (int i = 0; i < 4; ++i) { w.x = __builtin_amdgcn_cvt_pk_u8_f32(v[i], i, w.x); w.y = __builtin_amdgcn_cvt_pk_u8_f32(v[4 + i], i, w.y); }
                        *(u32x2*)(gates + (size_t)row * 2048 + cb + bj * 128) = w; } }
        }
    }
};
struct EpiNull {
    __device__ __forceinline__ void operator()(f32x4 (&acc)[2][2][4][2], const Unit& u, int wr, int wc, int fr, int fq) const {
#pragma unroll
        for (int ai = 0; ai < 2; ++ai)
#pragma unroll
            for (int bj = 0; bj < 2; ++bj)
#pragma unroll
                for (int m = 0; m < 4; ++m)
#pragma unroll
                    for (int n = 0; n < 2; ++n) asm volatile("" :: "v"(acc[ai][bj][m][n]));
    }
};
struct EpiQMla {
    GAS unsigned char* ws; const LAS float* rope;
    __device__ __forceinline__ void operator()(f32x4 (&acc)[2][2][4][2], const Unit& u, int wr, int wc, int fr_, int fq) const {
        const int fr = opaque_tid() & 15;
        EPI_ROWS(u, wr, fr)
        bf16_t* const qmla = gp<bf16_t>(ws, WS_QMLA); const float* const rowsq = gp<const float>(ws, WS_ROWSQ);
        const bool xrows = u.pm < (MX / 256);
#pragma unroll
        for (int ai = 0; ai < 2; ++ai)
#pragma unroll
            for (int m = 0; m < 4; ++m) { const int row = row0_ + ai * 128 + m * 16;
                const f32x4 q0_ = *(const f32x4*)(rowsq + (size_t)row * 12), q1_ = *(const f32x4*)(rowsq + (size_t)row * 12 + 4);
                const float sc = rsqrtf((((q0_[0] + q0_[1]) + (q0_[2] + q0_[3])) + ((q1_[0] + q1_[1]) + (q1_[2] + q1_[3]))) * (1.0f / 384.0f) + EPS);
#pragma unroll
                for (int bj = 0; bj < 2; ++bj) { const int g32 = u.pn * 8 + bj * 4 + wc, j = g32 % 6;
                    EPI_V8(v, acc, ai, bj, m);
#pragma unroll
                    for (int i = 0; i < 8; ++i) v[i] *= sc;
                    if (xrows && j >= 4) rope8(v, row & 4095, j - 4, fq, rope);
                    store8_bf16(qmla + (size_t)row * 768 + g32 * 32 + 8 * fq, v); } }
    }
};
struct EpiKvMla {
    GAS unsigned char* ws;
    __device__ __forceinline__ void operator()(f32x4 (&acc)[2][2][4][2], const Unit& u, int wr, int wc, int fr_, int fq) const {
        const int fr = opaque_tid() & 15;
        EPI_ROWS(u, wr, fr)
        bf16_t* const kvmla = gp<bf16_t>(ws, WS_KVMLA); const float* const rowsq = gp<const float>(ws, WS_ROWSQ);
        const int cb = u.pn * 256 + wc * 32 + 8 * fq;
#pragma unroll
        for (int ai = 0; ai < 2; ++ai)
#pragma unroll
            for (int m = 0; m < 4; ++m) { const int row = row0_ + ai * 128 + m * 16;
                const f32x4 q2_ = *(const f32x4*)(rowsq + (size_t)row * 12 + 8);
                const float sc = rsqrtf(((q2_[0] + q2_[1]) + (q2_[2] + q2_[3])) * (1.0f / 256.0f) + EPS);
#pragma unroll
                for (int bj = 0; bj < 2; ++bj) { EPI_V8(v, acc, ai, bj, m);
#pragma unroll
                    for (int i = 0; i < 8; ++i) v[i] *= sc;
                    store8_bf16(kvmla + (size_t)row * 1024 + cb + bj * 128, v); } }
    }
};
struct EpiBranch {
    GAS unsigned char* ws;
    __device__ __forceinline__ void operator()(f32x4 (&acc)[2][2][4][2], const Unit& u, int wr, int wc, int fr, int fq) const {
        EPI_ROWS(u, wr, fr)
        unsigned char* const U8 = gp<unsigned char>(ws, WS_U); const unsigned char* const gates = gp<const unsigned char>(ws, WS_GATES);
        const int cb = u.pn * 256 + wc * 32 + 8 * fq;
#define UNPK8(g) {(float)(g.x & 255u), (float)((g.x >> 8) & 255u), (float)((g.x >> 16) & 255u), (float)(g.x >> 24), (float)(g.y & 255u), (float)((g.y >> 8) & 255u), (float)((g.y >> 16) & 255u), (float)(g.y >> 24)}
        if (u.z == 0) {
#pragma unroll
            for (int ai = 0; ai < 2; ++ai) { u32x2 ga_[4][2], gb_[4][2];
#pragma unroll
                for (int m = 0; m < 4; ++m)
#pragma unroll
                    for (int bj = 0; bj < 2; ++bj) { const unsigned char* gp_ = gates + (size_t)(row0_ + ai * 128 + m * 16) * 2048 + cb + bj * 128; ga_[m][bj] = *(const u32x2*)gp_; gb_[m][bj] = *(const u32x2*)(gp_ + 1024); }
                __builtin_amdgcn_sched_barrier(0);
#pragma unroll
                for (int m = 0; m < 4; ++m)
#pragma unroll
                    for (int bj = 0; bj < 2; ++bj) { const float a_[8] = UNPK8(ga_[m][bj]); const float b_[8] = UNPK8(gb_[m][bj]);
#pragma unroll
                        for (int i = 0; i < 4; ++i) { acc[ai][bj][m][0][i] *= a_[i] * __builtin_amdgcn_rcpf(b_[i]); acc[ai][bj][m][1][i] *= a_[4 + i] * __builtin_amdgcn_rcpf(b_[4 + i]); } }
            }
        } else {
#pragma unroll
            for (int ai = 0; ai < 2; ++ai) { u32x2 gb_[4][2];
#pragma unroll
                for (int m = 0; m < 4; ++m)
#pragma unroll
                    for (int bj = 0; bj < 2; ++bj) gb_[m][bj] = *(const u32x2*)(gates + (size_t)(row0_ + ai * 128 + m * 16) * 2048 + 1024 + cb + bj * 128);
                __builtin_amdgcn_sched_barrier(0);
#pragma unroll
                for (int m = 0; m < 4; ++m)
#pragma unroll
                    for (int bj = 0; bj < 2; ++bj) { const float b_[8] = UNPK8(gb_[m][bj]); EPI_V8(v, acc, ai, bj, m);
#pragma unroll
                        for (int i = 0; i < 8; ++i) v[i] = fminf(fmaxf(v[i] * b_[i] * (8.0f / 255.0f / 512.0f), -448.0f), 448.0f);
                        int w0 = __builtin_amdgcn_cvt_pk_fp8_f32(v[0], v[1], 0, false); w0 = __builtin_amdgcn_cvt_pk_fp8_f32(v[2], v[3], w0, true);
                        int w1 = __builtin_amdgcn_cvt_pk_fp8_f32(v[4], v[5], 0, false); w1 = __builtin_amdgcn_cvt_pk_fp8_f32(v[6], v[7], w1, true);
                        *(u32x2*)(U8 + (size_t)(row0_ + ai * 128 + m * 16) * 1024 + cb + bj * 128) = (u32x2){(unsigned)w0, (unsigned)w1}; }
            }
        }
#undef UNPK8
    }
};
struct EpiOut {
    bf16_t* XS; const float* xin; const float* ctx; const float* mod_l; int first;
    __device__ __forceinline__ void operator()(f32x4 (&acc)[2][2][4][2], const Unit& u, int wr, int wc, int fr, int fq) const {
        EPI_ROWS(u, wr, fr)
        const int cb = u.pn * 256 + wc * 32 + 8 * fq;
        const bool xrows = u.pm < (MX / 256);
        const int bidx = xrows ? (u.pm >> 4) : 8;
        const float* g1 = mod_l + (size_t)bidx * 6144 + 2048;
        if (first) {
            const float* base = xrows ? xin : ctx - (size_t)MX * 1024;
#pragma unroll
            for (int bj = 0; bj < 2; ++bj) { const int col = cb + bj * 128;
                const f32x4 ga = *(const f32x4*)(g1 + col) * (1.0f / 512.0f), gb = *(const f32x4*)(g1 + col + 4) * (1.0f / 512.0f);
#pragma unroll
                for (int ai = 0; ai < 2; ++ai) { f32x4 b0_[4], b1_[4];
#pragma unroll
                    for (int m = 0; m < 4; ++m) { const size_t off = (size_t)(row0_ + ai * 128 + m * 16) * 1024 + col; b0_[m] = *(const f32x4*)(base + off); b1_[m] = *(const f32x4*)(base + off + 4); }
                    __builtin_amdgcn_sched_barrier(0);
#pragma unroll
                    for (int m = 0; m < 4; ++m) { const size_t off = (size_t)(row0_ + ai * 128 + m * 16) * 1024 + col;
                        const f32x4 r0 = b0_[m] + ga * acc[ai][bj][m][0], r1 = b1_[m] + gb * acc[ai][bj][m][1];
                        u32x4 w; w.x = cvt_pk_bf16(r0.x, r0.y); w.y = cvt_pk_bf16(r0.z, r0.w); w.z = cvt_pk_bf16(r1.x, r1.y); w.w = cvt_pk_bf16(r1.z, r1.w); *(u32x4*)(XS + off) = w; } } }
        } else {
#pragma unroll
            for (int bj = 0; bj < 2; ++bj) { const int col = cb + bj * 128;
                const f32x4 ga = *(const f32x4*)(g1 + col) * (1.0f / 512.0f), gb = *(const f32x4*)(g1 + col + 4) * (1.0f / 512.0f);
#pragma unroll
                for (int ai = 0; ai < 2; ++ai) { u32x4 bb[4];
#pragma unroll
                    for (int m = 0; m < 4; ++m) { const size_t off = (size_t)(row0_ + ai * 128 + m * 16) * 1024 + col; bb[m] = *(const u32x4*)(XS + off); }
                    __builtin_amdgcn_sched_barrier(0);
#pragma unroll
                    for (int m = 0; m < 4; ++m) { const size_t off = (size_t)(row0_ + ai * 128 + m * 16) * 1024 + col;
                        const f32x4 b0 = (f32x4){bf_lo(bb[m].x), bf_hi(bb[m].x), bf_lo(bb[m].y), bf_hi(bb[m].y)}, b1 = (f32x4){bf_lo(bb[m].z), bf_hi(bb[m].z), bf_lo(bb[m].w), bf_hi(bb[m].w)};
                        const f32x4 r0 = b0 + ga * acc[ai][bj][m][0], r1 = b1 + gb * acc[ai][bj][m][1];
                        u32x4 w; w.x = cvt_pk_bf16(r0.x, r0.y); w.y = cvt_pk_bf16(r0.z, r0.w); w.z = cvt_pk_bf16(r1.x, r1.y); w.w = cvt_pk_bf16(r1.z, r1.w); *(u32x4*)(XS + off) = w; } } }
        }
    }
};
struct EpiUp {
    unsigned char* act; const float* bgu;
    __device__ __forceinline__ void operator()(f32x4 (&acc)[2][2][4][2], const Unit& u, int wr, int wc, int fr, int fq) const {
        EPI_ROWS(u, wr, fr)
        const int j0 = u.pn * 128 + wc * 32 + 8 * fq;
        const float* bg = bgu + (size_t)u.z * 1024 + j0;
        const f32x4 g0 = *(const f32x4*)bg, g1 = *(const f32x4*)(bg + 4), l0 = *(const f32x4*)(bg + 512), l1 = *(const f32x4*)(bg + 516);
        const float bgv[8] = {g0[0], g0[1], g0[2], g0[3], g1[0], g1[1], g1[2], g1[3]}, blv[8] = {l0[0], l0[1], l0[2], l0[3], l1[0], l1[1], l1[2], l1[3]};
#pragma unroll
        for (int ai = 0; ai < 2; ++ai)
#pragma unroll
            for (int m = 0; m < 4; ++m) { const int row = row0_ + ai * 128 + m * 16;
                EPI_V8(gt, acc, ai, 0, m); EPI_V8(ln, acc, ai, 1, m); float o[8];
#pragma unroll
                for (int i = 0; i < 8; ++i) { const float g = fminf(gt[i] * (1.0f / 64.0f) + bgv[i], 7.0f); const float li = fminf(fmaxf(ln[i] * (1.0f / 64.0f) + blv[i], -7.0f), 7.0f);
                    o[i] = fminf(fmaxf((li + 1.0f) * g * sigmoidf_(1.702f * g) * 8.0f, -448.0f), 448.0f); }
                int w0 = __builtin_amdgcn_cvt_pk_fp8_f32(o[0], o[1], 0, false); w0 = __builtin_amdgcn_cvt_pk_fp8_f32(o[2], o[3], w0, true);
                int w1 = __builtin_amdgcn_cvt_pk_fp8_f32(o[4], o[5], 0, false); w1 = __builtin_amdgcn_cvt_pk_fp8_f32(o[6], o[7], w1, true);
                *(u32x2*)(act + (size_t)row * 512 + j0) = (u32x2){(unsigned)w0, (unsigned)w1}; }
    }
};
struct EpiDown {
    unsigned char* Y; const float* bdn;
    __device__ __forceinline__ void operator()(f32x4 (&acc)[2][2][4][2], const Unit& u, int wr, int wc, int fr, int fq) const {
        EPI_ROWS(u, wr, fr)
        const int cb = u.pn * 256 + wc * 32 + 8 * fq;
#pragma unroll
        for (int bj = 0; bj < 2; ++bj) { const int col = cb + bj * 128; const float* bp = bdn + (size_t)u.z * 1024 + col;
            const f32x4 b0 = *(const f32x4*)bp, b1 = *(const f32x4*)(bp + 4);
#pragma unroll
            for (int ai = 0; ai < 2; ++ai)
#pragma unroll
                for (int m = 0; m < 4; ++m) { const int row = row0_ + ai * 128 + m * 16;
                    f32x4 a0 = acc[ai][bj][m][0] * (1.0f / 64.0f) + b0 * 8.0f, a1 = acc[ai][bj][m][1] * (1.0f / 64.0f) + b1 * 8.0f;
#pragma unroll
                    for (int i = 0; i < 4; ++i) { a0[i] = fminf(fmaxf(a0[i], -448.0f), 448.0f); a1[i] = fminf(fmaxf(a1[i], -448.0f), 448.0f); }
                    int w0 = __builtin_amdgcn_cvt_pk_fp8_f32(a0[0], a0[1], 0, false); w0 = __builtin_amdgcn_cvt_pk_fp8_f32(a0[2], a0[3], w0, true);
                    int w1 = __builtin_amdgcn_cvt_pk_fp8_f32(a1[0], a1[1], 0, false); w1 = __builtin_amdgcn_cvt_pk_fp8_f32(a1[2], a1[3], w1, true);
                    *(u32x2*)(Y + (size_t)row * 1024 + col) = (u32x2){(unsigned)w0, (unsigned)w1}; } }
    }
};

namespace att {
constexpr int NW = 8, QBLK = 32, KVBLK = 64;
constexpr int SHM_V = 16384, SHM_KR = 8192, SHM_KN = 16384;
constexpr int OFF_V = 0, OFF_KR = 3 * SHM_V, OFF_KN = OFF_KR + 3 * SHM_KR, OFF_WS = OFF_KN + 3 * SHM_KN;
static_assert(OFF_WS + 2048 <= 131072, "attention LDS map");
constexpr float THR = 8.f;
#define KSLAB(row, c) ((((c) >> 4) * 2048) + (row) * 32 + ((((((c) >> 3) & 1) ^ (((row) >> 3) & 1))) << 4))
#define SBAR() __builtin_amdgcn_sched_barrier(0)
__device__ __forceinline__ int crow(int r, int hi) { return (r & 3) + 8 * (r >> 2) + 4 * hi; }
template <int DN> struct SC { static constexpr float SCALE = DN ? 0.07216878364870322f : 0.125f; };
__device__ __forceinline__ void psm1(const f32x16& p0, float& pmax) {
    pmax = p0[0];
#pragma unroll
    for (int r = 1; r < 16; ++r) pmax = fmaxf(pmax, p0[r]);
}
template <int DN>
__device__ __forceinline__ void psm2(const f32x16& p1, float& pmax, float& m_reg, float& mn, float& alpha) {
    constexpr float SCALE = SC<DN>::SCALE, C = SCALE * 1.4426950408889634f;
#pragma unroll
    for (int r = 0; r < 16; ++r) pmax = fmaxf(pmax, p1[r]);
    { auto rr = __builtin_amdgcn_permlane32_swap(__float_as_uint(pmax), __float_as_uint(pmax), false, false);
      pmax = fmaxf(__uint_as_float(rr[0]), __uint_as_float(rr[1])); }
    if (__builtin_expect(__all(pmax - m_reg <= THR / SCALE), 1)) { mn = m_reg; alpha = 1.f; }
    else { mn = fmaxf(m_reg, pmax); alpha = __builtin_amdgcn_exp2f((m_reg - mn) * C); m_reg = mn; }
}
template <int DN>
__device__ __forceinline__ void psm3(f32x16& p0, f32x16& p1, float mn) {
    constexpr float SCALE = SC<DN>::SCALE, C = SCALE * 1.4426950408889634f;
    const float mnC = -mn * C;
#pragma unroll
    for (int r = 0; r < 16; ++r) p0[r] = fmaf(p0[r], C, mnC);
#pragma unroll
    for (int r = 0; r < 16; ++r) p1[r] = fmaf(p1[r], C, mnC);
}
__device__ __forceinline__ void psm4(f32x16& p0) {
#pragma unroll
    for (int r = 0; r < 16; ++r) p0[r] = __builtin_amdgcn_exp2f(p0[r]);
}
template <int DN>
__device__ __forceinline__ void partialSM(f32x16& p0, f32x16& p1, float& m_reg, float& mn, float& alpha) {
    float pmax; psm1(p0, pmax); psm2<DN>(p1, pmax, m_reg, mn, alpha); psm3<DN>(p0, p1, mn); psm4(p0);
}
__device__ __forceinline__ void finishSM(f32x16& p0, f32x16& p1, float alpha, float& l_reg, bf16x8& pa0, bf16x8& pa1, bf16x8& pa2, bf16x8& pa3) {
#pragma unroll
    for (int r = 0; r < 16; ++r) p1[r] = __builtin_amdgcn_exp2f(p1[r]);
    float ps = 0;
#pragma unroll
    for (int r = 0; r < 16; ++r) ps += p0[r];
#pragma unroll
    for (int r = 0; r < 16; ++r) ps += p1[r];
    { auto rr = __builtin_amdgcn_permlane32_swap(__float_as_uint(ps), __float_as_uint(ps), false, false);
      ps = __uint_as_float(rr[0]) + __uint_as_float(rr[1]); }
    l_reg = l_reg * alpha + ps;
#define PK4(P, BASE, OUT) do { unsigned a0 = cvt_pk_bf16(P[BASE + 0], P[BASE + 1]), a1 = cvt_pk_bf16(P[BASE + 2], P[BASE + 3]);   \
    unsigned b0 = cvt_pk_bf16(P[BASE + 4], P[BASE + 5]), b1 = cvt_pk_bf16(P[BASE + 6], P[BASE + 7]);                              \
    auto r0 = __builtin_amdgcn_permlane32_swap(a0, b0, false, false); auto r1 = __builtin_amdgcn_permlane32_swap(a1, b1, false, false); \
    u32x4 w = {r0[0], r1[0], r0[1], r1[1]}; OUT = *reinterpret_cast<bf16x8*>(&w); } while (0)
    PK4(p0, 0, pa0); PK4(p0, 8, pa1); PK4(p1, 0, pa2); PK4(p1, 8, pa3);
#undef PK4
}
template <int DN>
__device__ __forceinline__ void qkt(f32x16& p0, f32x16& p1, const LAS char* Kn, const LAS char* Kr, const bf16x8* qn, const bf16x8* qr, int kb) {
    p0 = f32x16{}; p1 = f32x16{};
    if constexpr (DN > 0) {
#pragma unroll
        for (int d0 = 0; d0 < DN / 16; ++d0) {
            const bf16x8 b0 = *(const LAS bf16x8*)(Kn + kb + d0 * 2048);
            const bf16x8 b1 = *(const LAS bf16x8*)(Kn + kb + d0 * 2048 + 1024);
            p0 = __builtin_amdgcn_mfma_f32_32x32x16_bf16(b0, qn[d0], p0, 0, 0, 0);
            p1 = __builtin_amdgcn_mfma_f32_32x32x16_bf16(b1, qn[d0], p1, 0, 0, 0); }
    }
#pragma unroll
    for (int d0 = 0; d0 < 4; ++d0) {
        const bf16x8 b0 = *(const LAS bf16x8*)(Kr + kb + d0 * 2048);
        const bf16x8 b1 = *(const LAS bf16x8*)(Kr + kb + d0 * 2048 + 1024);
        p0 = __builtin_amdgcn_mfma_f32_32x32x16_bf16(b0, qr[d0], p0, 0, 0, 0);
        p1 = __builtin_amdgcn_mfma_f32_32x32x16_bf16(b1, qr[d0], p1, 0, 0, 0); }
}
__device__ __forceinline__ int v_st(int k, int c) { const int kk = (k & ~0xC) | ((k & 4) << 1) | ((k & 8) >> 1); return ((kk >> 3) * 4 + (c >> 5)) * 512 + ((kk & 7) * 32 + (c & 31)) * 2; }
__device__ __forceinline__ int v_rd_base(int lane) { return ((lane & 3) << 3) | (((lane >> 2) & 3) << 6) | (((lane >> 4) & 1) << 5) | (((lane >> 5) & 1) << 8); }
constexpr int v_rd_off(int d0, int ks, int half) { return d0 * 512 + ks * 4096 + half * 2048; }
template <int OFF> __device__ __forceinline__ s16x4 tr_read(int vb) {
    s16x4 r; asm volatile("ds_read_b64_tr_b16 %0, %1 offset:%2" : "=&v"(r) : "v"(vb), "i"(OFF) : "memory"); return r;
}
template <int D0> __device__ __forceinline__ void pv_one(f32x16& od, int vb, bf16x8 pa0, bf16x8 pa1, bf16x8 pa2, bf16x8 pa3) {
    const s16x4 l0 = tr_read<v_rd_off(D0, 0, 0)>(vb), h0 = tr_read<v_rd_off(D0, 0, 1)>(vb), l1 = tr_read<v_rd_off(D0, 1, 0)>(vb), h1 = tr_read<v_rd_off(D0, 1, 1)>(vb);
    const s16x4 l2 = tr_read<v_rd_off(D0, 2, 0)>(vb), h2 = tr_read<v_rd_off(D0, 2, 1)>(vb), l3 = tr_read<v_rd_off(D0, 3, 0)>(vb), h3 = tr_read<v_rd_off(D0, 3, 1)>(vb);
    asm volatile("s_waitcnt lgkmcnt(0)" ::: "memory"); SBAR();
#define PK(L, H) (bf16x8){L[0], L[1], L[2], L[3], H[0], H[1], H[2], H[3]}
    od = __builtin_amdgcn_mfma_f32_32x32x16_bf16(pa0, PK(l0, h0), od, 0, 0, 0);
    od = __builtin_amdgcn_mfma_f32_32x32x16_bf16(pa1, PK(l1, h1), od, 0, 0, 0);
    od = __builtin_amdgcn_mfma_f32_32x32x16_bf16(pa2, PK(l2, h2), od, 0, 0, 0);
    od = __builtin_amdgcn_mfma_f32_32x32x16_bf16(pa3, PK(l3, h3), od, 0, 0, 0);
#undef PK
}
template <int DN>
__device__ __forceinline__ void pv_sm(f32x16* o, int vb, bf16x8 pa0, bf16x8 pa1, bf16x8 pa2, bf16x8 pa3, f32x16& p0, f32x16& p1, float& m_reg, float& mn, float& alpha) {
    float pmax;
    pv_one<0>(o[0], vb, pa0, pa1, pa2, pa3); psm1(p0, pmax);
    pv_one<1>(o[1], vb, pa0, pa1, pa2, pa3); psm2<DN>(p1, pmax, m_reg, mn, alpha);
    pv_one<2>(o[2], vb, pa0, pa1, pa2, pa3); psm3<DN>(p0, p1, mn);
    pv_one<3>(o[3], vb, pa0, pa1, pa2, pa3); psm4(p0);
}
__device__ __forceinline__ void pv_d0(f32x16* o, int vb, bf16x8 pa0, bf16x8 pa1, bf16x8 pa2, bf16x8 pa3) {
    pv_one<0>(o[0], vb, pa0, pa1, pa2, pa3); pv_one<1>(o[1], vb, pa0, pa1, pa2, pa3); pv_one<2>(o[2], vb, pa0, pa1, pa2, pa3); pv_one<3>(o[3], vb, pa0, pa1, pa2, pa3);
}
template <int DN, int LDQ, int LDKN, int LDKR, int LDV, int LDO, int SDEPTH>
__device__ __forceinline__ void attn_unit(const bf16_t* __restrict__ Qn, const bf16_t* __restrict__ Qr, const bf16_t* __restrict__ Kng, const bf16_t* __restrict__ Krg,
                                          const bf16_t* __restrict__ Vg, bf16_t* __restrict__ Ob, const int q0, const int kx0, const int ky0, const int ntx, const int NT, char* lds, unsigned char* __restrict__ O8 = nullptr) {
    const int tid = opaque_tid(), wid = tid >> 6, lane = tid & 63, r32 = lane & 31, hi = lane >> 5;
    char* V_lds = lds + OFF_V; char* KR_lds = lds + OFF_KR; char* KN_lds = lds + OFF_KN;
    float* ws = (float*)(lds + OFF_WS) + wid * 64; float* li_l = ws; float* al_l = ws + 32;
    float m_reg = -1e30f, l_reg = 0; f32x16 o[4] = {}; bf16x8 qn[DN ? DN / 16 : 1], qr[4];
    { const size_t qrow = (size_t)(q0 + wid * QBLK + r32);
      if constexpr (DN > 0) {
#pragma unroll
          for (int d0 = 0; d0 < DN / 16; ++d0) qn[d0] = *reinterpret_cast<const bf16x8*>(Qn + qrow * LDQ + hi * 8 + d0 * 16);
      }
#pragma unroll
      for (int d0 = 0; d0 < 4; ++d0) qr[d0] = *reinterpret_cast<const bf16x8*>(Qr + qrow * LDQ + hi * 8 + d0 * 16); }
    const int sr = tid >> 4, sc = (tid & 15) * 8, vst0 = v_st(sr, sc), vst1 = v_st(32 + sr, sc);
    const int rr_ = tid >> 3, rc_ = (tid & 7) * 8;
    const int vb0 = (int)(uintptr_t)V_lds + v_rd_base(lane);
    const int kb_ = KSLAB(r32, hi * 8);
#define KROW(j) __builtin_amdgcn_readfirstlane((j) < ntx ? kx0 + (j) * KVBLK : ky0 + ((j) - ntx) * KVBLK)
    const int wv_ = __builtin_amdgcn_readfirstlane(tid >> 6);
    unsigned ogV[2], ogN[2], ogR;
#pragma unroll
    for (int i = 0; i < 2; ++i) { const int b = tid * 16 + i * 8192;
        { const int sub = b >> 9, within = b & 511, kk = (sub >> 2) * 8 + (within >> 6), k = (kk & ~0xC) | ((kk & 4) << 1) | ((kk & 8) >> 1), c = (sub & 3) * 32 + ((within & 63) >> 1); ogV[i] = (unsigned)(k * LDV + c) * 2u; }
        { const int d0 = b >> 11, rem = b & 2047, row = rem >> 5, half = ((rem >> 4) & 1) ^ ((row >> 3) & 1); ogN[i] = (unsigned)(row * LDKN + d0 * 16 + half * 8) * 2u; } }
    { const int b = tid * 16, d0 = b >> 11, rem = b & 2047, row = rem >> 5, half = ((rem >> 4) & 1) ^ ((row >> 3) & 1); ogR = (unsigned)(row * LDKR + d0 * 16 + half * 8) * 2u; }
    LAS char* const V3 = (LAS char*)V_lds; LAS char* const KR3 = (LAS char*)KR_lds; LAS char* const KN3 = (LAS char*)KN_lds;
#define DMA16(gp, lp) __builtin_amdgcn_global_load_lds((const unsigned*)(gp), (LAS unsigned*)(lp), 16, 0, 0)
#define SDMA(j, b) do { const size_t k0_ = (size_t)KROW(j); const char* vb_ = (const char*)(Vg + k0_ * LDV); const char* rb_ = (const char*)(Krg + k0_ * LDKR); \
    DMA16(vb_ + ogV[0], V3 + (b) * SHM_V + wv_ * 1024); DMA16(vb_ + ogV[1], V3 + (b) * SHM_V + wv_ * 1024 + 8192); \
    if constexpr (DN > 0) { const char* nb_ = (const char*)(Kng + k0_ * LDKN); DMA16(nb_ + ogN[0], KN3 + (b) * SHM_KN + wv_ * 1024); DMA16(nb_ + ogN[1], KN3 + (b) * SHM_KN + wv_ * 1024 + 8192); } \
    DMA16(rb_ + ogR, KR3 + (b) * SHM_KR + wv_ * 1024); } while (0)
#define DMAWAIT() asm volatile("s_waitcnt vmcnt(0)" ::: "memory")
#define RESC(a) do { if (__any((a) < 1.f)) { if (hi == 0) al_l[r32] = (a); asm volatile("s_waitcnt lgkmcnt(0)" ::: "memory"); \
    _Pragma("unroll") for (int d = 0; d < 4; ++d) _Pragma("unroll") for (int r = 0; r < 16; ++r) o[d][r] *= al_l[crow(r, hi)]; } } while (0)
    f32x16 pA0, pA1, pB0, pB1; float mnA, mnB, alA, alB; bf16x8 pa0, pa1, pa2, pa3;
    SDMA(0, 0); SDMA(1, 1); if (2 < NT) SDMA(2, 2); DMAWAIT(); __syncthreads();
    qkt<DN>(pA0, pA1, (const LAS char*)KN3, (const LAS char*)KR3, qn, qr, kb_); partialSM<DN>(pA0, pA1, m_reg, mnA, alA);
    int bK = 1, bV = 0;
#define TRIP(C0, C1, MNC, ALC, P0, P1, ALP, j) do { \
        SBAR(); qkt<DN>(C0, C1, (const LAS char*)(KN3 + bK * SHM_KN), (const LAS char*)(KR3 + bK * SHM_KR), qn, qr, kb_); \
        finishSM(P0, P1, ALP, l_reg, pa0, pa1, pa2, pa3); SBAR(); \
        pv_sm<DN>(o, vb0 + bV * SHM_V, pa0, pa1, pa2, pa3, C0, C1, m_reg, MNC, ALC); \
        RESC(ALC); \
        DMAWAIT(); __syncthreads(); \
        if ((j) + 2 < NT) SDMA((j) + 2, bV); \
        bV = bK; bK = (bK == 2) ? 0 : bK + 1; } while (0)
    for (int j = 1; j + 1 < NT; j += 2) {
        TRIP(pB0, pB1, mnB, alB, pA0, pA1, alA, j);
        TRIP(pA0, pA1, mnA, alA, pB0, pB1, alB, j + 1);
    }
    SBAR(); qkt<DN>(pB0, pB1, (const LAS char*)(KN3 + bK * SHM_KN), (const LAS char*)(KR3 + bK * SHM_KR), qn, qr, kb_);
    finishSM(pA0, pA1, alA, l_reg, pa0, pa1, pa2, pa3); SBAR();
    pv_sm<DN>(o, vb0 + bV * SHM_V, pa0, pa1, pa2, pa3, pB0, pB1, m_reg, mnB, alB);
    RESC(alB);
    finishSM(pB0, pB1, alB, l_reg, pa0, pa1, pa2, pa3); SBAR();
    pv_d0(o, vb0 + bK * SHM_V, pa0, pa1, pa2, pa3);
#undef TRIP
    if (hi == 0) li_l[r32] = l_reg; asm volatile("s_waitcnt lgkmcnt(0)" ::: "memory");
    const int tz = opaque_tid(), wid2 = tz >> 6, r32b = tz & 31, hib = (tz >> 5) & 1;
    const float* li2 = (const float*)(lds + OFF_WS) + wid2 * 64;
    float rli[16];
#pragma unroll
    for (int r = 0; r < 16; ++r) rli[r] = __builtin_amdgcn_rcpf(li2[crow(r, hib)]);
    if (O8) {
        unsigned char* Ow8 = O8 + (size_t)(q0 + wid2 * QBLK) * 512;
#pragma unroll
        for (int r = 0; r < 16; ++r) { const int orow = crow(r, hib);
#pragma unroll
            for (int d0 = 0; d0 < 4; ++d0) { const float v_ = fminf(fmaxf(o[d0][r] * rli[r] * 8.0f, -448.0f), 448.0f);
                const int w = __builtin_amdgcn_cvt_pk_fp8_f32(v_, 0.f, 0, false); Ow8[(size_t)orow * 512 + d0 * 32 + r32b] = (unsigned char)(w & 0xff); } }
    } else {
    bf16_t* Ow = Ob + (size_t)(q0 + wid2 * QBLK) * LDO;
#pragma unroll
    for (int r = 0; r < 16; ++r) { const int orow = crow(r, hib);
#pragma unroll
        for (int d0 = 0; d0 < 4; ++d0) { const unsigned w = cvt_pk_bf16(o[d0][r] * rli[r], 0.f); Ow[(size_t)orow * LDO + d0 * 32 + r32b] = (bf16_t)(w & 0xffffu); } }
    }
    __syncthreads();
#undef KROW
#undef SDMA
#undef DMA16
#undef DMAWAIT
#undef RESC
}
}

struct Params { const float* in[28]; float* out; unsigned char* ws; int ph_lo, ph_hi; };
struct Ctx { LAS unsigned char* lds; char* ldsg; int tid, lane, wave, vcu, G; GAS unsigned char* ws; };
enum { I_X = 0, I_C, I_CTX, I_CCTX, I_ADAW, I_ADAB, I_N1G, I_N2G, I_WIN, I_LQ1, I_LK1, I_LQ2, I_LK2, I_SUBLN, I_QAG, I_KVAG, I_WQB, I_WKVB, I_WBRA, I_WBRB, I_WOUT, I_RW, I_RB, I_WGU, I_BGU, I_WDN, I_BDN, I_FG };
template <typename T> __device__ __forceinline__ T* wsp(const Ctx& C, size_t off) { return (T*)(GAS T*)(C.ws + off); }
constexpr int PTRTAB_OFF = MISC_OFF + 3072;
__device__ __forceinline__ const float* inp(const Ctx& C, int i) {
    const unsigned long long v = ((volatile LAS unsigned long long*)(C.lds + PTRTAB_OFF))[i];
    const unsigned lo = __builtin_amdgcn_readfirstlane((unsigned)v), hi = __builtin_amdgcn_readfirstlane((unsigned)(v >> 32));
    return (const float*)(GAS const float*)(((unsigned long long)hi << 32) | lo);
}

__device__ __forceinline__ void p0_transpose_item(const float* W, int K, int N, bf16_t* WT, int k0, int n0d, int n0s, const float* gain, LAS float* scr, int lane) {
    float w_[32];
#pragma unroll
    for (int i = 0; i < 32; ++i) { const int kk = 2 * i + (lane >> 5); w_[i] = (n0s >= 0) ? __builtin_nontemporal_load(W + (size_t)(k0 + kk) * N + n0s + (lane & 31)) : 0.f; }
    if (gain) {
#pragma unroll
        for (int i = 0; i < 32; ++i) w_[i] *= gain[k0 + 2 * i + (lane >> 5)]; }
#pragma unroll
    for (int i = 0; i < 32; ++i) scr[(2 * i + (lane >> 5)) * 33 + (lane & 31)] = w_[i];
    LDS_WAIT(); asm volatile("" ::: "memory");
    const int c = lane & 7;
#pragma unroll
    for (int j = 0; j < 4; ++j) { const int n = (lane >> 3) + 8 * j; const LAS float* s = scr + (8 * c) * 33 + n;
        u32x4 o; o.x = cvt_pk_bf16(s[0 * 33], s[1 * 33]); o.y = cvt_pk_bf16(s[2 * 33], s[3 * 33]); o.z = cvt_pk_bf16(s[4 * 33], s[5 * 33]); o.w = cvt_pk_bf16(s[6 * 33], s[7 * 33]);
        __builtin_nontemporal_store(o, (u32x4*)(WT + (size_t)(n0d + n) * K + k0 + 8 * c)); }
    LDS_WAIT(); asm volatile("" ::: "memory");
}
__device__ __forceinline__ void p0_transpose_item_f8(const float* W, int K, int N, unsigned char* WT, int k0, int n0d, int n0s, LAS float* scr, int lane) {
    float w_[32];
#pragma unroll
    for (int i = 0; i < 32; ++i) { const int kk = 2 * i + (lane >> 5); w_[i] = __builtin_nontemporal_load(W + (size_t)(k0 + kk) * N + n0s + (lane & 31)); }
#pragma unroll
    for (int i = 0; i < 32; ++i) scr[(2 * i + (lane >> 5)) * 33 + (lane & 31)] = w_[i] * 64.0f;
    LDS_WAIT(); asm volatile("" ::: "memory");
    const int c = lane & 7;
#pragma unroll
    for (int j = 0; j < 4; ++j) { const int n = (lane >> 3) + 8 * j; const LAS float* s = scr + (8 * c) * 33 + n;
        int w0 = __builtin_amdgcn_cvt_pk_fp8_f32(s[0 * 33], s[1 * 33], 0, false); w0 = __builtin_amdgcn_cvt_pk_fp8_f32(s[2 * 33], s[3 * 33], w0, true);
        int w1 = __builtin_amdgcn_cvt_pk_fp8_f32(s[4 * 33], s[5 * 33], 0, false); w1 = __builtin_amdgcn_cvt_pk_fp8_f32(s[6 * 33], s[7 * 33], w1, true);
        __builtin_nontemporal_store((u32x2){(unsigned)w0, (unsigned)w1}, (u32x2*)(WT + (size_t)(n0d + n) * K + k0 + 8 * c)); }
    LDS_WAIT(); asm volatile("" ::: "memory");
}
__device__ __forceinline__ int win_src_col(int n) {
    if (n < 1536) return n; if (n < 3584) return 2240 + (n - 1536); if (n < 3968) return 1536 + (n - 3584);
    if (n < 4032) return 2176 + (n - 3968); if (n < 4096) return -1; return 1920 + (n - 4096);
}
constexpr int I_IN_ = 16 * (NIN / 32), I_QB_ = 6 * 24, I_KVB_ = 4 * 32, I_BR_ = 8 * 32, I_OUT_ = 16 * 32, I_GU_ = 32 * 16 * 32, I_DN_ = 32 * 8 * 32;
constexpr int PER_L = I_IN_ + I_QB_ + I_KVB_ + 2 * I_BR_ + I_OUT_ + I_GU_ + I_DN_;
constexpr int PER_L_DENSE = I_IN_ + I_QB_ + I_KVB_;
__device__ __forceinline__ void p0_item(const Ctx& C, const int l, int r, LAS float* scr) {
    if (r < I_IN_) { const int nb = r % (NIN / 32), kb = r / (NIN / 32);
        if (nb >= 32 && nb < 112) p0_transpose_item_f8(inp(C, I_WIN) + (size_t)l * 1024 * 4288, 1024, 4288, wsp<unsigned char>(C, WS_WING8) + (size_t)l * 2560 * 1024, kb * 64, nb * 32 - 1024, win_src_col(nb * 32), scr, C.lane);
        else p0_transpose_item(inp(C, I_WIN) + (size_t)l * 1024 * 4288, 1024, 4288, wsp<bf16_t>(C, WS_WIN) + (size_t)l * NIN * 1024, kb * 64, nb * 32, win_src_col(nb * 32), nullptr, scr, C.lane);
        return; } r -= I_IN_;
    if (r < I_QB_) { const int nb = r % 24, kb = r / 24;
        p0_transpose_item(inp(C, I_WQB) + (size_t)l * 384 * 768, 384, 768, wsp<bf16_t>(C, WS_WQB) + (size_t)l * 768 * 384, kb * 64, nb * 32, nb * 32, inp(C, I_QAG) + l * 384, scr, C.lane); return; } r -= I_QB_;
    if (r < I_KVB_) { const int nb = r % 32, kb = r / 32;
        p0_transpose_item(inp(C, I_WKVB) + (size_t)l * 256 * 1024, 256, 1024, wsp<bf16_t>(C, WS_WKVB) + (size_t)l * 1024 * 256, kb * 64, nb * 32, nb * 32, inp(C, I_KVAG) + l * 256, scr, C.lane); return; } r -= I_KVB_;
    if (r < I_BR_) { const int nb = r % 32, kb = r / 32;
        p0_transpose_item(inp(C, I_WBRA) + (size_t)l * 512 * 1024, 512, 1024, wsp<bf16_t>(C, WS_WBRA) + (size_t)l * 1024 * 512, kb * 64, nb * 32, nb * 32, nullptr, scr, C.lane);
        p0_transpose_item_f8(inp(C, I_WBRA) + (size_t)l * 512 * 1024, 512, 1024, wsp<unsigned char>(C, WS_WBR8) + (size_t)(l * 2) * 1024 * 512, kb * 64, nb * 32, nb * 32, scr, C.lane); return; } r -= I_BR_;
    if (r < I_BR_) { const int nb = r % 32, kb = r / 32;
        p0_transpose_item(inp(C, I_WBRB) + (size_t)l * 512 * 1024, 512, 1024, wsp<bf16_t>(C, WS_WBRB) + (size_t)l * 1024 * 512, kb * 64, nb * 32, nb * 32, nullptr, scr, C.lane);
        p0_transpose_item_f8(inp(C, I_WBRB) + (size_t)l * 512 * 1024, 512, 1024, wsp<unsigned char>(C, WS_WBR8) + (size_t)(l * 2 + 1) * 1024 * 512, kb * 64, nb * 32, nb * 32, scr, C.lane); return; } r -= I_BR_;
    if (r < I_OUT_) { const int nb = r % 32, kb = r / 32;
        p0_transpose_item(inp(C, I_WOUT) + (size_t)l * 1024 * 1024, 1024, 1024, wsp<bf16_t>(C, WS_WOUT) + (size_t)l * 1024 * 1024, kb * 64, nb * 32, nb * 32, nullptr, scr, C.lane);
        p0_transpose_item_f8(inp(C, I_WOUT) + (size_t)l * 1024 * 1024, 1024, 1024, wsp<unsigned char>(C, WS_WOUT8) + (size_t)l * 1024 * 1024, kb * 64, nb * 32, nb * 32, scr, C.lane); return; } r -= I_OUT_;
    if (r < I_GU_) { const int e = r / 512, q = r % 512, nb = q % 32, kb = q / 32; const int n0 = nb * 32;
        const int src = 512 * ((n0 >> 7) & 1) + 128 * (n0 >> 8) + (n0 & 127);
        p0_transpose_item_f8(inp(C, I_WGU) + ((size_t)l * 32 + e) * 1024 * 1024, 1024, 1024, wsp<unsigned char>(C, WS_WGU) + ((size_t)l * 32 + e) * 1024 * 1024, kb * 64, n0, src, scr, C.lane); return; } r -= I_GU_;
    { const int e = r / 256, q = r % 256, nb = q % 32, kb = q / 32;
        p0_transpose_item_f8(inp(C, I_WDN) + ((size_t)l * 32 + e) * 512 * 1024, 512, 1024, wsp<unsigned char>(C, WS_WDN) + ((size_t)l * 32 + e) * 1024 * 512, kb * 64, nb * 32, nb * 32, scr, C.lane); }
}
__device__ __forceinline__ void convert_layer_share(const Ctx& C0, const int l, const int r_lo, const int r_hi, const int n_next) {
    Ctx C = C0; { const int t_ = opaque_tid(); C.tid = t_; C.lane = t_ & 63; C.wave = __builtin_amdgcn_readfirstlane(t_ >> 6); asm volatile("" : "+s"(C.ws)); asm volatile("" : "+s"(C.vcu)); asm volatile("" : "+s"(C.G)); }
    LAS float* scr = (LAS float*)(C.lds + C.wave * 8448);
    const int gw = C.vcu * 8 + C.wave, NGW = C.G * 8;
    const int n0 = r_hi - r_lo;
    for (int j = gw; j < n0 + n_next; j += NGW) { const bool nx = j >= n0; p0_item(C, nx ? l + 1 : l, nx ? j - n0 : r_lo + j, scr); }
    __syncthreads();
}
__device__ __forceinline__ void phase_prologue(const Params& P, const Ctx& C0) {
    Ctx C = C0; { const int t_ = opaque_tid(); C.tid = t_; C.lane = t_ & 63; C.wave = __builtin_amdgcn_readfirstlane(t_ >> 6); asm volatile("" : "+s"(C.ws)); asm volatile("" : "+s"(C.vcu)); asm volatile("" : "+s"(C.G)); }
    convert_layer_share(C, 0, 0, PER_L_DENSE, 0);
    { int* idl = wsp<int>(C, WS_IDLIST); for (int i = C.vcu * 512 + C.tid; i < PMAX; i += C.G * 512) idl[i] = i; }
    { float* rwt = wsp<float>(C, WS_RWT); const float* rw = inp(C, I_RW);
      for (int i = C.vcu * 512 + C.tid; i < DEPTH * 32 * 1024; i += C.G * 512) { const int l = i >> 15, e = (i >> 10) & 31, d = i & 1023; rwt[i] = rw[((size_t)l * 1024 + d) * 32 + e]; }
      { bf16_t* rwb = wsp<bf16_t>(C, WS_RWT) + (size_t)DEPTH * 32 * 1024 * 2;
        for (int i = C.vcu * 512 + C.tid; i < DEPTH * 32 * 1024; i += C.G * 512) { const int l = i >> 15, e = (i >> 10) & 31, d = i & 1023; rwb[i] = (bf16_t)(cvt_pk_bf16(rw[((size_t)l * 1024 + d) * 32 + e], 0.f) & 0xffffu); } }
 }
    __syncthreads();
    { LAS float* s = (LAS float*)(C.lds + 69632); LAS float* red = (LAS float*)(C.lds + 106496);
      const float* const cc = inp(C, I_C); const float* const cx = inp(C, I_CCTX);
      for (int i = C.tid; i < 9 * 1024; i += 512) { const float v = i < 8192 ? cc[i] : cx[i - 8192]; s[i] = v / (1.0f + __expf(-v)); }
      __syncthreads();
      const int cl = C.tid & 31, kg = C.tid >> 5; float* MOD = wsp<float>(C, WS_MOD); const float* const adaw = inp(C, I_ADAW); const float* const adab = inp(C, I_ADAB);
      for (int blk = C.vcu; blk < DEPTH * 192; blk += C.G) { const int l = blk / 192, col = (blk % 192) * 32 + cl;
          const float* w = adaw + (size_t)l * 1024 * 6144 + col; float a[9];
#pragma unroll
          for (int r = 0; r < 9; ++r) a[r] = 0.f;
          float wv_[64];
#pragma unroll
          for (int kk = 0; kk < 64; ++kk) wv_[kk] = w[(size_t)(kg * 64 + kk) * 6144];
#pragma unroll
          for (int kk = 0; kk < 64; ++kk) { const int k = kg * 64 + kk; const float wv = wv_[kk];
#pragma unroll
              for (int r = 0; r < 9; ++r) a[r] += s[r * 1024 + k] * wv; }
#pragma unroll
          for (int r = 0; r < 9; ++r) red[(kg * 32 + cl) * 9 + r] = a[r];
          __syncthreads();
          if (C.tid < 288) { const int c2 = C.tid & 31, r = C.tid >> 5; float t = 0.f;
              for (int g = 0; g < 16; ++g) t += red[(g * 32 + c2) * 9 + r];
              const int col2 = (blk % 192) * 32 + c2; MOD[((size_t)l * 9 + r) * 6144 + col2] = t + adab[(size_t)l * 6144 + col2]; }
          __syncthreads(); } }
}

struct RowPipe { unsigned y[16]; f32x4 v[4]; u32x2 xb[4]; f32x4 wt; };
template <bool FINAL, bool FIRST>
__device__ __forceinline__ void phase_rows(const Params& P, const Ctx& C0, const int l) {
    Ctx C = C0; { const int t_ = opaque_tid(); C.tid = t_; C.lane = t_ & 63; C.wave = __builtin_amdgcn_readfirstlane(t_ >> 6); asm volatile("" : "+s"(C.ws)); asm volatile("" : "+s"(C.vcu)); asm volatile("" : "+s"(C.G)); }
    const int gw = C.vcu * 8 + C.wave, NGW = C.G * 8, MR = FINAL ? MX : MT;
    const float* MOD = wsp<float>(C, WS_MOD); bf16_t* XS = wsp<bf16_t>(C, WS_XS); bf16_t* H = wsp<bf16_t>(C, WS_H);
    const u32x4* YD = wsp<u32x4>(C, WS_YDEST); const f32x4* WT = wsp<f32x4>(C, WS_WTS); const unsigned char* Y = wsp<unsigned char>(C, WS_Y);
    const float* ng = FINAL ? inp(C, I_FG) : inp(C, I_N1G) + l * 1024; const float* const xin = inp(C, I_X); const float* const cin = inp(C, I_CTX); float* const outp = (float*)inp(C, 28);
    constexpr bool comb = !FIRST;
    f32x4 gv[4];
#pragma unroll
    for (int j = 0; j < 4; ++j) gv[j] = ((const f32x4*)ng)[C.lane + 64 * j];
    RowPipe cur, nxt; u32x4 ydn = (u32x4){0u, 0u, 0u, 0u}; f32x4 wtn = (f32x4){0.f, 0.f, 0.f, 0.f};
#define ROW_LOAD(R, m, yd) do { if constexpr (FIRST) { const float* s_ = (m) < MX ? xin + (size_t)(m) * 1024 : cin + (size_t)((m) - MX) * 1024; _Pragma("unroll") for (int j = 0; j < 4; ++j) R.v[j] = ((const f32x4*)s_)[C.lane + 64 * j]; } \
        else { const u32x2* s_ = (const u32x2*)(XS + (size_t)(m) * 1024); _Pragma("unroll") for (int j = 0; j < 4; ++j) R.xb[j] = s_[C.lane + 64 * j]; } \
        if (comb) { const unsigned d_[4] = {yd.x, yd.y, yd.z, yd.w}; _Pragma("unroll") for (int k = 0; k < 4; ++k) { const unsigned* yr = (const unsigned*)(Y + (size_t)d_[k] * 1024); \
            _Pragma("unroll") for (int j = 0; j < 4; ++j) R.y[k * 4 + j] = yr[C.lane + 64 * j]; } } } while (0)
    int m = gw;
    if (m < MR) { if (comb) { ydn = YD[m]; wtn = WT[m]; } cur.wt = wtn; ROW_LOAD(cur, m, ydn); if (comb && m + NGW < MR) { ydn = YD[m + NGW]; wtn = WT[m + NGW]; } }
    for (; m < MR; m += NGW) {
        const int mn = m + NGW;
        if (mn < MR) { nxt.wt = wtn; ROW_LOAD(nxt, mn, ydn); if (comb && mn + NGW < MR) { ydn = YD[mn + NGW]; wtn = WT[mn + NGW]; } }
        const int bidx = m < MX ? (m >> 12) : 8;
        f32x4 v[4];
#pragma unroll
        for (int j = 0; j < 4; ++j) { if constexpr (FIRST) v[j] = cur.v[j]; else v[j] = (f32x4){bf_lo(cur.xb[j].x), bf_hi(cur.xb[j].x), bf_lo(cur.xb[j].y), bf_hi(cur.xb[j].y)}; }
        if (comb) {
            const float w_[4] = {cur.wt.x * 0.125f, cur.wt.y * 0.125f, cur.wt.z * 0.125f, cur.wt.w * 0.125f};
            const float* g2 = MOD + ((size_t)(FINAL ? DEPTH - 1 : l - 1) * 9 + bidx) * 6144 + 5 * 1024;
#pragma unroll
            for (int j = 0; j < 4; ++j) { f32x4 f = (f32x4){0.f, 0.f, 0.f, 0.f};
#pragma unroll
                for (int k = 0; k < 4; ++k) { const int y = (int)cur.y[k * 4 + j]; const f32x2_t ylo = __builtin_amdgcn_cvt_pk_f32_fp8(y, false), yhi = __builtin_amdgcn_cvt_pk_f32_fp8(y, true); f += w_[k] * (f32x4){ylo.x, ylo.y, yhi.x, yhi.y}; }
                v[j] += ((const f32x4*)g2)[C.lane + 64 * j] * f;
                if (!FINAL) { u32x2 w; w.x = cvt_pk_bf16(v[j].x, v[j].y); w.y = cvt_pk_bf16(v[j].z, v[j].w); ((u32x2*)(XS + (size_t)m * 1024))[C.lane + 64 * j] = w; } }
        }
        float ss = 0.f;
#pragma unroll
        for (int j = 0; j < 4; ++j) ss += (v[j].x * v[j].x + v[j].y * v[j].y) + (v[j].z * v[j].z + v[j].w * v[j].w);
        const float rstd = rsqrtf(wave_sum(ss, C.lane) * (1.0f / 1024.0f) + EPS);
        if (FINAL) {
#pragma unroll
            for (int j = 0; j < 4; ++j) ((f32x4*)(outp + (size_t)m * 1024))[C.lane + 64 * j] = v[j] * rstd * gv[j];
        } else {
            const float* sh = MOD + ((size_t)l * 9 + bidx) * 6144; const float* sc = sh + 1024;
            u32x2* o8 = (u32x2*)(H + (size_t)m * 1024); unsigned* q8 = (unsigned*)(wsp<unsigned char>(C, WS_H8) + (size_t)m * 1024);
#pragma unroll
            for (int j = 0; j < 4; ++j) { const f32x4 s1 = ((const f32x4*)sc)[C.lane + 64 * j], s0 = ((const f32x4*)sh)[C.lane + 64 * j];
                const f32x4 h = v[j] * rstd * gv[j] * (1.0f + s1) + s0; u32x2 w; w.x = cvt_pk_bf16(h.x, h.y); w.y = cvt_pk_bf16(h.z, h.w); o8[C.lane + 64 * j] = w;
                const f32x4 hc = (f32x4){fminf(fmaxf(h.x, -448.0f), 448.0f), fminf(fmaxf(h.y, -448.0f), 448.0f), fminf(fmaxf(h.z, -448.0f), 448.0f), fminf(fmaxf(h.w, -448.0f), 448.0f)};
                int f = __builtin_amdgcn_cvt_pk_fp8_f32(hc.x, hc.y, 0, false); f = __builtin_amdgcn_cvt_pk_fp8_f32(hc.z, hc.w, f, true); q8[C.lane + 64 * j] = (unsigned)f; }
        }
        if (mn < MR) { cur = nxt; }
    }
#undef ROW_LOAD
}
__device__ __forceinline__ void phase_mod1(const Params& P, const Ctx& C0, const int l) { if (l == 0) phase_rows<false, true>(P, C0, l); else phase_rows<false, false>(P, C0, l); }
__device__ __forceinline__ void phase_final(const Params& P, const Ctx& C0) { phase_rows<true, false>(P, C0, DEPTH - 1); }
__device__ __forceinline__ void phase_damerge(const Params& P, const Ctx& C0, const int l, const int Ml) {
    Ctx C = C0; { const int t_ = opaque_tid(); C.tid = t_; C.lane = t_ & 63; C.wave = __builtin_amdgcn_readfirstlane(t_ >> 6); asm volatile("" : "+s"(C.ws)); asm volatile("" : "+s"(C.vcu)); asm volatile("" : "+s"(C.G)); }
    const int gw = C.vcu * 8 + C.wave, NGW = C.G * 8;
    const float lam_init = 0.8f - 0.6f * expf(-0.3f * (float)l);
    const float d1 = wave_sum(inp(C, I_LQ1)[l * 64 + C.lane] * inp(C, I_LK1)[l * 64 + C.lane], C.lane), d2 = wave_sum(inp(C, I_LQ2)[l * 64 + C.lane] * inp(C, I_LK2)[l * 64 + C.lane], C.lane);
    const float lam = expf(d1) - expf(d2) + lam_init;
    const int h = C.lane >> 4, c = C.lane & 15;
    float gq[8];
    { const float* sg = inp(C, I_SUBLN) + l * 128 + c * 8;
#pragma unroll
      for (int i = 0; i < 8; ++i) gq[i] = sg[i] * (1.0f - lam_init); }
    const bf16_t* ODA = wsp<bf16_t>(C, WS_ODA); bf16_t* ODAN = wsp<bf16_t>(C, WS_ODAN); unsigned char* OB8 = wsp<unsigned char>(C, WS_OB8);
    for (int m0 = gw; m0 < Ml; m0 += 4 * NGW) {
        u32x4 a[4], b[4];
#pragma unroll
        for (int r = 0; r < 4; ++r) { const int m = m0 + r * NGW; if (m < Ml) { a[r] = *(const u32x4*)(ODA + (size_t)m * 1024 + h * 256 + c * 8); b[r] = *(const u32x4*)(ODA + (size_t)m * 1024 + h * 256 + 128 + c * 8); } }
#pragma unroll
        for (int r = 0; r < 4; ++r) { const int m = m0 + r * NGW; if (m < Ml) {
            const unsigned aw[4] = {a[r].x, a[r].y, a[r].z, a[r].w}, bw[4] = {b[r].x, b[r].y, b[r].z, b[r].w}; float o[8]; float ss = 0.f;
#pragma unroll
            for (int i = 0; i < 4; ++i) { o[2 * i] = bf_lo(aw[i]) - lam * bf_lo(bw[i]); o[2 * i + 1] = bf_hi(aw[i]) - lam * bf_hi(bw[i]); ss += o[2 * i] * o[2 * i] + o[2 * i + 1] * o[2 * i + 1]; }
            ss += shx(ss, 1, C.lane); ss += shx(ss, 2, C.lane); ss += shx(ss, 4, C.lane); ss += shx(ss, 8, C.lane);
            const float rr = rsqrtf(ss * (1.0f / 128.0f) + EPS);
            if (m >= MX) {
            u32x4 w; w.x = cvt_pk_bf16(o[0] * rr * gq[0], o[1] * rr * gq[1]); w.y = cvt_pk_bf16(o[2] * rr * gq[2], o[3] * rr * gq[3]);
            w.z = cvt_pk_bf16(o[4] * rr * gq[4], o[5] * rr * gq[5]); w.w = cvt_pk_bf16(o[6] * rr * gq[6], o[7] * rr * gq[7]);
            *(u32x4*)(ODAN + (size_t)m * 512 + h * 128 + c * 8) = w;
            } else {
            float q_[8];
#pragma unroll
            for (int i = 0; i < 8; ++i) q_[i] = fminf(fmaxf(o[i] * rr * gq[i] * 8.0f, -448.0f), 448.0f);
            int w0 = __builtin_amdgcn_cvt_pk_fp8_f32(q_[0], q_[1], 0, false); w0 = __builtin_amdgcn_cvt_pk_fp8_f32(q_[2], q_[3], w0, true);
            int w1 = __builtin_amdgcn_cvt_pk_fp8_f32(q_[4], q_[5], 0, false); w1 = __builtin_amdgcn_cvt_pk_fp8_f32(q_[6], q_[7], w1, true);
            *(u32x2*)(OB8 + (size_t)m * 512 + C.lane * 8) = (u32x2){(unsigned)w0, (unsigned)w1};
            }
            } }
    }
}
__device__ __forceinline__ void phase_mod2_router(const Params& P, const Ctx& C0, const int l, const int Ml) {
    Ctx C = C0; { const int t_ = opaque_tid(); C.tid = t_; C.lane = t_ & 63; C.wave = __builtin_amdgcn_readfirstlane(t_ >> 6); asm volatile("" : "+s"(C.ws)); asm volatile("" : "+s"(C.vcu)); asm volatile("" : "+s"(C.G)); }
    LAS int* hist = (LAS int*)(C.lds + MISC_OFF + 256);
    if (C.tid < 32) hist[C.tid] = 0;
    const float* MOD = wsp<float>(C, WS_MOD); const bf16_t* XS = wsp<bf16_t>(C, WS_XS);
    int* TOPE = wsp<int>(C, WS_TOPE); float* WT = wsp<float>(C, WS_WTS); unsigned char* H8 = wsp<unsigned char>(C, WS_H8);
    const float* ng = inp(C, I_N2G) + l * 1024;
    const int wg = blockIdx.x, RPW = (Ml + C.G - 1) / C.G, m_lo = wg * RPW, m_hi = (m_lo + RPW < Ml) ? m_lo + RPW : Ml;
    { constexpr int RP = 2064;
      LAS unsigned char* rows = C.lds + 40960;
      LAS float* part = (LAS float*)C.lds;
      LAS float* lgt = (LAS float*)(C.lds + 32768);
      const int r32 = C.lane & 31, hi = C.lane >> 5, kq = C.wave * 128;
      const bf16_t* RWB = wsp<bf16_t>(C, WS_RWT) + (size_t)DEPTH * 32 * 1024 * 2 + (size_t)l * 32768;
      const float rbias = inp(C, I_RB)[l * 32 + r32];
      f32x4 gv[4];
#pragma unroll
      for (int j = 0; j < 4; ++j) gv[j] = ((const f32x4*)ng)[C.lane + 64 * j];
      bf16x8 bfr[8];
#pragma unroll
      for (int ks = 0; ks < 8; ++ks) bfr[ks] = *(const bf16x8*)(RWB + (size_t)r32 * 1024 + kq + ks * 16 + hi * 8);
      u32x2 xr[4][4];
#define XLOAD(mb_) do { _Pragma("unroll") for (int i = 0; i < 4; ++i) { const int m_ = (mb_) + C.wave * 4 + i; \
          _Pragma("unroll") for (int j = 0; j < 4; ++j) xr[i][j] = m_ < m_hi ? ((const u32x2*)(XS + (size_t)m_ * 1024))[C.lane + 64 * j] : (u32x2){0u, 0u}; } } while (0)
      if (m_lo < m_hi) XLOAD(m_lo);
      for (int mb = m_lo; mb < m_hi; mb += 32) {
          const int nrow = (m_hi - mb) < 32 ? (m_hi - mb) : 32;
#pragma unroll
          for (int i = 0; i < 4; ++i) { const int m = mb + C.wave * 4 + i;
              if (m < m_hi) {
                  const int bidx = m < MX ? (m >> 12) : 8;
                  f32x4 v[4]; float ss = 0.f;
#pragma unroll
                  for (int j = 0; j < 4; ++j) { v[j] = (f32x4){bf_lo(xr[i][j].x), bf_hi(xr[i][j].x), bf_lo(xr[i][j].y), bf_hi(xr[i][j].y)}; ss += (v[j].x * v[j].x + v[j].y * v[j].y) + (v[j].z * v[j].z + v[j].w * v[j].w); }
                  const float rstd = rsqrtf(wave_sum(ss, C.lane) * (1.0f / 1024.0f) + EPS);
                  const float* sh = MOD + ((size_t)l * 9 + bidx) * 6144 + 3 * 1024; const float* sc = sh + 1024;
                  LAS u32x2* o8 = (LAS u32x2*)(rows + (C.wave * 4 + i) * RP); unsigned* q8 = (unsigned*)(H8 + (size_t)m * 1024);
#pragma unroll
                  for (int j = 0; j < 4; ++j) { const f32x4 s1 = ((const f32x4*)sc)[C.lane + 64 * j], s0 = ((const f32x4*)sh)[C.lane + 64 * j];
                      const f32x4 h = v[j] * rstd * gv[j] * (1.0f + s1) + s0; u32x2 w; w.x = cvt_pk_bf16(h.x, h.y); w.y = cvt_pk_bf16(h.z, h.w); o8[C.lane + 64 * j] = w;
                      const f32x4 hc = (f32x4){fminf(fmaxf(h.x, -448.0f), 448.0f), fminf(fmaxf(h.y, -448.0f), 448.0f), fminf(fmaxf(h.z, -448.0f), 448.0f), fminf(fmaxf(h.w, -448.0f), 448.0f)};
                      int f = __builtin_amdgcn_cvt_pk_fp8_f32(hc.x, hc.y, 0, false); f = __builtin_amdgcn_cvt_pk_fp8_f32(hc.z, hc.w, f, true); q8[C.lane + 64 * j] = (unsigned)f; }
              } }
          if (mb + 32 < m_hi) XLOAD(mb + 32);
          __syncthreads();
          bf16x8 afr[8];
#pragma unroll
          for (int ks = 0; ks < 8; ++ks) afr[ks] = *(const LAS bf16x8*)(rows + r32 * RP + (kq + ks * 16 + hi * 8) * 2);
          f32x16 acc = {};
#pragma unroll
          for (int ks = 0; ks < 8; ++ks) acc = __builtin_amdgcn_mfma_f32_32x32x16_bf16(afr[ks], bfr[ks], acc, 0, 0, 0);
#pragma unroll
          for (int r = 0; r < 16; ++r) part[(C.wave * 32 + att::crow(r, hi)) * 32 + r32] = acc[r];
          __syncthreads();
          { const int i0 = C.tid, i1 = C.tid + 512; float s0 = 0.f, s1 = 0.f;
#pragma unroll
            for (int w = 0; w < 8; ++w) { s0 += part[w * 1024 + i0]; s1 += part[w * 1024 + i1]; }
            lgt[(i0 >> 5) * 33 + (i0 & 31)] = s0; lgt[(i1 >> 5) * 33 + (i1 & 31)] = s1; }
          __syncthreads();
#pragma unroll
          for (int pr = 0; pr < 2; ++pr) { const int tok = C.wave * 4 + pr * 2 + hi; const bool live = tok < nrow;
              const float lg = lgt[(tok < 32 ? tok : 31) * 33 + r32] + rbias;
              int rank = 0;
#pragma unroll 4
              for (int j = 0; j < 32; ++j) { const float o0 = __int_as_float(__builtin_amdgcn_readlane(__float_as_int(lg), j)), o1 = __int_as_float(__builtin_amdgcn_readlane(__float_as_int(lg), 32 + j));
                  const float oj = hi ? o1 : o0; rank += (oj > lg || (oj == lg && j < r32)) ? 1 : 0; }
              float tv[4]; int ti[4];
#pragma unroll
              for (int k = 0; k < 4; ++k) { const unsigned long long mk = __ballot(rank == k); const unsigned lo = (unsigned)mk, hh = (unsigned)(mk >> 32);
                  const int s0 = __builtin_ctz(lo | 0x80000000u) & 31, s1 = __builtin_ctz(hh | 0x80000000u) & 31;
                  const float v0 = __int_as_float(__builtin_amdgcn_readlane(__float_as_int(lg), s0)), v1 = __int_as_float(__builtin_amdgcn_readlane(__float_as_int(lg), 32 + s1));
                  tv[k] = hi ? v1 : v0; ti[k] = hi ? s1 : s0; }
              const float e1 = __expf(tv[1] - tv[0]), e2 = __expf(tv[2] - tv[0]), e3 = __expf(tv[3] - tv[0]); const float inv = 1.0f / (1.0f + e1 + e2 + e3);
              if (live && r32 < 4) { const int e = r32 == 0 ? ti[0] : r32 == 1 ? ti[1] : r32 == 2 ? ti[2] : ti[3];
                  const float w = (r32 == 0 ? 1.0f : r32 == 1 ? e1 : r32 == 2 ? e2 : e3) * inv;
                  const int rk = atomicAdd((int*)(hist + e), 1);
                  const int m = mb + tok; TOPE[m * 4 + r32] = e | (rk << 8); WT[m * 4 + r32] = w; } }
      } }
#undef XLOAD
    __syncthreads();
    if (C.tid < 32) wsp<int>(C, WS_CNTWG)[wg * 32 + C.tid] = hist[C.tid];
    __syncthreads();
}
__device__ __forceinline__ void phase_lists(const Params& P, const Ctx& C0, const int Ml) {
    Ctx C = C0; { const int t_ = opaque_tid(); C.tid = t_; C.lane = t_ & 63; C.wave = __builtin_amdgcn_readfirstlane(t_ >> 6); asm volatile("" : "+s"(C.ws)); asm volatile("" : "+s"(C.vcu)); asm volatile("" : "+s"(C.G)); }
    LAS int* part = (LAS int*)(C.lds);
    LAS int* tot = (LAS int*)(C.lds + 4096);
    LAS int* base = (LAS int*)(C.lds + 4096 + 128);
    LAS int* pst = (LAS int*)(C.lds + 4096 + 256);
    const int* CNT = wsp<int>(C, WS_CNTWG); const int wg = blockIdx.x;
    { const int e = C.tid & 31, seg = C.tid >> 5; int s = 0, sb = 0;
      for (int w = seg; w < C.G; w += 16) { const int c = CNT[w * 32 + e]; s += c; if (w < wg) sb += c; }
      part[seg * 32 + e] = s; part[512 + seg * 32 + e] = sb; }
    __syncthreads();
    if (C.tid < 32) { int s = 0, sb = 0; for (int g = 0; g < 16; ++g) { s += part[g * 32 + C.tid]; sb += part[512 + g * 32 + C.tid]; } tot[C.tid] = s; base[C.tid] = sb; }
    __syncthreads();
    if (C.tid == 0) { int p = 0; for (int e = 0; e < 32; ++e) { pst[e] = p; p += (tot[e] + 255) & ~255; } pst[32] = p;
        if (wg == 0) { int* PS = wsp<int>(C, WS_PSTART); for (int e = 0; e <= 32; ++e) PS[e] = pst[e]; } }
    __syncthreads();
    const int* TOPE = wsp<int>(C, WS_TOPE); int* YD = wsp<int>(C, WS_YDEST); int* RL = wsp<int>(C, WS_ROWLIST);
    const int RPW = (Ml + C.G - 1) / C.G, m_lo = wg * RPW, m_hi = (m_lo + RPW < Ml) ? m_lo + RPW : Ml;
    for (int i = m_lo * 4 + C.tid; i < m_hi * 4; i += 512) { const int t = TOPE[i], e = t & 255, rank = t >> 8; const int dst = pst[e] + base[e] + rank;
        YD[i] = dst; RL[dst] = i >> 2; }
    for (int e = 0; e < 32; ++e) { const int lo = pst[e] + tot[e], hi = pst[e + 1];
        for (int r = lo + wg * 512 + C.tid; r < hi; r += C.G * 512) RL[r] = 0; }
    __syncthreads();
}
struct SkOut { const bf16_t* A; const bf16_t* B; static constexpr int NC = 8, LD = 1024;
    __device__ __forceinline__ const bf16_t* a(int c) const { return A + c * 128; } __device__ __forceinline__ const bf16_t* b(int c) const { return B + c * 128; }
    static __device__ __forceinline__ constexpr int ai(int) { return 0; } };
struct SkBranch { const bf16_t* A0; const bf16_t* B0; const bf16_t* A1; const bf16_t* B1; static constexpr int NC = 8, LD = 512;
    __device__ __forceinline__ const bf16_t* a(int c) const { return c < 4 ? A0 + c * 128 : A1 + (c - 4) * 128; } __device__ __forceinline__ const bf16_t* b(int c) const { return c < 4 ? B0 + c * 128 : B1 + (c - 4) * 128; }
    static __device__ __forceinline__ constexpr int ai(int c) { return c < 4 ? 0 : 1; } };
template <class Src>
__device__ __forceinline__ void skinny_mm(const Src& S, f32x16 (&acc)[2], LAS unsigned char* lds, const int tid) {
    constexpr int NC = Src::NC, LD = Src::LD, ST = 136;
    LAS bf16_t* As = (LAS bf16_t*)lds;
    LAS bf16_t* Bs = As + 2 * 128 * ST;
    const int lane = tid & 63, wv = tid >> 6, r32 = lane & 31, hi = lane >> 5, wr = wv >> 1, wc = wv & 1;
    const int prow = tid >> 4, pk = (tid & 15) * 8;
    u32x4 ra[2][4], rb[2][2];
#define SK_LOAD(c, s) do { const bf16_t* a_ = S.a(c) + (size_t)prow * LD + pk; const bf16_t* b_ = S.b(c) + (size_t)prow * LD + pk; \
        _Pragma("unroll") for (int i = 0; i < 4; ++i) ra[s][i] = *(const u32x4*)(a_ + (size_t)i * 32 * LD); \
        _Pragma("unroll") for (int i = 0; i < 2; ++i) rb[s][i] = *(const u32x4*)(b_ + (size_t)i * 32 * LD); } while (0)
#define SK_WRITE(s, buf) do { _Pragma("unroll") for (int i = 0; i < 4; ++i) *(LAS u32x4*)(As + ((buf) * 128 + prow + 32 * i) * ST + pk) = ra[s][i]; \
        _Pragma("unroll") for (int i = 0; i < 2; ++i) *(LAS u32x4*)(Bs + ((buf) * 64 + prow + 32 * i) * ST + pk) = rb[s][i]; } while (0)
    SK_LOAD(0, 0); SK_LOAD(1, 1);
#pragma unroll
    for (int c = 0; c < NC; ++c) {
        SK_WRITE(c & 1, c & 1);
        if (c + 2 < NC) SK_LOAD(c + 2, c & 1);
        __syncthreads();
        const LAS bf16_t* ar = As + ((c & 1) * 128 + wr * 32 + r32) * ST + hi * 8; const LAS bf16_t* br = Bs + ((c & 1) * 64 + wc * 32 + r32) * ST + hi * 8;
#pragma unroll
        for (int ks = 0; ks < 8; ++ks) acc[Src::ai(c)] = __builtin_amdgcn_mfma_f32_32x32x16_bf16(*(const LAS bf16x8*)(ar + ks * 16), *(const LAS bf16x8*)(br + ks * 16), acc[Src::ai(c)], 0, 0, 0);
    }
    __syncthreads();
#undef SK_LOAD
#undef SK_WRITE
}
__device__ __forceinline__ void phase_skinny_branch(const Ctx& C0, const int l) {
    Ctx C = C0; { const int t_ = opaque_tid(); C.tid = t_; C.lane = t_ & 63; C.wave = __builtin_amdgcn_readfirstlane(t_ >> 6); asm volatile("" : "+s"(C.ws)); asm volatile("" : "+s"(C.vcu)); asm volatile("" : "+s"(C.G)); }
    const int r32 = C.lane & 31, hi = C.lane >> 5;
    for (int item = C.vcu; item < 256; item += C.G) {
        const int rb0 = MX + (item >> 4) * 128, cb0 = (item & 15) * 64;
        f32x16 acc[2] = {};
        SkBranch S{wsp<bf16_t>(C, WS_ODAN) + (size_t)rb0 * 512, wsp<bf16_t>(C, WS_WBRA) + (size_t)l * 1024 * 512 + (size_t)cb0 * 512,
                   wsp<bf16_t>(C, WS_OMLA) + (size_t)rb0 * 512, wsp<bf16_t>(C, WS_WBRB) + (size_t)l * 1024 * 512 + (size_t)cb0 * 512};
        skinny_mm(S, acc, C.lds, C.tid);
        const unsigned char* gates = wsp<unsigned char>(C, WS_GATES); bf16_t* U = wsp<bf16_t>(C, WS_U);
        const int r0 = rb0 + (C.wave >> 1) * 32, col = cb0 + (C.wave & 1) * 32 + r32;
#pragma unroll
        for (int r = 0; r < 16; ++r) { const size_t row = (size_t)(r0 + att::crow(r, hi));
            const float ga = (float)gates[row * 2048 + col], gb = (float)gates[row * 2048 + 1024 + col];
            const unsigned w = cvt_pk_bf16((ga * acc[0][r] + gb * acc[1][r]) * (1.0f / 255.0f), 0.f); U[row * 1024 + col] = (bf16_t)(w & 0xffffu); }
    }
}
__device__ __forceinline__ void phase_skinny_out(const Ctx& C0, const int l) {
    Ctx C = C0; { const int t_ = opaque_tid(); C.tid = t_; C.lane = t_ & 63; C.wave = __builtin_amdgcn_readfirstlane(t_ >> 6); asm volatile("" : "+s"(C.ws)); asm volatile("" : "+s"(C.vcu)); asm volatile("" : "+s"(C.G)); }
    const int r32 = C.lane & 31, hi = C.lane >> 5;
    for (int item = C.vcu; item < 256; item += C.G) {
        const int rb0 = MX + (item >> 4) * 128, cb0 = (item & 15) * 64;
        f32x16 acc[2] = {};
        SkOut S{wsp<bf16_t>(C, WS_U) + (size_t)rb0 * 1024, wsp<bf16_t>(C, WS_WOUT) + (size_t)l * 1024 * 1024 + (size_t)cb0 * 1024};
        skinny_mm(S, acc, C.lds, C.tid);
        bf16_t* XS = wsp<bf16_t>(C, WS_XS); const float* cin = inp(C, I_CTX);
        const int r0 = rb0 + (C.wave >> 1) * 32, col = cb0 + (C.wave & 1) * 32 + r32;
        const float g1 = (wsp<float>(C, WS_MOD) + ((size_t)l * 9 + 8) * 6144 + 2048)[col];
#pragma unroll
        for (int r = 0; r < 16; ++r) { const size_t row = (size_t)(r0 + att::crow(r, hi));
            const float base = l == 0 ? cin[(row - MX) * 1024 + col] : bf_lo((unsigned)XS[row * 1024 + col]);
            const unsigned w = cvt_pk_bf16(base + g1 * acc[0][r], 0.f); XS[row * 1024 + col] = (bf16_t)(w & 0xffffu); }
    }
}
__device__ __forceinline__ int moe_tiles(const Ctx& C0, LAS int* tile_e) {
    Ctx C = C0; { const int t_ = opaque_tid(); C.tid = t_; C.lane = t_ & 63; C.wave = __builtin_amdgcn_readfirstlane(t_ >> 6); asm volatile("" : "+s"(C.ws)); asm volatile("" : "+s"(C.vcu)); asm volatile("" : "+s"(C.G)); }
    const int* PS = wsp<int>(C, WS_PSTART);
    LAS int* pst = tile_e + 600;
    if (C.tid <= 32) pst[C.tid] = PS[C.tid] >> 8;
    __syncthreads();
    const int ntiles = pst[32];
    for (int t = C.tid; t < ntiles; t += 512) { int e = 0;
#pragma unroll
        for (int j = 1; j < 32; ++j) e = (pst[j] <= t) ? j : e;
        tile_e[t] = e; }
    __syncthreads();
    return __builtin_amdgcn_readfirstlane(ntiles);
}

__device__ unsigned g_barw[XCD_BAR_WORDS + 64];
constexpr int PH_PER_LAYER = 11, N_PHASES = 1 + DEPTH * PH_PER_LAYER + 1;
__global__ void __launch_bounds__(512, 2) dit_fwd(Params P) {
    extern __shared__ __attribute__((aligned(16))) unsigned char lds_raw[];
    Ctx C; C.lds = (LAS unsigned char*)lds_raw; C.ldsg = (char*)lds_raw; C.tid = threadIdx.x; C.lane = C.tid & 63; C.wave = __builtin_amdgcn_readfirstlane(C.tid >> 6);
    C.G = gridDim.x; { const int bx = blockIdx.x; C.vcu = (C.G % 8 == 0) ? (bx % 8) * (C.G / 8) + bx / 8 : bx; }
    C.ws = (GAS unsigned char*)P.ws;
    volatile LAS unsigned* MISC = (volatile LAS unsigned*)(C.lds + MISC_OFF);
    if (C.tid < 64) MISC[C.tid] = 0u;
    if (C.tid == 64) { LAS unsigned long long* tab = (LAS unsigned long long*)(C.lds + PTRTAB_OFF);
#pragma unroll
        for (int i = 0; i < 28; ++i) tab[i] = (unsigned long long)P.in[i];
        tab[28] = (unsigned long long)P.out; }
    { LAS float* T = (LAS float*)(C.lds + ROPE_OFF);
      for (int i = C.tid; i < 1024; i += 512) { const int p = i >> 4, f = i & 15; const float fr = powf(10000.0f, -(float)(2 * f) / 32.0f); const float a = (float)p * fr; T[2 * i] = cosf(a); T[2 * i + 1] = sinf(a); } }
    __syncthreads();
    unsigned* barw = g_barw;
    XcdBarrier bar; bar.bar = barw; bar.x = 0; bar.st = nullptr;
    const int lo = P.ph_lo, hi = P.ph_hi;
    const bool multi = (hi - lo) > 1;
    if (multi) bar = xcd_barrier_post(barw, MISC + 8);
#ifndef PH_MASK
#define PH_MASK 0xffff
#endif
#define IN(k) (lo <= (k) && (k) < hi)
#define EN(p) ((PH_MASK >> (p)) & 1)
#ifndef DUP_MASK
#define DUP_MASK 0
#endif
#define NREP(p) (((DUP_MASK >> (p)) & 1) ? 2 : 1)
#define PHASE_CTX(Q) Ctx Q = C; asm volatile("" : "+s"(Q.ws)); asm volatile("" : "+s"(Q.vcu)); asm volatile("" : "+s"(Q.G))
#ifndef TIME_MASK
#define TIME_MASK 0
#endif
#ifndef TIME_AMP
#define TIME_AMP 4
#endif
#define TM_BEGIN(p) unsigned long long tm0_ = 0; if ((TIME_MASK >> (p)) & 1) { __syncthreads(); tm0_ = __builtin_amdgcn_s_memrealtime(); }
#define TM_END(p) if ((TIME_MASK >> (p)) & 1) { __syncthreads(); const unsigned long long d_ = (__builtin_amdgcn_s_memrealtime() - tm0_) * TIME_AMP; const unsigned long long t1_ = __builtin_amdgcn_s_memrealtime(); while (__builtin_amdgcn_s_memrealtime() - t1_ < d_) __builtin_amdgcn_s_sleep(32); }
#define SEAM(k) do { if (IN((k) + 1)) xcd_barrier(bar); } while (0)
    if (EN(11) && IN(0)) { for (int rep = 0; rep < NREP(11); ++rep) { if (rep) xcd_barrier(bar); phase_prologue(P, C); } SEAM(0); }
    for (int l = 0; l < DEPTH; ++l) {
        const int pb = 1 + l * PH_PER_LAYER;
        const bool lastl = (l == DEPTH - 1);
        const int Ml = lastl ? MX : MT;
        const int nMl = Ml / 256;
        if (EN(0) && IN(pb + 0)) { TM_BEGIN(0) phase_mod1(P, C, l); TM_END(0) SEAM(pb + 0); }
        if (EN(1) && IN(pb + 1)) { TM_BEGIN(1)
            { PHASE_CTX(Q);
              pg8::G1aSched S{(const char*)wsp<bf16_t>(Q, WS_H), (const char*)(wsp<bf16_t>(Q, WS_WIN) + (size_t)l * NIN * 1024), 1024, MT / 256, 256, (int)blockIdx.x};
              EpiG1 E{Q.ws, (const LAS float*)(Q.lds + ROPE_OFF)};
              pg8::gemm_phase(Q.lds, 1024, S, E); }
            { PHASE_CTX(Q);
              pg8::G1bSched S{(const char*)wsp<unsigned char>(Q, WS_H8), (const char*)(wsp<unsigned char>(Q, WS_WING8) + (size_t)l * 2560 * 1024), 512, MT / 256, 256, (int)blockIdx.x, wsp<int>(Q, WS_IDLIST)};
              EpiGate E{Q.ws};
              pg8::gemm_phase<EpiGate, pg8::G1bSched, true, true>(Q.lds, 512, S, E); }
            TM_END(1) SEAM(pb + 1);
        }
        if (EN(2) && IN(pb + 2)) { TM_BEGIN(2) PHASE_CTX(Q); const int bx = (int)blockIdx.x;
            { pg8::PlainSched S{(const char*)wsp<bf16_t>(Q, WS_CQ), (const char*)(wsp<bf16_t>(Q, WS_WQB) + (size_t)l * 768 * 384), 384, MT / 256, 3, 256, bx};
              EpiQMla E{Q.ws, (const LAS float*)(Q.lds + ROPE_OFF)};
              pg8::gemm_phase(Q.lds, 384, S, E); }
            { pg8::PlainSched S{(const char*)wsp<bf16_t>(Q, WS_CKV), (const char*)(wsp<bf16_t>(Q, WS_WKVB) + (size_t)l * 1024 * 256), 256, MT / 256, 4, 256, (bx + 104) & 255};
              EpiKvMla E{Q.ws};
              pg8::gemm_phase(Q.lds, 256, S, E); }
            TM_END(2) SEAM(pb + 2);
        }
        if (EN(3) && IN(pb + 3)) { TM_BEGIN(3) for (int rep = 0; rep < NREP(3); ++rep) { if (rep) xcd_barrier(bar); PHASE_CTX(Q);
            const bf16_t* QDA = wsp<bf16_t>(Q, WS_QDA); const bf16_t* KDA = wsp<bf16_t>(Q, WS_KDA); const bf16_t* VDA = wsp<bf16_t>(Q, WS_VDA); bf16_t* ODA = wsp<bf16_t>(Q, WS_ODA);
            const bf16_t* QM = wsp<bf16_t>(Q, WS_QMLA); const bf16_t* KVM = wsp<bf16_t>(Q, WS_KVMLA); const bf16_t* KR = wsp<bf16_t>(Q, WS_KR); bf16_t* OM = wsp<bf16_t>(Q, WS_OMLA);
#ifndef ATT_ONLY
#define ATT_ONLY 3
#endif
            const int nu_m = (ATT_ONLY & 1) ? NB * 4 * 16 + (lastl ? 0 : NB * 4) : 0;
            for (int u = Q.vcu; u < nu_m; u += Q.G) {
                int h, q0, kx0, ky0, ntx, nt;
                if (u < NB * 4 * 16) { const int qb = u & 15, b = u >> 6; h = (u >> 4) & 3; q0 = b * SEQ + qb * 256; kx0 = b * SEQ; ky0 = MX + b * CTXL; ntx = SEQ / 64; nt = SEQ / 64 + CTXL / 64; }
                else { const int v = u - NB * 4 * 16, b = v >> 2; h = v & 3; q0 = MX + b * CTXL; kx0 = 0; ky0 = q0; ntx = 0; nt = CTXL / 64; }
                att::attn_unit<128, 768, 1024, 64, 1024, 512, 1>(QM + h * 192, QM + h * 192 + 128, KVM + h * 256, KR, KVM + h * 256 + 128, OM + h * 128, q0, kx0, ky0, ntx, nt, Q.ldsg,
                                                                 u < NB * 4 * 16 ? wsp<unsigned char>(Q, WS_OB8) + (size_t)MX * 512 + h * 128 : nullptr); }
            const int nu_d = (ATT_ONLY & 2) ? NB * 8 * 16 + (lastl ? 0 : NB * 8) : 0;
            for (int u = Q.vcu; u < nu_d; u += (Q.G == 256 && u < NB * 8 * 16 && u + Q.G >= NB * 8 * 16) ? ((Q.vcu >= 64 && Q.vcu < 128) ? Q.G - 64 : 4 * Q.G) : Q.G) {
                int hm, q0, kx0, ky0, ntx, nt;
                if (u < NB * 8 * 16) { const int qb = u & 15, b = u >> 7; hm = (u >> 4) & 7; q0 = b * SEQ + qb * 256; kx0 = b * SEQ; ky0 = MX + b * CTXL; ntx = SEQ / 64; nt = SEQ / 64 + CTXL / 64; }
                else { const int v = u - NB * 8 * 16, b = v >> 3; hm = v & 7; q0 = MX + b * CTXL; kx0 = 0; ky0 = q0; ntx = 0; nt = CTXL / 64; }
                att::attn_unit<0, 512, 512, 512, 512, 1024, 2>(QDA, QDA + hm * 64, KDA, KDA + hm * 64, VDA + (hm >> 1) * 128, ODA + hm * 128, q0, kx0, ky0, ntx, nt, Q.ldsg);
                if ((u >> 8) == (Q.vcu & 3)) convert_layer_share(Q, l, PER_L_DENSE, PER_L, lastl ? 0 : PER_L_DENSE); }
            } TM_END(3) SEAM(pb + 3);
        }
        if (EN(4) && IN(pb + 4)) { TM_BEGIN(4) phase_damerge(P, C, l, Ml); TM_END(4) SEAM(pb + 4); }
        if (EN(5) && IN(pb + 5)) { TM_BEGIN(5) for (int rep = 0; rep < NREP(5); ++rep) { if (rep) xcd_barrier(bar); PHASE_CTX(Q);
            pg8::PairGSched S{(const char*)wsp<unsigned char>(Q, WS_OB8), (long)MX * 512, (const char*)(wsp<unsigned char>(Q, WS_WBR8) + (size_t)(l * 2) * 1024 * 512), (long)1024 * 512, 256, MX / 256, 4, Q.G, (int)blockIdx.x, wsp<int>(Q, WS_IDLIST)};
            EpiBranch E{Q.ws};
            int kq_ = 256; asm volatile("" : "+s"(kq_));
            pg8::gemm_phase<EpiBranch, pg8::PairGSched, true, true>(Q.lds, kq_, S, E);
            if (!lastl) phase_skinny_branch(Q, l);
            } TM_END(5) SEAM(pb + 5);
        }
        if (EN(6) && IN(pb + 6)) { TM_BEGIN(6) PHASE_CTX(Q);
            pg8::PlainGSched S{(const char*)wsp<unsigned char>(Q, WS_U), (const char*)(wsp<unsigned char>(Q, WS_WOUT8) + (size_t)l * 1024 * 1024), 512, MX / 256, 4, Q.G, (int)blockIdx.x, wsp<int>(Q, WS_IDLIST)};
            EpiOut E{wsp<bf16_t>(Q, WS_XS), inp(Q, I_X), inp(Q, I_CTX), wsp<float>(Q, WS_MOD) + (size_t)l * 9 * 6144, l == 0 ? 1 : 0};
            pg8::gemm_phase<EpiOut, pg8::PlainGSched, true, true>(Q.lds, 512, S, E);
            if (!lastl) phase_skinny_out(Q, l);
            TM_END(6) SEAM(pb + 6);
        }
        if (EN(7) && IN(pb + 7)) { TM_BEGIN(7) for (int rep = 0; rep < NREP(7); ++rep) { if (rep) xcd_barrier(bar); phase_mod2_router(P, C, l, Ml); } TM_END(7) SEAM(pb + 7); }
        if (EN(8) && IN(pb + 8)) { TM_BEGIN(8) for (int rep = 0; rep < NREP(8); ++rep) { if (rep) xcd_barrier(bar); phase_lists(P, C, Ml); } TM_END(8) SEAM(pb + 8); }
        if (EN(9) && IN(pb + 9)) { TM_BEGIN(9) for (int rep = 0; rep < NREP(9); ++rep) { if (rep) xcd_barrier(bar); PHASE_CTX(Q);
            LAS int* tile_e = (LAS int*)(Q.lds + MISC_OFF + 512);
            const int ntiles = moe_tiles(Q, tile_e);
            pg8::MoeSched S{(const char*)wsp<unsigned char>(Q, WS_H8), (const char*)(wsp<unsigned char>(Q, WS_WGU) + (size_t)l * 32 * 1024 * 1024), 512, (size_t)1024 * 1024, ntiles, Q.G, Q.vcu, tile_e, wsp<int>(Q, WS_ROWLIST)};
            EpiUp E{wsp<unsigned char>(Q, WS_ACT), inp(Q, I_BGU) + (size_t)l * 32 * 1024};
            pg8::gemm_phase<EpiUp, pg8::MoeSched, true, true>(Q.lds, 512, S, E);
            } TM_END(9) SEAM(pb + 9);
        }
        if (EN(10) && IN(pb + 10)) { TM_BEGIN(10) for (int rep = 0; rep < NREP(10); ++rep) { if (rep) xcd_barrier(bar); PHASE_CTX(Q);
            LAS int* tile_e = (LAS int*)(Q.lds + MISC_OFF + 512);
            const int ntiles = moe_tiles(Q, tile_e);
            pg8::MoeSched S{(const char*)wsp<unsigned char>(Q, WS_ACT), (const char*)(wsp<unsigned char>(Q, WS_WDN) + (size_t)l * 32 * 1024 * 512), 256, (size_t)1024 * 512, ntiles, Q.G, Q.vcu, tile_e, wsp<int>(Q, WS_IDLIST)};
            EpiDown E{wsp<unsigned char>(Q, WS_Y), inp(Q, I_BDN) + (size_t)l * 32 * 1024};
            int kq_ = 256; asm volatile("" : "+s"(kq_));
            pg8::gemm_phase<EpiDown, pg8::MoeSched, true, true>(Q.lds, kq_, S, E);
            } TM_END(10) SEAM(pb + 10);
        }
    }
    if (EN(12) && IN(N_PHASES - 1)) phase_final(P, C);
    if (multi) {
        __syncthreads();
        if (threadIdx.x == 0) { const unsigned old = xb_add(&g_barw[XCD_BAR_WORDS], 1u); MISC[10] = (old + 1u == gridDim.x) ? 1u : 0u; }
        __syncthreads();
        if (MISC[10]) { for (int i = threadIdx.x; i < XCD_BAR_WORDS + 64; i += 512) g_barw[i] = 0u; }
    }
#undef IN
#undef SEAM
}

extern "C" void kernel_launch(void* const* d_in, const int* in_sizes, int n_in, void* d_out, int out_size, void* d_ws, size_t ws_size, hipStream_t stream) {
    static int grid = 0;
    if (grid == 0) {
        if (n_in != 28 || in_sizes[0] != MX * DM || out_size != MX * DM || ws_size < WS_END) { fprintf(stderr, "kernel_launch: shape/workspace mismatch (n_in %d, ws %zu < %zu)\n", n_in, ws_size, (size_t)WS_END); grid = -1; return; }
        int dev = 0, cus = 0, per_cu = 0;
        if (hipGetDevice(&dev) != hipSuccess || hipDeviceGetAttribute(&cus, hipDeviceAttributeMultiprocessorCount, dev) != hipSuccess) { grid = -1; return; }
        if (hipFuncSetAttribute((const void*)dit_fwd, hipFuncAttributeMaxDynamicSharedMemorySize, LDS_BYTES) != hipSuccess) { fprintf(stderr, "kernel_launch: hipFuncSetAttribute failed\n"); grid = -1; return; }
        if (hipOccupancyMaxActiveBlocksPerMultiprocessor(&per_cu, (const void*)dit_fwd, 512, LDS_BYTES) != hipSuccess || per_cu < 1) fprintf(stderr, "kernel_launch: occupancy query says %d\n", per_cu);
        (void)hipGetLastError();
        grid = cus > 1024 ? 1024 : cus;
    }
    if (grid < 0) return;
    Params p{};
    for (int i = 0; i < 28; ++i) p.in[i] = (const float*)d_in[i];
    p.out = (float*)d_out; p.ws = (unsigned char*)d_ws;
#if MK_ONE_LAUNCH
    p.ph_lo = 0; p.ph_hi = N_PHASES;
    hipLaunchKernelGGL(dit_fwd, dim3(grid), dim3(512), LDS_BYTES, stream, p);
#else
    for (int k = 0; k < N_PHASES; ++k) { p.ph_lo = k; p.ph_hi = k + 1; hipLaunchKernelGGL(dit_fwd, dim3(grid), dim3(512), LDS_BYTES, stream, p); }
#endif
    const hipError_t le = hipPeekAtLastError();
    if (le != hipSuccess) fprintf(stderr, "kernel_launch: launch failed: %s\n", hipGetErrorName(le));
}
```
